# Optimizing an MI355X kernel written in HIP

```python
import math
import jax, jax.numpy as jnp
from jax import lax
import numpy as np

D_MODEL = 1024
BATCH = 32
SEQ = 2048
DEPTH = 1
DEC_BATCH = 2
DEC_SEQ = 8192
PAST_LEN = 128

N_HEADS = 8
QK_HEAD_DIM = 64
V_HEAD_DIM = 2 * QK_HEAD_DIM
Q_WIDTH = N_HEADS * 2 * QK_HEAD_DIM
ATTN_WIDTH = N_HEADS * V_HEAD_DIM
N_FOURIER_GROUPS = 4
FOURIER_GROUP_DIM = 128
FOURIER_WIDTH = N_FOURIER_GROUPS * FOURIER_GROUP_DIM
ROPE_DIM = QK_HEAD_DIM // 4
ROPE_THETA = 500000.0
D_FF = 4 * D_MODEL
PLE_DIM = 256
Q_BLOCK = 128
EPS = 1e-6
LAMBDA_STD = 0.1
IN_WIDTH = FOURIER_WIDTH + Q_WIDTH + Q_WIDTH + ATTN_WIDTH + D_MODEL + D_MODEL

kernel_name = "hybrid_fnet_diffattn_encoder"


def rmsnorm(x, g):
    xf = x.astype(jnp.float32)
    y = xf * lax.rsqrt(jnp.mean(xf * xf, axis=-1, keepdims=True) + EPS)
    return (y * g.astype(jnp.float32)).astype(x.dtype)


def partial_rope(x):
    S = x.shape[1]
    half = ROPE_DIM // 2
    pos = jnp.arange(S, dtype=jnp.float32)
    inv_freq = ROPE_THETA ** (-(jnp.arange(0, ROPE_DIM, 2, dtype=jnp.float32) / ROPE_DIM))
    ang = pos[:, None] * inv_freq[None, :]
    cos = jnp.cos(ang)[None, :, None, None, :].astype(x.dtype)
    sin = jnp.sin(ang)[None, :, None, None, :].astype(x.dtype)
    x1 = x[..., :half]
    x2 = x[..., half:ROPE_DIM]
    rot = jnp.concatenate([x1 * cos - x2 * sin, x2 * cos + x1 * sin], axis=-1)
    return jnp.concatenate([rot, x[..., ROPE_DIM:]], axis=-1)


def fourier_mix(f):
    B, S, _ = f.shape
    fg = f.astype(jnp.float32).reshape(B, S, N_FOURIER_GROUPS, FOURIER_GROUP_DIM)
    out = jnp.fft.fft2(fg, axes=(1, 3), norm="ortho").real
    return out.reshape(B, S, FOURIER_WIDTH).astype(f.dtype)


def diff_attention(q, k, v, lam):
    B, S, H, _, Dh = q.shape
    nb = S // Q_BLOCK
    scale = 1.0 / math.sqrt(Dh)
    qb = q.reshape(B, nb, Q_BLOCK, H, 2, Dh).transpose(1, 0, 2, 3, 4, 5)

    def block(qi):
        s = jnp.einsum('bqhcd,bkhcd->bchqk', qi, k, preferred_element_type=jnp.float32) * scale
        pr = jax.nn.softmax(s, axis=-1)
        a = pr[:, 0] - lam * pr[:, 1]
        return jnp.einsum('bhqk,bkhd->bqhd', a.astype(v.dtype), v)

    out = lax.map(block, qb)
    return out.transpose(1, 0, 2, 3, 4).reshape(B, S, H, V_HEAD_DIM)


def layer(x, p, layer_idx, norm_mix_pre, w_in, w_fourier, w_attn, w_out,
          lambda_q1, lambda_k1, lambda_q2, lambda_k2, subln,
          norm_mix_post, norm_mlp_pre, w_up, w_down, norm_mlp_post,
          w_ple, w_ple_gate, norm_ple_post):
    B, S, _ = x.shape
    h = rmsnorm(x, norm_mix_pre)
    proj = h @ w_in
    o = 0
    f_in = proj[..., o:o + FOURIER_WIDTH]; o += FOURIER_WIDTH
    q = proj[..., o:o + Q_WIDTH]; o += Q_WIDTH
    k = proj[..., o:o + Q_WIDTH]; o += Q_WIDTH
    v = proj[..., o:o + ATTN_WIDTH]; o += ATTN_WIDTH
    g_f = jax.nn.sigmoid(proj[..., o:o + D_MODEL]); o += D_MODEL
    g_a = jax.nn.sigmoid(proj[..., o:o + D_MODEL])

    fourier_out = fourier_mix(f_in) @ w_fourier

    q = partial_rope(q.reshape(B, S, N_HEADS, 2, QK_HEAD_DIM))
    k = partial_rope(k.reshape(B, S, N_HEADS, 2, QK_HEAD_DIM))
    v = v.reshape(B, S, N_HEADS, V_HEAD_DIM)
    lam_init = 0.8 - 0.6 * math.exp(-0.3 * layer_idx)
    lam = (jnp.exp(jnp.sum(lambda_q1.astype(jnp.float32) * lambda_k1.astype(jnp.float32)))
           - jnp.exp(jnp.sum(lambda_q2.astype(jnp.float32) * lambda_k2.astype(jnp.float32)))
           + lam_init)
    att = diff_attention(q, k, v, lam)
    att = rmsnorm(att, subln) * (1.0 - lam_init)
    attn_out = att.reshape(B, S, ATTN_WIDTH) @ w_attn

    merged = g_f * fourier_out + g_a * attn_out
    x = x + rmsnorm(merged @ w_out, norm_mix_post)

    h2 = rmsnorm(x, norm_mlp_pre)
    u = jnp.square(jax.nn.relu(h2 @ w_up))
    x = x + rmsnorm(u @ w_down, norm_mlp_post)

    e = (p @ w_ple) * jax.nn.sigmoid(x @ w_ple_gate)
    x = x + rmsnorm(e, norm_ple_post)
    return x


def setup_inputs(seed: int = 0) -> dict:
    key = jax.random.key(seed)
    ks = jax.random.split(key, 24)
    f32 = jnp.float32

    def nrm(k, shape, scale=1.0):
        return jax.random.normal(k, shape, dtype=f32) * scale

    def gain(k):
        return 1.0 + 0.01 * jax.random.normal(k, (DEPTH, D_MODEL), dtype=f32)

    return {
        "x_prompt": nrm(ks[0], (BATCH, SEQ, D_MODEL)),
        "x_sample": nrm(ks[1], (DEC_BATCH, DEC_SEQ, D_MODEL)),
        "p_prompt": nrm(ks[2], (DEPTH, BATCH, SEQ, PLE_DIM)),
        "p_sample": nrm(ks[3], (DEPTH, DEC_BATCH, DEC_SEQ, PLE_DIM)),
        "norm_mix_pre": gain(ks[4]),
        "w_in": nrm(ks[5], (DEPTH, D_MODEL, IN_WIDTH), D_MODEL ** -0.5),
        "w_fourier": nrm(ks[6], (DEPTH, FOURIER_WIDTH, D_MODEL), FOURIER_WIDTH ** -0.5),
        "w_attn": nrm(ks[7], (DEPTH, ATTN_WIDTH, D_MODEL), ATTN_WIDTH ** -0.5),
        "w_out": nrm(ks[8], (DEPTH, D_MODEL, D_MODEL), D_MODEL ** -0.5),
        "lambda_q1": nrm(ks[9], (DEPTH, QK_HEAD_DIM), LAMBDA_STD),
        "lambda_k1": nrm(ks[10], (DEPTH, QK_HEAD_DIM), LAMBDA_STD),
        "lambda_q2": nrm(ks[11], (DEPTH, QK_HEAD_DIM), LAMBDA_STD),
        "lambda_k2": nrm(ks[12], (DEPTH, QK_HEAD_DIM), LAMBDA_STD),
        "subln": 1.0 + 0.01 * nrm(ks[13], (DEPTH, V_HEAD_DIM)),
        "norm_mix_post": gain(ks[14]),
        "norm_mlp_pre": gain(ks[15]),
        "w_up": nrm(ks[16], (DEPTH, D_MODEL, D_FF), D_MODEL ** -0.5),
        "w_down": nrm(ks[17], (DEPTH, D_FF, D_MODEL), D_FF ** -0.5),
        "norm_mlp_post": gain(ks[18]),
        "w_ple": nrm(ks[19], (DEPTH, PLE_DIM, D_MODEL), PLE_DIM ** -0.5),
        "w_ple_gate": nrm(ks[20], (DEPTH, D_MODEL, D_MODEL), D_MODEL ** -0.5),
        "norm_ple_post": gain(ks[21]),
    }


def reference(x_prompt, x_sample, p_prompt, p_sample, norm_mix_pre, w_in, w_fourier, w_attn, w_out,
              lambda_q1, lambda_k1, lambda_q2, lambda_k2, subln, norm_mix_post, norm_mlp_pre,
              w_up, w_down, norm_mlp_post, w_ple, w_ple_gate, norm_ple_post):
    y_prompt = x_prompt
    y_sample = x_sample
    for i in range(DEPTH):
        params = (norm_mix_pre[i], w_in[i], w_fourier[i], w_attn[i], w_out[i],
                  lambda_q1[i], lambda_k1[i], lambda_q2[i], lambda_k2[i], subln[i],
                  norm_mix_post[i], norm_mlp_pre[i], w_up[i], w_down[i], norm_mlp_post[i],
                  w_ple[i], w_ple_gate[i], norm_ple_post[i])
        y_prompt = layer(y_prompt, p_prompt[i], i, *params)
        y_sample = layer(y_sample, p_sample[i], i, *params)
    return (y_prompt, y_sample)
```

```cpp
#include <hip/hip_runtime.h>
#include <hip/hip_cooperative_groups.h>
#include <hip/hip_bf16.h>
#include <cstdio>
#include <cstdint>
namespace cg = cooperative_groups;

namespace xl {
__device__ __forceinline__ float dpp_f(float v, const int ctrl_sel) {
    int x = __builtin_bit_cast(int, v), r;
    if (ctrl_sel == 0) r = __builtin_amdgcn_mov_dpp(x, 0xB1, 0xF, 0xF, true);
    else if (ctrl_sel == 1) r = __builtin_amdgcn_mov_dpp(x, 0x4E, 0xF, 0xF, true);
    else if (ctrl_sel == 2) r = __builtin_amdgcn_mov_dpp(x, 0x141, 0xF, 0xF, true);
    else r = __builtin_amdgcn_mov_dpp(x, 0x140, 0xF, 0xF, true);
    return __builtin_bit_cast(float, r);
}
__device__ __forceinline__ float sum16(float v) { v += dpp_f(v, 0); v += dpp_f(v, 1); v += dpp_f(v, 2); v += dpp_f(v, 3); return v; }
__device__ __forceinline__ float add_x16(float v) { auto r = __builtin_amdgcn_permlane16_swap(__float_as_uint(v), __float_as_uint(v), false, false); return __uint_as_float(r[0]) + __uint_as_float(r[1]); }
__device__ __forceinline__ float add_x32(float v) { auto r = __builtin_amdgcn_permlane32_swap(__float_as_uint(v), __float_as_uint(v), false, false); return __uint_as_float(r[0]) + __uint_as_float(r[1]); }
__device__ __forceinline__ float get_x16(float v, bool odd_row) { auto r = __builtin_amdgcn_permlane16_swap(__float_as_uint(v), __float_as_uint(v), false, false); return __uint_as_float(odd_row ? r[0] : r[1]); }
__device__ __forceinline__ float sum32(float v) { return add_x16(sum16(v)); }
__device__ __forceinline__ float sum64(float v) { return add_x32(add_x16(sum16(v))); }
}
namespace pg8 {
#define PG8_LAS __attribute__((address_space(3)))
typedef unsigned short bf16_t;
typedef short bf16x8 __attribute__((ext_vector_type(8)));
typedef float f32x4 __attribute__((ext_vector_type(4)));
typedef unsigned u32x4 __attribute__((ext_vector_type(4)));
constexpr int BM = 256, BK = 64, HALF = 128, HTB = HALF * BK * 2  , STAGE_BYTES = 8 * HTB, NXCD = 8, WGM = 8;

__host__ __device__ __forceinline__ int lds_byte(int r, int c) { const int st = (r >> 4) * 2 + (c >> 5), rr = r & 15, cc = c & 31, ob = rr * 64 + cc * 2; return st * 1024 + (ob ^ (((ob >> 9) & 1) << 5)); }
__host__ __device__ __forceinline__ void stage_rc(int b, int& R, int& C) { const int st = b / 1024, sb = b % 1024, swz = sb ^ (((sb >> 9) & 1) << 5); R = (st >> 1) * 16 + swz / 64; C = (st & 1) * 32 + (swz % 64) / 2; }
__host__ __device__ __forceinline__ int perm32(int rho) { const int n = rho >> 4, i = rho & 15; return 8 * (i >> 2) + 4 * n + (i & 3); }

struct Unit { int pm, pn; };
struct Gemm { const bf16_t* A; const bf16_t* Bt; int M, N, K; };

struct StaticOrder {
    int nM, nN, nwg, G, c;
    __host__ __device__ void init(int M, int N, int G_, int c_) { nM = M / BM; nN = N / BM; nwg = nM * nN; G = G_; c = c_; }
    __host__ __device__ bool next(int i, Unit& u) const {
        const long L = (long)i * G + c; if (L >= nwg) return false;
        int wgid = (int)L; { const int q = nwg / NXCD, r = nwg % NXCD, xcd = wgid % NXCD, off = wgid / NXCD; wgid = (xcd < r ? xcd * (q + 1) : r * (q + 1) + (xcd - r) * q) + off; }
        const int nig = WGM * nN, gid = wgid / nig, fm = gid * WGM, gsz = (nM - fm) < WGM ? (nM - fm) : WGM;
        u.pm = fm + ((wgid % nig) % gsz); u.pn = (wgid % nig) / gsz; return true;
    }
    __device__ __forceinline__ void a_ready(const Unit&) const {}
    __device__ __forceinline__ void done(const Unit&) const {}
};

__device__ __forceinline__ unsigned cvt_pk_bf16(float lo, float hi) { unsigned r; asm volatile("s_nop 0\n\tv_cvt_pk_bf16_f32 %0, %1, %2" : "=v"(r) : "v"(lo), "v"(hi)); return r; }
__device__ __forceinline__ void unpack8(const u32x4 w, float (&f)[8]) {
#pragma unroll
    for (int i = 0; i < 4; ++i) { f[2 * i] = __uint_as_float(w[i] << 16); f[2 * i + 1] = __uint_as_float(w[i] & 0xffff0000u); }
}
__device__ __forceinline__ u32x4 pack8(const float (&f)[8]) { u32x4 w; w.x = cvt_pk_bf16(f[0], f[1]); w.y = cvt_pk_bf16(f[2], f[3]); w.z = cvt_pk_bf16(f[4], f[5]); w.w = cvt_pk_bf16(f[6], f[7]); return w; }
__device__ __forceinline__ float sigm(float x) { return __builtin_amdgcn_rcpf(1.0f + __builtin_amdgcn_exp2f(-1.4426950408889634f * x)); }
template <int MODE> struct EpiGen {
    static constexpr bool PERM = true, AFTER_DRAIN = false;
    bf16_t* O; int ldc; const bf16_t* X1; const bf16_t* X2; float* ss; float scale; size_t split_stride;
    __device__ __forceinline__ void operator()(const f32x4 (&acc)[2][2][4][2], const Unit& u, int wr_, int wc_, int fr_, int fq_) const {
        int t_ = threadIdx.x; asm volatile("" : "+v"(t_));
        const int wid_ = __builtin_amdgcn_readfirstlane(t_ >> 6), wr = wid_ >> 2, wc = wid_ & 3, fr = t_ & 15, fq = (t_ >> 4) & 3;
        const int row0 = u.pm * BM + wr * 64 + fr; int colt = u.pn * BM; bf16_t* base = O;
        if (MODE == 1) { const int t = colt >> 10; base += (size_t)t * split_stride; colt -= t << 10; }
        const int col0 = colt + wc * 32 + 8 * fq;
#pragma unroll
        for (int ai = 0; ai < 2; ++ai)
#pragma unroll
            for (int m = 0; m < 4; ++m) { const int row = row0 + ai * HALF + m * 16; const size_t ro = (size_t)row * ldc + col0; float sq = 0.f;
#pragma unroll
                for (int bj = 0; bj < 2; ++bj) { float v[8];
#pragma unroll
                    for (int i = 0; i < 4; ++i) { v[i] = acc[ai][bj][m][0][i]; v[4 + i] = acc[ai][bj][m][1][i]; }
                    const size_t off = ro + bj * HALF;
                    if (MODE == 1) {
#pragma unroll
                        for (int i = 0; i < 8; ++i) v[i] = sigm(v[i]); }
                    if (MODE == 2) { float a[8]; unpack8(*(const u32x4*)(X1 + off), a);
#pragma unroll
                        for (int i = 0; i < 8; ++i) v[i] *= a[i]; }
                    if (MODE == 3) { float a[8], b[8]; unpack8(*(const u32x4*)(X1 + off), a); unpack8(*(const u32x4*)(X2 + off), b);
#pragma unroll
                        for (int i = 0; i < 8; ++i) v[i] = a[i] + b[i] * v[i]; }
                    if (MODE == 5) {
#pragma unroll
                        for (int i = 0; i < 8; ++i) { const float r = fmaxf(v[i], 0.f); v[i] = r * r; } }
                    if (MODE == 6) { float a[8]; unpack8(*(const u32x4*)(X1 + off), a);
#pragma unroll
                        for (int i = 0; i < 8; ++i) v[i] = a[i] * sigm(v[i]); }
                    if (MODE == 4 || MODE == 6) {
#pragma unroll
                        for (int i = 0; i < 8; ++i) sq += v[i] * v[i]; }
                    *(u32x4*)(base + off) = pack8(v); }
                if (MODE == 4 || MODE == 6) { sq = xl::add_x32(xl::add_x16(sq)); if (fq == 0) ss[(size_t)row * 16 + u.pn * 4 + wc] = sq; }
            }
    }
};
struct EpiGT {
    static constexpr bool PERM = true, AFTER_DRAIN = false;
    bf16_t* GT;
    __device__ __forceinline__ void operator()(const f32x4 (&acc)[2][2][4][2], const Unit& u, int wr, int wc, int fr, int fq) const {
        const int n0 = u.pm * BM + wr * 64 + fr; const int t0 = u.pn * BM + wc * 32 + 8 * fq;
#pragma unroll
        for (int bj = 0; bj < 2; ++bj) { const int t = t0 + bj * HALF; size_t tb; int S, s, b;
            if (t < 65536) { b = t >> 11; s = t & 2047; S = 2048; tb = 0; } else { const int tt = t - 65536; b = tt >> 13; s = tt & 8191; S = 8192; tb = (size_t)65536 * 1024; }
#pragma unroll
            for (int ai = 0; ai < 2; ++ai)
#pragma unroll
                for (int m = 0; m < 4; ++m) { const int n = n0 + ai * HALF + m * 16, comp = n >> 9, c = n & 511; float v[8];
#pragma unroll
                    for (int i = 0; i < 4; ++i) { v[i] = acc[ai][bj][m][0][i]; v[4 + i] = acc[ai][bj][m][1][i]; }
                    *(u32x4*)(GT + tb + ((size_t)(b * 512 + c) * 2 + comp) * S + s) = pack8(v); } }
    }
};
struct EpiQKV {
    static constexpr bool PERM = true, AFTER_DRAIN = false;
    bf16_t* Gb; bf16_t* Q; bf16_t* K; size_t vstride; const float* rope;
    __device__ __forceinline__ void operator()(const f32x4 (&acc)[2][2][4][2], const Unit& u, int wr, int wc, int fr, int fq) const {
        const int row0 = u.pm * BM + wr * 64 + fr; int colt = u.pn * BM; const int t = colt >> 10; bf16_t* base = (t == 0) ? Gb : ((t == 1) ? Q : (K + (size_t)(t - 2) * vstride)); colt -= t << 10;
        const int col0 = colt + wc * 32 + 8 * fq; const bool rot = (t == 1 || t == 2) && ((wc & 1) == 0);
#pragma unroll
        for (int ai = 0; ai < 2; ++ai)
#pragma unroll
            for (int m = 0; m < 4; ++m) { const int row = row0 + ai * HALF + m * 16; const size_t ro = (size_t)row * 1024 + col0;
                float cs[8], sn[8];
                if (rot) { const int pos = row < 65536 ? (row & 2047) : (row & 8191); const f32x4* rp = (const f32x4*)(rope + (size_t)pos * 16);
                    const f32x4 c0 = rp[0], c1 = rp[1], s0 = rp[2], s1 = rp[3];
#pragma unroll
                    for (int i = 0; i < 4; ++i) { cs[i] = c0[i]; cs[4 + i] = c1[i]; sn[i] = s0[i]; sn[4 + i] = s1[i]; } }
#pragma unroll
                for (int bj = 0; bj < 2; ++bj) { float v[8];
#pragma unroll
                    for (int i = 0; i < 4; ++i) { v[i] = acc[ai][bj][m][0][i]; v[4 + i] = acc[ai][bj][m][1][i]; }
                    if (rot) {
#pragma unroll
                        for (int i = 0; i < 8; ++i) { const float o = xl::get_x16(v[i], (fq & 1) != 0);
                            const float r = (fq == 0) ? (v[i] * cs[i] - o * sn[i]) : (v[i] * cs[i] + o * sn[i]);
                            if (fq < 2) v[i] = r; } }
                    *(u32x4*)(base + ro + bj * HALF) = pack8(v); } }
    }
};
struct EpiDFT {
    static constexpr bool PERM = true, AFTER_DRAIN = false;
    bf16_t* F; int S; float scale;
    __device__ __forceinline__ void operator()(const f32x4 (&acc)[2][2][4][2], const Unit& u, int wr, int wc, int fr, int fq) const {
        const int b = u.pn >> 1, ct = u.pn & 1; const int row0 = b * S + u.pm * BM + wr * 64 + fr; const int col0 = ct * BM + wc * 32 + 8 * fq;
#pragma unroll
        for (int ai = 0; ai < 2; ++ai)
#pragma unroll
            for (int m = 0; m < 4; ++m) { const size_t ro = (size_t)(row0 + ai * HALF + m * 16) * 512 + col0;
#pragma unroll
                for (int bj = 0; bj < 2; ++bj) { float v[8];
#pragma unroll
                    for (int i = 0; i < 4; ++i) { v[i] = acc[ai][bj][m][0][i] * scale; v[4 + i] = acc[ai][bj][m][1][i] * scale; }
                    *(u32x4*)(F + ro + bj * HALF) = pack8(v); } }
    }
};
struct ListOrder {
    int base, count, nfast; bool pnfast;
    __device__ bool next(int i, Unit& u) const { if (i >= count) return false; const int idx = base + i; if (pnfast) { u.pn = idx % nfast; u.pm = idx / nfast; } else { u.pm = idx % nfast; u.pn = idx / nfast; } return true; }
    __device__ __forceinline__ void a_ready(const Unit&) const {}
    __device__ __forceinline__ void done(const Unit&) const {}
};
template <class Epi, class Sched, bool ALIGN_EPI = false, bool SP2 = false>
__device__ __forceinline__ void gemm_phase(PG8_LAS unsigned char* lds, const Gemm g, const Sched& S, const Epi& E) {
    int tid_ = threadIdx.x; asm volatile("" : "+v"(tid_));
    const int tid = tid_, wid = __builtin_amdgcn_readfirstlane(tid >> 6), lane = tid & 63, wr = wid >> 2, wc = wid & 3, fr = lane & 15, fq = lane >> 4;
    const int K = g.K, nt = K / BK;
    unsigned voffA[2], voffB[2];
#pragma unroll
    for (int i = 0; i < 2; ++i) { int R, C; stage_rc(tid * 16 + i * 8192, R, C); const int Rb = Epi::PERM ? ((R & ~31) + perm32(R & 31)) : R;
        voffA[i] = (unsigned)(R * K + C) * 2u; voffB[i] = (unsigned)(Rb * K + C) * 2u; }
    const size_t kstep = (size_t)(BK * 2);
    const size_t hstep = (size_t)HALF * K * 2;
    const size_t tstep = 2 * hstep;
    const unsigned ldsw = (unsigned)wid * 1024u;
    const int aoff = lds_byte(wr * 64 + fr, fq * 8), boff = lds_byte(wc * 32 + fr, fq * 8);
#define PG8_SA(b, h) (((b) * 2 + (h)) * HTB)
#define PG8_SB(b, h) ((4 + (b) * 2 + (h)) * HTB)
#define PG8_STAGE(bufoff, gbase, voff) do { _Pragma("unroll") for (int _i = 0; _i < 2; ++_i) \
        __builtin_amdgcn_global_load_lds((const unsigned*)((const char*)(gbase) + (voff)[_i]), (PG8_LAS unsigned*)(lds + (bufoff) + ldsw + _i * 8192), 16, 0, 0); } while (0)
#define PG8_LDA(dst, b, h) do { _Pragma("unroll") for (int m = 0; m < 4; ++m) _Pragma("unroll") for (int k = 0; k < 2; ++k) dst[m][k] = *(const PG8_LAS bf16x8*)(lds + PG8_SA(b, h) + aoff + m * 2048 + k * 1024); } while (0)
#define PG8_LDB(dst, b, h) do { _Pragma("unroll") for (int n = 0; n < 2; ++n) _Pragma("unroll") for (int k = 0; k < 2; ++k) dst[n][k] = *(const PG8_LAS bf16x8*)(lds + PG8_SB(b, h) + boff + n * 2048 + k * 1024); } while (0)
#define PG8_MMA(ai, bj, At, Bt) do { __builtin_amdgcn_s_setprio(1); _Pragma("unroll") for (int m = 0; m < 4; ++m) _Pragma("unroll") for (int n = 0; n < 2; ++n) _Pragma("unroll") for (int k = 0; k < 2; ++k) \
        acc[ai][bj][m][n] = __builtin_amdgcn_mfma_f32_16x16x32_bf16(Bt[n][k], At[m][k], acc[ai][bj][m][n], 0, 0, 0); __builtin_amdgcn_s_setprio(0); } while (0)
#define PG8_WAIT_V(n) asm volatile("s_waitcnt vmcnt(" #n ")" ::: "memory")
#define PG8_WAIT_L(n) asm volatile("s_waitcnt lgkmcnt(" #n ")" ::: "memory")
#define PG8_BAR __builtin_amdgcn_s_barrier()
#define PG8_SCHED __builtin_amdgcn_sched_barrier(0)
    Unit cur, nxt; int ui = 0;
    if (!S.next(0, cur)) return;
    f32x4 acc[2][2][4][2];
#pragma unroll
    for (int a = 0; a < 2; ++a)
#pragma unroll
        for (int b = 0; b < 2; ++b)
#pragma unroll
            for (int m = 0; m < 4; ++m)
#pragma unroll
                for (int n = 0; n < 2; ++n) acc[a][b][m][n] = (f32x4){0.f, 0.f, 0.f, 0.f};
    bf16x8 At[4][2], B0[2][2], B1[2][2];
    const char* cA = (const char*)g.A + (size_t)cur.pm * tstep; const char* cB = (const char*)g.Bt + (size_t)cur.pn * tstep;
    S.a_ready(cur);
    if constexpr (SP2) {
        PG8_STAGE(PG8_SB(0, 0), cB, voffB); PG8_STAGE(PG8_SB(0, 1), cB + hstep, voffB); PG8_STAGE(PG8_SA(0, 0), cA, voffA); PG8_STAGE(PG8_SA(0, 1), cA + hstep, voffA);
        if (wr == 1) PG8_BAR;
        PG8_WAIT_V(2); PG8_BAR;
        PG8_STAGE(PG8_SB(1, 0), cB + kstep, voffB); PG8_STAGE(PG8_SA(1, 0), cA + kstep, voffA); PG8_STAGE(PG8_SB(1, 1), cB + hstep + kstep, voffB);
        PG8_WAIT_V(6); PG8_BAR;
    } else {
        PG8_STAGE(PG8_SB(0, 0), cB, voffB); PG8_STAGE(PG8_SA(0, 0), cA, voffA); PG8_STAGE(PG8_SB(0, 1), cB + hstep, voffB); PG8_STAGE(PG8_SA(0, 1), cA + hstep, voffA);
        if (wr == 1) PG8_BAR;
        PG8_WAIT_V(4); PG8_BAR;
        PG8_STAGE(PG8_SB(1, 0), cB + kstep, voffB); PG8_STAGE(PG8_SA(1, 0), cA + kstep, voffA); PG8_STAGE(PG8_SB(1, 1), cB + hstep + kstep, voffB);
        PG8_WAIT_V(6); PG8_BAR;
    }
    for (;;) {
        const bool has_next = S.next(ui + 1, nxt);
        const char* nA = has_next ? (const char*)g.A + (size_t)nxt.pm * tstep : cA; const char* nB = has_next ? (const char*)g.Bt + (size_t)nxt.pn * tstep : cB;
        for (int t = 0; t < nt; t += 2) {
            const bool last = (t == nt - 2);
            const char* a1 = cA + (size_t)(t + 1) * kstep;
            const char* a2 = last ? nA : cA + (size_t)(t + 2) * kstep; const char* b2 = last ? nB : cB + (size_t)(t + 2) * kstep;
            const char* a3 = a2 + kstep; const char* b3 = b2 + kstep;
            if (last && has_next) S.a_ready(nxt);
            if constexpr (SP2) {
            PG8_LDB(B0, 0, 0); PG8_LDB(B1, 0, 1); PG8_SCHED; PG8_LDA(At, 0, 0); PG8_STAGE(PG8_SA(1, 1), a1 + hstep, voffA);
            PG8_WAIT_V(8); PG8_WAIT_L(0); PG8_BAR; PG8_MMA(0, 0, At, B0); PG8_MMA(0, 1, At, B1); PG8_BAR; PG8_SCHED;
            PG8_LDA(At, 0, 1); PG8_STAGE(PG8_SB(0, 0), b2, voffB); PG8_STAGE(PG8_SB(0, 1), b2 + hstep, voffB); PG8_STAGE(PG8_SA(0, 0), a2, voffA);
            PG8_WAIT_V(8); PG8_WAIT_L(0); PG8_BAR; PG8_MMA(1, 0, At, B0); PG8_MMA(1, 1, At, B1); PG8_BAR; PG8_SCHED;
            PG8_LDB(B0, 1, 0); PG8_LDB(B1, 1, 1); PG8_SCHED; PG8_LDA(At, 1, 0); PG8_STAGE(PG8_SA(0, 1), a2 + hstep, voffA);
            PG8_WAIT_V(8); PG8_WAIT_L(0); PG8_BAR; PG8_MMA(0, 0, At, B0); PG8_MMA(0, 1, At, B1); PG8_BAR; PG8_SCHED;
            PG8_LDA(At, 1, 1); PG8_STAGE(PG8_SB(1, 0), b3, voffB); PG8_STAGE(PG8_SB(1, 1), b3 + hstep, voffB); PG8_STAGE(PG8_SA(1, 0), a3, voffA);
            PG8_WAIT_V(8); PG8_WAIT_L(0); PG8_BAR; PG8_MMA(1, 0, At, B0); PG8_MMA(1, 1, At, B1); PG8_BAR; PG8_SCHED;
            } else {
            PG8_LDB(B0, 0, 0); PG8_SCHED; PG8_LDA(At, 0, 0); PG8_STAGE(PG8_SA(1, 1), a1 + hstep, voffA);
            PG8_WAIT_L(8); PG8_BAR; PG8_WAIT_L(0); PG8_MMA(0, 0, At, B0); PG8_BAR; PG8_SCHED;
            PG8_LDB(B1, 0, 1); PG8_STAGE(PG8_SB(0, 0), b2, voffB);
            PG8_BAR; PG8_WAIT_L(0); PG8_MMA(0, 1, At, B1); PG8_BAR;
            PG8_LDA(At, 0, 1); PG8_STAGE(PG8_SA(0, 0), a2, voffA);
            PG8_BAR; PG8_WAIT_L(0); PG8_MMA(1, 0, At, B0); PG8_BAR; PG8_SCHED;
            PG8_STAGE(PG8_SB(0, 1), b2 + hstep, voffB);
            PG8_WAIT_V(6); PG8_BAR; PG8_MMA(1, 1, At, B1); PG8_BAR;
            PG8_LDB(B0, 1, 0); PG8_SCHED; PG8_LDA(At, 1, 0); PG8_STAGE(PG8_SA(0, 1), a2 + hstep, voffA);
            PG8_WAIT_L(8); PG8_BAR; PG8_WAIT_L(0); PG8_MMA(0, 0, At, B0); PG8_BAR; PG8_SCHED;
            PG8_LDB(B1, 1, 1); PG8_STAGE(PG8_SB(1, 0), b3, voffB);
            PG8_BAR; PG8_WAIT_L(0); PG8_MMA(0, 1, At, B1); PG8_BAR;
            PG8_LDA(At, 1, 1); PG8_STAGE(PG8_SA(1, 0), a3, voffA);
            PG8_BAR; PG8_WAIT_L(0); PG8_MMA(1, 0, At, B0); PG8_BAR; PG8_SCHED;
            PG8_STAGE(PG8_SB(1, 1), b3 + hstep, voffB);
            PG8_WAIT_V(6); PG8_BAR; PG8_MMA(1, 1, At, B1); PG8_BAR;
            }
        }
        if constexpr (ALIGN_EPI) { if (wr == 0) PG8_BAR; }
        if constexpr (!Epi::AFTER_DRAIN) { E(acc, cur, wr, wc, fr, fq); S.done(cur); }
        if (!has_next) break;
#pragma unroll
        for (int a = 0; a < 2; ++a)
#pragma unroll
            for (int b = 0; b < 2; ++b)
#pragma unroll
                for (int m = 0; m < 4; ++m)
#pragma unroll
                    for (int n = 0; n < 2; ++n) acc[a][b][m][n] = (f32x4){0.f, 0.f, 0.f, 0.f};
        cur = nxt; cA = nA; cB = nB; ++ui;
        if constexpr (ALIGN_EPI) { if (wr == 1) PG8_BAR; }
    }
    PG8_WAIT_V(0);
    if constexpr (!ALIGN_EPI) { if (wr == 0) PG8_BAR; }
    PG8_BAR;
    if constexpr (Epi::AFTER_DRAIN) { E.fused(acc, cur, wr, wc, fr, fq, lds, wid, lane); S.done(cur); }
#undef PG8_SA
#undef PG8_SB
#undef PG8_STAGE
#undef PG8_LDA
#undef PG8_LDB
#undef PG8_MMA
#undef PG8_WAIT_V
#undef PG8_WAIT_L
#undef PG8_BAR
#undef PG8_SCHED
}
}
namespace att {
using bf16x8 = __attribute__((ext_vector_type(8))) short;
using s16x4  = __attribute__((ext_vector_type(4))) short;
using f32x16 = __attribute__((ext_vector_type(16))) float;
using u32x4  = __attribute__((ext_vector_type(4))) unsigned;
using f32x4v = __attribute__((ext_vector_type(4))) float;
typedef unsigned short bf16_t;
constexpr int NW = 8, QBLK = 32, KVBLK = 64, LD = 1024;
constexpr float SCALE = 0.125f, THR = 8.f;
constexpr int SHM_V = KVBLK * 128 * 2, SHM_K = KVBLK * 64 * 2, SHM_ATTN = 3 * SHM_V + 3 * SHM_K + NW * 64 * 4;
#define KSWZ(row, colB) ((row) * 128 + ((colB) ^ ((((row) >> 1) & 7) << 4)))
#define SBAR() __builtin_amdgcn_sched_barrier(0)
__device__ __forceinline__ int crow(int r, int hi) { return (r & 3) + 8 * (r >> 2) + 4 * hi; }
__device__ __forceinline__ unsigned cvtpk(float lo, float hi) { unsigned r; asm volatile("s_nop 0\n\tv_cvt_pk_bf16_f32 %0, %1, %2" : "=v"(r) : "v"(lo), "v"(hi)); return r; }
__device__ __forceinline__ void partialSM(f32x16& p0, f32x16& p1, float& m_reg, float& mn, float& alpha) {
  constexpr float C = SCALE * 1.4426950408889634f;
  float pmax = p0[0];
#pragma unroll
  for (int r = 1; r < 16; ++r) pmax = fmaxf(pmax, p0[r]);
#pragma unroll
  for (int r = 0; r < 16; ++r) pmax = fmaxf(pmax, p1[r]);
  { auto rr = __builtin_amdgcn_permlane32_swap(__float_as_uint(pmax), __float_as_uint(pmax), false, false);
    pmax = fmaxf(__uint_as_float(rr[0]), __uint_as_float(rr[1])); }
  if (__builtin_expect(__all(pmax - m_reg <= THR / SCALE), 1)) { mn = m_reg; alpha = 1.f; }
  else { mn = fmaxf(m_reg, pmax); alpha = __builtin_amdgcn_exp2f((m_reg - mn) * C); m_reg = mn; }
  float mnC = -mn * C;
#pragma unroll
  for (int r = 0; r < 16; ++r) p0[r] = fmaf(p0[r], C, mnC);
#pragma unroll
  for (int r = 0; r < 16; ++r) p1[r] = fmaf(p1[r], C, mnC);
#pragma unroll
  for (int r = 0; r < 16; ++r) p0[r] = __builtin_amdgcn_exp2f(p0[r]);
}
__device__ __forceinline__ void finishSM(f32x16& p0, f32x16& p1, float alpha, float& l_reg, bf16x8& pa0, bf16x8& pa1, bf16x8& pa2, bf16x8& pa3) {
#pragma unroll
  for (int r = 0; r < 16; ++r) p1[r] = __builtin_amdgcn_exp2f(p1[r]);
  float ps = 0;
#pragma unroll
  for (int r = 0; r < 16; ++r) ps += p0[r];
#pragma unroll
  for (int r = 0; r < 16; ++r) ps += p1[r];
  { auto rr = __builtin_amdgcn_permlane32_swap(__float_as_uint(ps), __float_as_uint(ps), false, false);
    ps = __uint_as_float(rr[0]) + __uint_as_float(rr[1]); }
  l_reg = l_reg * alpha + ps;
#define PK4(P, BASE, OUT) do { unsigned a0 = cvtpk(P[BASE + 0], P[BASE + 1]), a1 = cvtpk(P[BASE + 2], P[BASE + 3]);   \
    unsigned b0 = cvtpk(P[BASE + 4], P[BASE + 5]), b1 = cvtpk(P[BASE + 6], P[BASE + 7]);                              \
    auto r0 = __builtin_amdgcn_permlane32_swap(a0, b0, false, false); auto r1 = __builtin_amdgcn_permlane32_swap(a1, b1, false, false); \
    u32x4 w = {r0[0], r1[0], r0[1], r1[1]}; OUT = *reinterpret_cast<bf16x8*>(&w); } while (0)
  PK4(p0, 0, pa0); PK4(p0, 8, pa1); PK4(p1, 0, pa2); PK4(p1, 8, pa3);
#undef PK4
}
__device__ __forceinline__ void qkt(f32x16& p0, f32x16& p1, const char* Ks, const bf16x8* qr, int r32, int hi) {
  p0 = f32x16{}; p1 = f32x16{};
#pragma unroll
  for (int d0 = 0; d0 < 4; ++d0) { int cb = (d0 * 16 + hi * 8) * 2;
    bf16x8 b0 = *reinterpret_cast<const bf16x8*>(Ks + KSWZ(r32, cb));
    bf16x8 b1 = *reinterpret_cast<const bf16x8*>(Ks + KSWZ(32 + r32, cb));
    p0 = __builtin_amdgcn_mfma_f32_32x32x16_bf16(b0, qr[d0], p0, 0, 0, 0);
    p1 = __builtin_amdgcn_mfma_f32_32x32x16_bf16(b1, qr[d0], p1, 0, 0, 0); }
}
__device__ __forceinline__ int v_st(int k, int c) { const int kk = (k & ~0xC) | ((k & 4) << 1) | ((k & 8) >> 1); return ((kk >> 3) * 4 + (c >> 5)) * 512 + ((kk & 7) * 32 + (c & 31)) * 2; }
__device__ __forceinline__ int v_rd_base(int lane) { return ((lane & 3) << 3) | (((lane >> 2) & 3) << 6) | (((lane >> 4) & 1) << 5) | (((lane >> 5) & 1) << 8); }
constexpr int v_rd_off(int d0, int ks, int half) { return d0 * 512 + ks * 4096 + half * 2048; }
template <int OFF> __device__ __forceinline__ s16x4 tr_read(int vb) {
  s16x4 r; asm volatile("ds_read_b64_tr_b16 %0, %1 offset:%2" : "=&v"(r) : "v"(vb), "i"(OFF) : "memory"); return r;
}
template <int D0> __device__ __forceinline__ void pv_one(f32x16& od, int vb, bf16x8 pa0, bf16x8 pa1, bf16x8 pa2, bf16x8 pa3) {
  const s16x4 l0 = tr_read<v_rd_off(D0, 0, 0)>(vb), h0 = tr_read<v_rd_off(D0, 0, 1)>(vb), l1 = tr_read<v_rd_off(D0, 1, 0)>(vb), h1 = tr_read<v_rd_off(D0, 1, 1)>(vb);
  const s16x4 l2 = tr_read<v_rd_off(D0, 2, 0)>(vb), h2 = tr_read<v_rd_off(D0, 2, 1)>(vb), l3 = tr_read<v_rd_off(D0, 3, 0)>(vb), h3 = tr_read<v_rd_off(D0, 3, 1)>(vb);
  asm volatile("s_waitcnt lgkmcnt(0)" ::: "memory"); SBAR();
#define PK(L, H) (bf16x8){L[0], L[1], L[2], L[3], H[0], H[1], H[2], H[3]}
  od = __builtin_amdgcn_mfma_f32_32x32x16_bf16(pa0, PK(l0, h0), od, 0, 0, 0);
  od = __builtin_amdgcn_mfma_f32_32x32x16_bf16(pa1, PK(l1, h1), od, 0, 0, 0);
  od = __builtin_amdgcn_mfma_f32_32x32x16_bf16(pa2, PK(l2, h2), od, 0, 0, 0);
  od = __builtin_amdgcn_mfma_f32_32x32x16_bf16(pa3, PK(l3, h3), od, 0, 0, 0);
#undef PK
}
__device__ __forceinline__ void pv_d0(f32x16* o, int vb, bf16x8 pa0, bf16x8 pa1, bf16x8 pa2, bf16x8 pa3) {
  pv_one<0>(o[0], vb, pa0, pa1, pa2, pa3); pv_one<1>(o[1], vb, pa0, pa1, pa2, pa3); pv_one<2>(o[2], vb, pa0, pa1, pa2, pa3); pv_one<3>(o[3], vb, pa0, pa1, pa2, pa3);
}
__device__ __forceinline__ void pv_sm(f32x16* o, int vb, bf16x8 pa0, bf16x8 pa1, bf16x8 pa2, bf16x8 pa3, f32x16& p0, f32x16& p1, float& m_reg, float& mn, float& alpha) {
  constexpr float C = SCALE * 1.4426950408889634f;
  pv_one<0>(o[0], vb, pa0, pa1, pa2, pa3);
  float pmax = p0[0];
#pragma unroll
  for (int r = 1; r < 16; ++r) pmax = fmaxf(pmax, p0[r]);
#pragma unroll
  for (int r = 0; r < 16; ++r) pmax = fmaxf(pmax, p1[r]);
  { auto rr = __builtin_amdgcn_permlane32_swap(__float_as_uint(pmax), __float_as_uint(pmax), false, false);
    pmax = fmaxf(__uint_as_float(rr[0]), __uint_as_float(rr[1])); }
  pv_one<1>(o[1], vb, pa0, pa1, pa2, pa3);
  const bool keep = __all(pmax - m_reg <= THR / SCALE);
  mn = keep ? m_reg : fmaxf(m_reg, pmax); alpha = __builtin_amdgcn_exp2f((m_reg - mn) * C); m_reg = mn;
  const float mnC = -mn * C;
#pragma unroll
  for (int r = 0; r < 16; ++r) p0[r] = fmaf(p0[r], C, mnC);
  pv_one<2>(o[2], vb, pa0, pa1, pa2, pa3);
#pragma unroll
  for (int r = 0; r < 16; ++r) p1[r] = fmaf(p1[r], C, mnC);
#pragma unroll
  for (int r = 0; r < 8; ++r) p0[r] = __builtin_amdgcn_exp2f(p0[r]);
  pv_one<3>(o[3], vb, pa0, pa1, pa2, pa3);
#pragma unroll
  for (int r = 8; r < 16; ++r) p0[r] = __builtin_amdgcn_exp2f(p0[r]);
}
__device__ __forceinline__ void attn_unit(const bf16_t* Qb, const bf16_t* Kb, const bf16_t* Vh, bf16_t* Ob, int seq, char* lds, float* stash, float lam, const float* subln) {
  int tid_ = threadIdx.x; asm volatile("" : "+v"(tid_));
  const int tid = tid_, wid = tid >> 6, lane = tid & 63, r32 = lane & 31, hi = lane >> 5;
  char* V_lds = lds; char* K_lds = lds + 3 * SHM_V;
  float* ws = (float*)(lds + 3 * SHM_V + 3 * SHM_K) + wid * 64; float* li_l = ws; float* al_l = ws + 32;
  const int sr = tid >> 4, sc = (tid & 15) * 8, vst0 = v_st(sr, sc), vst1 = v_st(32 + sr, sc);
  const int kr = tid >> 3, kc = (tid & 7) * 8, kst = KSWZ(kr, kc * 2);
  const int vb0 = (int)(uintptr_t)V_lds + v_rd_base(lane);
  const int NT = seq / KVBLK;
  f32x16 o[4];
  u32x4* const sl = (u32x4*)(lds + 3 * SHM_V + 3 * SHM_K + NW * 64 * 4) + tid;
  for (int comp = 0; comp < 2; ++comp) {
    const bf16_t* Kh = Kb + comp * 64;
    float m_reg = -1e30f, l_reg = 0; bf16x8 qr[4];
#pragma unroll
    for (int d = 0; d < 4; ++d) o[d] = f32x16{};
    const bf16_t* Qw = Qb + comp * 64 + (long)(wid * QBLK + r32) * LD + hi * 8;
#pragma unroll
    for (int d0 = 0; d0 < 4; ++d0) qr[d0] = *reinterpret_cast<const bf16x8*>(Qw + d0 * 16);
    struct { bf16x8 vs0, vs1, ks0; } sr_[2];
#define SLOAD(i, k0) do { sr_[i].vs0 = *reinterpret_cast<const bf16x8*>(&Vh[(long)((k0) + sr) * LD + sc]); sr_[i].vs1 = *reinterpret_cast<const bf16x8*>(&Vh[(long)((k0) + 32 + sr) * LD + sc]); \
    sr_[i].ks0 = *reinterpret_cast<const bf16x8*>(&Kh[(long)((k0) + kr) * LD + kc]); } while (0)
#define SWRITE(b, i) do { *(bf16x8*)(V_lds + (b) * SHM_V + vst0) = sr_[i].vs0; *(bf16x8*)(V_lds + (b) * SHM_V + vst1) = sr_[i].vs1; \
    *(bf16x8*)(K_lds + (b) * SHM_K + kst) = sr_[i].ks0; } while (0)
#define SWAIT() asm volatile("s_waitcnt vmcnt(3)" ::: "memory")
#define RESC(a) do { if (__any((a) < 1.f)) { if (hi == 0) al_l[r32] = (a); asm volatile("s_waitcnt lgkmcnt(0)" ::: "memory"); \
    _Pragma("unroll") for (int d = 0; d < 4; ++d) _Pragma("unroll") for (int r = 0; r < 16; ++r) o[d][r] *= al_l[crow(r, hi)]; } } while (0)
    f32x16 pA0, pA1, pB0, pB1; float mnA, mnB, alA, alB; bf16x8 pa0, pa1, pa2, pa3;
    int bp = 0, bc = 1, bn = 2;
#define ROT3() do { const int t_ = bp; bp = bc; bc = bn; bn = t_; } while (0)
    SLOAD(0, 0); asm volatile("s_waitcnt vmcnt(0)" ::: "memory"); SWRITE(0, 0); __syncthreads();
    qkt(pA0, pA1, K_lds, qr, r32, hi); partialSM(pA0, pA1, m_reg, mnA, alA);
    SLOAD(1, KVBLK); if (2 < NT) SLOAD(0, 2 * KVBLK);
    SWAIT(); SWRITE(1, 1); __syncthreads();
    for (int j = 1; j + 1 < NT; j += 2) {
      SBAR(); qkt(pB0, pB1, K_lds + bc * SHM_K, qr, r32, hi);
      finishSM(pA0, pA1, alA, l_reg, pa0, pa1, pa2, pa3); SBAR();
      SLOAD(1, (j + 2) * KVBLK); SBAR();
      pv_sm(o, vb0 + bp * SHM_V, pa0, pa1, pa2, pa3, pB0, pB1, m_reg, mnB, alB);
      SWAIT(); SWRITE(bn, 0);
      RESC(alB); __syncthreads(); ROT3();
      SBAR(); qkt(pA0, pA1, K_lds + bc * SHM_K, qr, r32, hi);
      finishSM(pB0, pB1, alB, l_reg, pa0, pa1, pa2, pa3); SBAR();
      if (j + 3 < NT) SLOAD(0, (j + 3) * KVBLK); SBAR();
      pv_sm(o, vb0 + bp * SHM_V, pa0, pa1, pa2, pa3, pA0, pA1, m_reg, mnA, alA);
      SWAIT(); SWRITE(bn, 1);
      RESC(alA); __syncthreads(); ROT3();
    }
    SBAR(); qkt(pB0, pB1, K_lds + bc * SHM_K, qr, r32, hi);
    finishSM(pA0, pA1, alA, l_reg, pa0, pa1, pa2, pa3); SBAR();
    pv_sm(o, vb0 + bp * SHM_V, pa0, pa1, pa2, pa3, pB0, pB1, m_reg, mnB, alB);
    RESC(alB);
    finishSM(pB0, pB1, alB, l_reg, pa0, pa1, pa2, pa3); SBAR();
    pv_d0(o, vb0 + bc * SHM_V, pa0, pa1, pa2, pa3);
#undef ROT3
    if (hi == 0) li_l[r32] = l_reg; asm volatile("s_waitcnt lgkmcnt(0)" ::: "memory");
#pragma unroll
    for (int r = 0; r < 16; ++r) { const float rl = __builtin_amdgcn_rcpf(li_l[crow(r, hi)]);
#pragma unroll
      for (int d0 = 0; d0 < 4; ++d0) o[d0][r] *= rl; }
    if (comp == 0) {
#pragma unroll
      for (int d0 = 0; d0 < 4; ++d0)
#pragma unroll
        for (int hf = 0; hf < 2; ++hf) { u32x4 t; t.x = cvtpk(o[d0][8 * hf], o[d0][8 * hf + 1]); t.y = cvtpk(o[d0][8 * hf + 2], o[d0][8 * hf + 3]); t.z = cvtpk(o[d0][8 * hf + 4], o[d0][8 * hf + 5]); t.w = cvtpk(o[d0][8 * hf + 6], o[d0][8 * hf + 7]); sl[(d0 * 2 + hf) * 512] = t; } }
    __syncthreads();
#undef SLOAD
#undef SWRITE
#undef SWAIT
#undef RESC
  }
  {
    bf16_t* stg = (bf16_t*)(lds + wid * 8704);
    float sg[4];
#pragma unroll
    for (int d0 = 0; d0 < 4; ++d0) sg[d0] = subln[d0 * 32 + r32] * 0.8f;
#pragma unroll
    for (int hf = 0; hf < 2; ++hf) {
      u32x4 t0[4];
#pragma unroll
      for (int d0 = 0; d0 < 4; ++d0) t0[d0] = sl[(d0 * 2 + hf) * 512];
#pragma unroll
      for (int k = 0; k < 8; ++k) { const int r = 8 * hf + k; float v[4]; float q = 0.f;
#pragma unroll
        for (int d0 = 0; d0 < 4; ++d0) { const unsigned w0 = t0[d0][k >> 1];
          const float a = __uint_as_float((k & 1) ? (w0 & 0xffff0000u) : (w0 << 16));
          v[d0] = a - lam * o[d0][r]; q += v[d0] * v[d0]; }
        q = xl::sum32(q);
        const float rs = __builtin_amdgcn_rsqf(q * (1.0f / 128.0f) + 1e-6f); const int orow = crow(r, hi);
#pragma unroll
        for (int d0 = 0; d0 < 4; ++d0) { const float w = v[d0] * rs * sg[d0]; stg[orow * 136 + d0 * 32 + r32] = (bf16_t)(cvtpk(w, w) & 0xffffu); } }
      asm volatile("" ::: "memory");
    }
    asm volatile("s_waitcnt lgkmcnt(0)" ::: "memory");
    bf16_t* Og = Ob + (long)(wid * QBLK) * LD;
#pragma unroll
    for (int i = 0; i < 8; ++i) { const int row = i * 4 + (lane >> 4), ch = lane & 15; const u32x4 t = *(const u32x4*)((const char*)stg + row * 272 + ch * 16); *(u32x4*)(Og + (long)row * LD + ch * 8) = t; }
  }
  __syncthreads();
}
#undef SBAR
#undef KSWZ
}

namespace ct {
using att::bf16x8; using att::f32x16; using att::bf16_t;
template <int MB> __device__ __forceinline__ void unit(const bf16_t* Amat, int K, const bf16_t* src, int P, long sA, long sB, bf16_t* dst, int Q, long sC, long sD, float scale, char* lds) {
  constexpr int NCH = 8 / MB;
  int tid_ = threadIdx.x; asm volatile("" : "+v"(tid_));
  const int tid = tid_, wid = tid >> 6, lane = tid & 63, r32 = lane & 31, hi = lane >> 5;
  const int rb = wid % MB, cc = wid / MB;
  const int sr = tid >> 4, sc = (tid & 15) * 8, vst0 = att::v_st(sr, sc), vst1 = att::v_st(32 + sr, sc);
  const int vb = (int)(uintptr_t)lds + cc * 16384 + att::v_rd_base(lane);
  const int NKT = K >> 6;
#pragma unroll 1
  for (int cs = 0; cs < 4 / NCH; ++cs) {
    f32x16 o[4] = {};
#pragma unroll 1
    for (int kt = 0; kt < NKT; ++kt) {
      const int k0 = kt * 64 + sr, k1 = k0 + 32;
      const bf16_t* r0 = src + (long)(k0 % P) * sA + (long)(k0 / P) * sB + cs * NCH * 128 + sc;
      const bf16_t* r1 = src + (long)(k1 % P) * sA + (long)(k1 / P) * sB + cs * NCH * 128 + sc;
      bf16x8 t0[NCH], t1[NCH];
#pragma unroll
      for (int ch = 0; ch < NCH; ++ch) { t0[ch] = *reinterpret_cast<const bf16x8*>(r0 + ch * 128); t1[ch] = *reinterpret_cast<const bf16x8*>(r1 + ch * 128); }
      const bf16_t* ap = Amat + (long)(rb * 32 + r32) * K + kt * 64 + hi * 8;
      const bf16x8 pa0 = *reinterpret_cast<const bf16x8*>(ap), pa1 = *reinterpret_cast<const bf16x8*>(ap + 16), pa2 = *reinterpret_cast<const bf16x8*>(ap + 32), pa3 = *reinterpret_cast<const bf16x8*>(ap + 48);
      __syncthreads();
#pragma unroll
      for (int ch = 0; ch < NCH; ++ch) { *(bf16x8*)(lds + ch * 16384 + vst0) = t0[ch]; *(bf16x8*)(lds + ch * 16384 + vst1) = t1[ch]; }
      __syncthreads();
      att::pv_d0(o, vb, pa0, pa1, pa2, pa3);
    }
    bf16_t* stg = (bf16_t*)(lds + 65536 + wid * 8704);
#pragma unroll
    for (int r = 0; r < 16; ++r) { const int orow = att::crow(r, hi);
#pragma unroll
      for (int d0 = 0; d0 < 4; ++d0) { const __bf16 hb = (__bf16)(o[d0][r] * scale); stg[orow * 136 + d0 * 32 + r32] = __builtin_bit_cast(bf16_t, hb); } }
    asm volatile("s_waitcnt lgkmcnt(0)" ::: "memory");
#pragma unroll
    for (int i = 0; i < 8; ++i) { const int row = i * 4 + (lane >> 4), ch = lane & 15, m = rb * 32 + row;
      const att::u32x4 t = *(const att::u32x4*)((const char*)stg + row * 272 + ch * 16);
      *(att::u32x4*)(dst + (long)(m % Q) * sC + (long)(m / Q) * sD + (cs * NCH + cc) * 128 + ch * 8) = t; }
    asm volatile("s_waitcnt lgkmcnt(0)" ::: "memory");
  }
  __syncthreads();
}
}
#define LAS __attribute__((address_space(3)))
typedef unsigned short bf16;
typedef unsigned v4u __attribute__((ext_vector_type(4)));
typedef float f32x4 __attribute__((ext_vector_type(4)));
constexpr int NWAVES = 8;
constexpr int T = 81920, TP = 65536, D = 1024, FF = 4096, PLE = 256, INW = 5632;
constexpr float EPS = 1e-6f;
constexpr size_t MiB = 1u << 20;
constexpr size_t WS_ROPE = 1 * MiB;
constexpr size_t WS_WF2 = 2 * MiB, WS_WQKV = 4 * MiB, WS_WG = 10 * MiB, WS_WF = 14 * MiB, WS_WA = 15 * MiB, WS_WO = 17 * MiB, WS_WUP = 19 * MiB, WS_WDN = 27 * MiB, WS_WPLE = 35 * MiB, WS_WGATE = 36 * MiB;
constexpr size_t WS_A1S = 42 * MiB, WS_A1P = 46 * MiB, WS_A2S = 47 * MiB, WS_A2P = 47 * MiB + 512 * 1024;
constexpr size_t WS_UC = 544 * MiB;
constexpr size_t WS_SS = 58 * MiB;
constexpr size_t WS_XH = 64 * MiB;
constexpr size_t WS_GT = 224 * MiB;
constexpr size_t WS_Q = 384 * MiB, WS_K = 544 * MiB, WS_V = 704 * MiB;
constexpr size_t WS_F = 864 * MiB;
constexpr size_t WS_STASH = 944 * MiB;
constexpr size_t WS_U = 384 * MiB;
constexpr size_t WS_PB = 384 * MiB;
constexpr size_t WS_EP = 424 * MiB, WS_E = 584 * MiB;
constexpr int LDS_BYTES = 147456;

#define XB_TMO      128
#define XB_XCNT(j)  (256  + 64 * (j))
#define XB_XSUB(j)  (1280 + 64 * (j))
#define XB_XGEN(j)  (2304 + 64 * (j))
#define XB_TOP      3328
#define XB_TOPGEN   3392
#define XCD_BAR_WORDS 3456
#define XB_SPIN_CAP (1u << 18)

__device__ __forceinline__ unsigned xb_ld(unsigned* p)              { return __hip_atomic_load(p, __ATOMIC_RELAXED, __HIP_MEMORY_SCOPE_AGENT); }
__device__ __forceinline__ unsigned xb_add(unsigned* p, unsigned v) { return __hip_atomic_fetch_add(p, v, __ATOMIC_RELAXED, __HIP_MEMORY_SCOPE_AGENT); }
__device__ __forceinline__ unsigned xb_xcc_id() { return (unsigned)__builtin_amdgcn_s_getreg((3 << 11) | 20) & 0xFu; }
#define XB_SPIN(cond, bar) do { unsigned _sp = 0; while (cond) { __builtin_amdgcn_s_sleep(1); \
    if ((++_sp & 255u) == 0u) { if (xb_ld(&(bar)[XB_TMO])) break; if (_sp > XB_SPIN_CAP) { atomicAdd(&(bar)[XB_TMO], 1u); break; } } } } while (0)

struct XcdBarrier {
    unsigned* bar; unsigned x;
    volatile LAS unsigned* st;
};

__device__ __forceinline__ XcdBarrier xcd_barrier_post(unsigned* bar, volatile LAS unsigned* st) {
    XcdBarrier b; b.bar = bar; b.x = xb_xcc_id(); b.st = st;
    if (threadIdx.x == 0) (void)xb_add(&bar[XB_XCNT(b.x)], 1u);
    return b;
}
__device__ __forceinline__ void xcd_barrier_complete(unsigned* bar, unsigned x, unsigned& nloc, unsigned& nx) {
    const unsigned G = gridDim.x * gridDim.y * gridDim.z;
    unsigned sum, cnt, mine, sp = 0u;
    for (;;) {
        sum = 0u; cnt = 0u; mine = 0u;
#pragma unroll
        for (unsigned j = 0; j < 16; ++j) { const unsigned c = xb_ld(&bar[XB_XCNT(j)]); sum += c; cnt += (c > 0u) ? 1u : 0u; mine = (j == x) ? c : mine; }
        if (sum == G) break;
        __builtin_amdgcn_s_sleep(1);
        if ((++sp & 255u) == 0u) { if (xb_ld(&bar[XB_TMO])) break; if (sp > XB_SPIN_CAP) { atomicAdd(&bar[XB_TMO], 1u); break; } }
    }
    nloc = mine > 0u ? mine : 1u; nx = cnt > 0u ? cnt : 1u;
}

__device__ __forceinline__ void xcd_barrier(const XcdBarrier& b) {
    asm volatile("s_waitcnt vmcnt(0)" ::: "memory");
    __syncthreads();
    if (threadIdx.x == 0) {
        unsigned* bar = b.bar;
        __builtin_amdgcn_s_waitcnt(0);
        unsigned nloc = b.st[0], nx = b.st[1];
        if (nloc == 0u) { xcd_barrier_complete(bar, b.x, nloc, nx); b.st[0] = nloc; b.st[1] = nx; }
        const unsigned old = xb_add(&bar[XB_XSUB(b.x)], 1u);
        const unsigned gen = old / nloc;
        if (old + 1u == (gen + 1u) * nloc) {
            __builtin_amdgcn_fence(__ATOMIC_RELEASE, "agent");
            asm volatile("s_waitcnt vmcnt(0)" ::: "memory");
            const unsigned og = xb_add(&bar[XB_TOP], 1u);
            const unsigned tg = og / nx;
            if (og + 1u == (tg + 1u) * nx) xb_add(&bar[XB_TOPGEN], 1u);
            else XB_SPIN(xb_ld(&bar[XB_TOPGEN]) == tg, bar);
            __builtin_amdgcn_fence(__ATOMIC_ACQUIRE, "agent");
            xb_add(&bar[XB_XGEN(b.x)], 1u);
            asm volatile("s_waitcnt vmcnt(0)" ::: "memory");
        } else {
            XB_SPIN(xb_ld(&bar[XB_XGEN(b.x)]) == gen, bar);
            __builtin_amdgcn_fence(__ATOMIC_ACQUIRE, "agent");
            asm volatile("s_waitcnt vmcnt(0)" ::: "memory");
        }
    }
    __syncthreads();
}

struct Args { const float* in[22]; float* out; unsigned char* ws; int ph_lo, ph_hi; };

__device__ __forceinline__ float wave_sum(float v) { return xl::sum64(v); }
__device__ __forceinline__ unsigned pk2(float lo, float hi) { return pg8::cvt_pk_bf16(lo, hi); }
__device__ __forceinline__ void p0_transpose_item(const float* W, int ldw, int col0, int K, int N, const float* gain, bf16* WT, LAS float* scr, int item, int lane) {
    const int nblk = N / 32, kb = item / nblk, nb = item % nblk, k0 = 64 * kb, n0 = 32 * nb;
#pragma unroll 8
    for (int i = 0; i < 32; ++i) { const int kk = 2 * i + (lane >> 5); const float g = gain ? gain[k0 + kk] : 1.f; scr[kk * 33 + (lane & 31)] = W[(size_t)(k0 + kk) * ldw + col0 + n0 + (lane & 31)] * g; }
    asm volatile("s_waitcnt lgkmcnt(0)" ::: "memory");
    const int c = lane & 7;
#pragma unroll
    for (int j = 0; j < 4; ++j) { const int n = (lane >> 3) + 8 * j; const LAS float* s = scr + (8 * c) * 33 + n;
        v4u o; o.x = pk2(s[0 * 33], s[1 * 33]); o.y = pk2(s[2 * 33], s[3 * 33]); o.z = pk2(s[4 * 33], s[5 * 33]); o.w = pk2(s[6 * 33], s[7 * 33]);
        *(v4u*)(WT + (size_t)(n0 + n) * K + k0 + 8 * c) = o; }
    asm volatile("s_waitcnt lgkmcnt(0)" ::: "memory");
}
__device__ __forceinline__ const float* xrow(const Args& a, int m) { return m < TP ? a.in[0] + (size_t)m * D : a.in[1] + (size_t)(m - TP) * D; }

__global__ void __launch_bounds__(NWAVES * 64, 2) fwd_mega(Args args) {
    extern __shared__ __attribute__((aligned(16))) unsigned char lds[];
    cg::grid_group grid = cg::this_grid();
#define IN(k) (args.ph_lo <= (k) && (k) < args.ph_hi)
    volatile LAS unsigned* xst = (volatile LAS unsigned*)((LAS unsigned char*)lds + (LDS_BYTES - 16));
    if (threadIdx.x == 0) { xst[0] = 0u; xst[1] = 0u; }
    __syncthreads();
    const XcdBarrier xbar = xcd_barrier_post((unsigned*)args.ws, xst);
#define GSYNC() xcd_barrier(xbar)
    const int tid = threadIdx.x, lane = tid & 63, wave = __builtin_amdgcn_readfirstlane(tid >> 6);
    const int G = gridDim.x, bx = blockIdx.x; const int vcu = (G % 8 == 0) ? (bx % 8) * (G / 8) + bx / 8 : bx;
    unsigned char* ws = args.ws;
    LAS unsigned char* ldsl = (LAS unsigned char*)lds;
#define WF2 ((bf16*)(ws + WS_WF2))
#define WQKV ((bf16*)(ws + WS_WQKV))
#define WG ((bf16*)(ws + WS_WG))
#define WF ((bf16*)(ws + WS_WF))
#define WA ((bf16*)(ws + WS_WA))
#define WO ((bf16*)(ws + WS_WO))
#define WUP ((bf16*)(ws + WS_WUP))
#define WDN ((bf16*)(ws + WS_WDN))
#define WPLE ((bf16*)(ws + WS_WPLE))
#define WGATE ((bf16*)(ws + WS_WGATE))
#define ROPE ((float*)(ws + WS_ROPE))
#define UC ((bf16*)(ws + WS_UC))
#define SS ((float*)(ws + WS_SS))
#define XH ((bf16*)(ws + WS_XH))
#define GT ((bf16*)(ws + WS_GT))
#define QB ((bf16*)(ws + WS_Q))
#define KB ((bf16*)args.out)
#define VB ((bf16*)args.out + (size_t)T * D)
#define FB ((bf16*)(ws + WS_F))
    const int gw = vcu * NWAVES + wave, NGW = G * NWAVES;
    const int gtid = bx * (NWAVES * 64) + tid, NGT = G * NWAVES * 64;

    using pg8::Gemm; using pg8::StaticOrder; using pg8::EpiGen; using pg8::ListOrder;
    LAS unsigned char* ring = ldsl;
    if (IN(0)) {
    {
        LAS float* scr = (LAS float*)(ldsl + wave * 16384);
        const float* w_in = args.in[5];
        constexpr int I_QKV = 16 * 96, I_G = 16 * 64, I_F = 8 * 32, I_A = 16 * 32, I_O = 16 * 32, I_UP = 16 * 128, I_DN = 64 * 32, I_PLE = 4 * 32, I_GATE = 16 * 32;
        constexpr int NITEMS = I_QKV + I_G + I_F + I_A + I_O + I_UP + I_DN + I_PLE + I_GATE;
        for (int it = gw; it < NITEMS; it += NGW) {
            int r = it;
            if (r < I_QKV) { p0_transpose_item(w_in, INW, 512, D, 3072, args.in[4], WQKV, scr, r, lane); continue; } r -= I_QKV;
            if (r < I_G) { p0_transpose_item(w_in, INW, 3584, D, 2048, args.in[4], WG, scr, r, lane); continue; } r -= I_G;
            if (r < I_F) { p0_transpose_item(args.in[6], D, 0, 512, D, nullptr, WF, scr, r, lane); continue; } r -= I_F;
            if (r < I_A) { p0_transpose_item(args.in[7], D, 0, D, D, nullptr, WA, scr, r, lane); continue; } r -= I_A;
            if (r < I_O) { p0_transpose_item(args.in[8], D, 0, D, D, nullptr, WO, scr, r, lane); continue; } r -= I_O;
            if (r < I_UP) { p0_transpose_item(args.in[16], FF, 0, D, FF, args.in[15], WUP, scr, r, lane); continue; } r -= I_UP;
            if (r < I_DN) { p0_transpose_item(args.in[17], D, 0, FF, D, nullptr, WDN, scr, r, lane); continue; } r -= I_DN;
            if (r < I_PLE) { p0_transpose_item(args.in[19], D, 0, PLE, D, nullptr, WPLE, scr, r, lane); continue; } r -= I_PLE;
            p0_transpose_item(args.in[20], D, 0, D, D, nullptr, WGATE, scr, r, lane);
        }
        __syncthreads();
        {
            LAS float* Wt = (LAS float*)ldsl;
            LAS float* ctab = (LAS float*)(ldsl + 8192);
            for (int item = bx; item < 256; item += G) {
                const int grp = item >> 6, k0 = (item & 63) * 16;
                for (int e = tid; e < 2048; e += NWAVES * 64) { const int kk = e >> 7, c = e & 127; Wt[c * 16 + kk] = w_in[(size_t)(k0 + kk) * INW + grp * 128 + c] * args.in[4][k0 + kk]; }
                if (tid < 128) ctab[tid] = __builtin_amdgcn_cosf((float)tid * (1.0f / 128.0f));
                __syncthreads();
                const int m = tid & 127, comp = (tid >> 7) & 1, kh = tid >> 8;
                float acc[8];
#pragma unroll
                for (int i = 0; i < 8; ++i) acc[i] = 0.f;
                for (int c = 0; c < 128; ++c) { const float t = ctab[(c * m + (comp ? 96 : 0)) & 127]; const LAS f32x4* wp = (const LAS f32x4*)(Wt + c * 16 + kh * 8); const f32x4 w0 = wp[0], w1 = wp[1];
#pragma unroll
                    for (int i = 0; i < 4; ++i) { acc[i] += w0[i] * t; acc[4 + i] += w1[i] * t; } }
                v4u o; o.x = pk2(acc[0], acc[1]); o.y = pk2(acc[2], acc[3]); o.z = pk2(acc[4], acc[5]); o.w = pk2(acc[6], acc[7]);
                *(v4u*)(WF2 + (size_t)(comp * 512 + grp * 128 + m) * D + k0 + kh * 8) = o;
                __syncthreads();
            }
        }
        { bf16* A1S = (bf16*)(ws + WS_A1S); bf16* A1P = (bf16*)(ws + WS_A1P); bf16* A2S = (bf16*)(ws + WS_A2S); bf16* A2P = (bf16*)(ws + WS_A2P);
          for (int it = gtid; it < 128 * 128 * 128; it += NGT) { const int k = it & 127, m = (it >> 7) & 127, s2 = it >> 14; const int ri = m >> 6, k1 = m & 63, comp = k >> 6, s1 = k & 63;
              const float fr = (float)((k1 * (128 * s1 + s2)) & 8191) * (1.0f / 8192.0f); const float c = __builtin_amdgcn_cosf(fr), s = __builtin_amdgcn_sinf(fr);
              const float v = ri == 0 ? (comp == 0 ? c : -s) : (comp == 0 ? -s : -c); A1S[it] = (bf16)(pk2(v, v) & 0xffffu); }
          for (int it = gtid; it < 64 * 64 * 64; it += NGT) { const int k = it & 63, m = (it >> 6) & 63, s2 = it >> 12; const int ri = m >> 5, k1 = m & 31, comp = k >> 5, s1 = k & 31;
              const float fr = (float)((k1 * (64 * s1 + s2)) & 2047) * (1.0f / 2048.0f); const float c = __builtin_amdgcn_cosf(fr), s = __builtin_amdgcn_sinf(fr);
              const float v = ri == 0 ? (comp == 0 ? c : -s) : (comp == 0 ? -s : -c); A1P[it] = (bf16)(pk2(v, v) & 0xffffu); }
          for (int it = gtid; it < 128 * 256; it += NGT) { const int k = it & 255, k2 = it >> 8; const int ri = k >> 7, s2 = k & 127;
              const float fr = (float)((k2 * s2) & 127) * (1.0f / 128.0f); const float v = ri == 0 ? __builtin_amdgcn_cosf(fr) : __builtin_amdgcn_sinf(fr); A2S[it] = (bf16)(pk2(v, v) & 0xffffu); }
          for (int it = gtid; it < 64 * 128; it += NGT) { const int k = it & 127, k2 = it >> 7; const int ri = k >> 6, s2 = k & 63;
              const float fr = (float)((k2 * s2) & 63) * (1.0f / 64.0f); const float v = ri == 0 ? __builtin_amdgcn_cosf(fr) : __builtin_amdgcn_sinf(fr); A2P[it] = (bf16)(pk2(v, v) & 0xffffu); }
        }
        if (gtid < 65536) { const int pos = gtid >> 3, i = gtid & 7;
            const double ifr[8] = {0.15915494309189535, 0.03086376340470123, 0.005985185712713705, 0.001160663641240061, 0.00022507907903927653, 4.364795279280289e-05, 8.464330808241401e-06, 1.6414262627950345e-06};
            double rev = (double)pos * (i == 0 ? ifr[0] : i == 1 ? ifr[1] : i == 2 ? ifr[2] : i == 3 ? ifr[3] : i == 4 ? ifr[4] : i == 5 ? ifr[5] : i == 6 ? ifr[6] : ifr[7]);
            rev -= (double)(long long)rev; const float fr = (float)rev;
            ROPE[pos * 16 + i] = __builtin_amdgcn_cosf(fr); ROPE[pos * 16 + 8 + i] = __builtin_amdgcn_sinf(fr); }
        for (int m = gw; m < T; m += NGW) { const f32x4* xr = (const f32x4*)xrow(args, m) + lane; f32x4 v[4]; float s = 0.f;
#pragma unroll
            for (int j = 0; j < 4; ++j) { v[j] = xr[64 * j]; s += (v[j].x * v[j].x + v[j].y * v[j].y) + (v[j].z * v[j].z + v[j].w * v[j].w); }
            const float ms = wave_sum(s) * (1.f / D) + EPS; const float rs = __builtin_amdgcn_rsqf(ms);
            if (lane == 0) ((float*)(ws + 63 * MiB))[m] = ms * rs;
            unsigned long long* o8 = (unsigned long long*)(XH + (size_t)m * D) + lane;
#pragma unroll
            for (int j = 0; j < 4; ++j) o8[64 * j] = (unsigned long long)pk2(v[j].x * rs, v[j].y * rs) | ((unsigned long long)pk2(v[j].z * rs, v[j].w * rs) << 32); }
    }
    if (IN(0) && IN(1)) { asm volatile("s_waitcnt vmcnt(0)" ::: "memory"); grid.sync(); }

    }

    if (IN(1)) {
    {
        Gemm g{XH, WF2, T, 4096, D}; StaticOrder S; S.init(T, 4096, G, bx); pg8::EpiQKV E{GT, QB, KB, (size_t)T * D, ROPE};
        pg8::gemm_phase<pg8::EpiQKV, StaticOrder, true, true>(ring, g, S, E);
    }
    if (IN(1) && IN(2)) GSYNC();

    }
#define GF GT
#define GA ((bf16*)(ws + WS_V))
#define Y1 ((bf16*)(ws + WS_UC))
#define MG ((bf16*)args.out)
#define ATT QB
    if (IN(2)) {
    {
        float lam;
        { const float a = wave_sum(args.in[9][lane] * args.in[10][lane]), b = wave_sum(args.in[11][lane] * args.in[12][lane]); lam = __expf(a) - __expf(b) + 0.2f; }
        float* stash = (float*)(ws + WS_STASH) + (size_t)bx * 32768;
        const int NCU = G;
        const int ppc = (2048 + NCU - 1) / NCU, spc = (512 + NCU - 1) / NCU;
#ifdef DBG_ATT2
        for (int pass2 = 0; pass2 < 2; ++pass2)
#else
        const int pass2 = 1;
#endif
        for (int i = 0; i < ppc + spc; ++i) { const bool smp = i >= ppc; int bh, qb;
            if (NCU == 256) { if (smp) { bh = (vcu >> 5) + 8 * (i - ppc); qb = vcu & 31; } else { bh = (vcu >> 3) + 32 * i; qb = vcu & 7; } }
            else { const int ui = smp ? vcu * spc + (i - ppc) : vcu * ppc + i; if (ui >= (smp ? 512 : 2048)) continue; const int lq = smp ? 5 : 3; bh = ui >> lq; qb = ui & ((1 << lq) - 1); }
            const int b = bh >> 3, h = bh & 7; const int seq = smp ? 8192 : 2048;
            const size_t r0 = (smp ? (size_t)TP : 0) + (size_t)b * seq; const size_t qo = (r0 + qb * 256) * D + h * 128, ko = r0 * D + h * 128;
            att::attn_unit(QB + qo, KB + ko, VB + ko, (pass2 ? QB : UC) + qo, seq, (char*)lds, stash, lam, args.in[13]); }
        __syncthreads();
        { const bf16* A1S = (const bf16*)(ws + WS_A1S); const bf16* A1P = (const bf16*)(ws + WS_A1P); bf16* US = UC + (size_t)131072 * 512;
          for (int ui = vcu; ui < 256 + 2048; ui += NCU) {
            if (ui < 256) { const int b = ui >> 7, s2 = ui & 127;
                ct::unit<4>(A1S + (size_t)s2 * 128 * 128, 128, GT + ((size_t)TP + (size_t)b * 8192 + s2) * 1024, 64, 128L * 1024, 512L, US + ((size_t)b * 64 * 2 * 128 + s2) * 512, 64, 2L * 128 * 512, 128L * 512, 1.0f, (char*)lds); }
            else { const int up = ui - 256, b = up >> 6, s2 = up & 63;
                ct::unit<2>(A1P + (size_t)s2 * 64 * 64, 64, GT + ((size_t)b * 2048 + s2) * 1024, 32, 64L * 1024, 512L, UC + ((size_t)b * 32 * 2 * 64 + s2) * 512, 32, 2L * 64 * 512, 64L * 512, 1.0f, (char*)lds); }
          } }
    }
    if (IN(2) && IN(3)) GSYNC();

    }

    if (IN(3)) {
    {
        const bf16* A2S = (const bf16*)(ws + WS_A2S); const bf16* A2P = (const bf16*)(ws + WS_A2P); const bf16* US = UC + (size_t)131072 * 512;
        for (int ui = vcu; ui < 128 + 1024; ui += G) {
            if (ui < 128) { const int b = ui >> 6, k1 = ui & 63;
                ct::unit<4>(A2S, 256, US + ((size_t)(b * 64 + k1) * 2 * 128) * 512, 256, 512L, 0L, FB + ((size_t)TP + (size_t)b * 8192 + k1) * 512, 128, 64L * 512, 0L, 1.0f / 1024.0f, (char*)lds); }
            else { const int up = ui - 128, b = up >> 5, k1 = up & 31;
                ct::unit<2>(A2P, 128, UC + ((size_t)(b * 32 + k1) * 2 * 64) * 512, 128, 512L, 0L, FB + ((size_t)b * 2048 + k1) * 512, 64, 32L * 512, 0L, 1.0f / 512.0f, (char*)lds); }
        }
    }
    {
        Gemm g{XH, WG, T, 2048, D}; StaticOrder S; S.init(T, 2048, G, bx); EpiGen<1> E{GF, D, nullptr, nullptr, nullptr, 1.f, (size_t)(WS_V - WS_GT) / 2};
        pg8::gemm_phase<EpiGen<1>, StaticOrder, true, true>(ring, g, S, E);
    }
    if (IN(3) && IN(4)) GSYNC();

    }

    if (IN(4)) {
    {
        Gemm g{FB, WF, T, D, 512}; StaticOrder S; S.init(T, D, G, bx); EpiGen<2> E{Y1, D, GF, nullptr, nullptr, 1.f, 0};
        pg8::gemm_phase<EpiGen<2>, StaticOrder, true, true>(ring, g, S, E);
    }

    }

    if (IN(5)) {
    {
        Gemm g{ATT, WA, T, D, D}; StaticOrder S; S.init(T, D, G, bx); EpiGen<3> E{MG, D, Y1, GA, nullptr, 1.f, 0};
        pg8::gemm_phase<EpiGen<3>, StaticOrder, true, true>(ring, g, S, E);
    }
    if (IN(5) && IN(6)) GSYNC();

    }
#define Z XH
#define Z4 UC
    if (IN(6)) {
    {
        Gemm g{MG, WO, T, D, D}; StaticOrder S; S.init(T, D, G, bx); EpiGen<4> E{Z4, D, nullptr, nullptr, SS, 1.f, 0};
        pg8::gemm_phase<EpiGen<4>, StaticOrder, true, true>(ring, g, S, E);
    }
    if (IN(6) && IN(7)) GSYNC();

    }
#define H2 GT
    if (IN(7)) {
    { int ln_ = threadIdx.x; asm volatile("" : "+v"(ln_)); const int lane = ln_ & 63;
    for (int m = gw; m < T; m += NGW) {
        const float* sp = SS + (size_t)m * 16; float s = (lane < 16) ? sp[lane] : 0.f; const float rs = __builtin_amdgcn_rsqf(wave_sum(s) * (1.f / D) + EPS);
        const unsigned long long* xr = (const unsigned long long*)(XH + (size_t)m * D) + lane; const float xs = ((const float*)(ws + 63 * MiB))[m]; const unsigned long long* zr = (const unsigned long long*)(Z4 + (size_t)m * D) + lane; const f32x4* gr = (const f32x4*)args.in[14] + lane;
        f32x4 v[4]; float s2 = 0.f;
#pragma unroll
        for (int j = 0; j < 4; ++j) { const unsigned long long zz = zr[64 * j]; const f32x4 gg = gr[64 * j]; const unsigned long long xq = xr[64 * j];
            f32x4 xx; xx.x = __uint_as_float((unsigned)xq << 16) * xs; xx.y = __uint_as_float((unsigned)xq & 0xffff0000u) * xs; xx.z = __uint_as_float((unsigned)(xq >> 32) << 16) * xs; xx.w = __uint_as_float((unsigned)(xq >> 32) & 0xffff0000u) * xs;
            f32x4 z; z.x = __uint_as_float((unsigned)zz << 16); z.y = __uint_as_float((unsigned)zz & 0xffff0000u); z.z = __uint_as_float((unsigned)(zz >> 32) << 16); z.w = __uint_as_float((unsigned)(zz >> 32) & 0xffff0000u);
            v[j] = xx + z * rs * gg; s2 += (v[j].x * v[j].x + v[j].y * v[j].y) + (v[j].z * v[j].z + v[j].w * v[j].w); }
        const float rs2 = __builtin_amdgcn_rsqf(wave_sum(s2) * (1.f / D) + EPS);
        unsigned long long* x8 = (unsigned long long*)((bf16*)args.out + (size_t)m * D) + lane; unsigned long long* h8 = (unsigned long long*)(H2 + (size_t)m * D) + lane;
#pragma unroll
        for (int j = 0; j < 4; ++j) { x8[64 * j] = (unsigned long long)pk2(v[j].x, v[j].y) | ((unsigned long long)pk2(v[j].z, v[j].w) << 32); h8[64 * j] = (unsigned long long)pk2(v[j].x * rs2, v[j].y * rs2) | ((unsigned long long)pk2(v[j].z * rs2, v[j].w * rs2) << 32); }
    }
    }
    if (IN(7) && IN(8)) GSYNC();

    }
#define U ((bf16*)(ws + WS_U))
    if (IN(8)) {
    {
        Gemm g{H2, WUP, T, FF, D}; StaticOrder S; S.init(T, FF, G, bx); EpiGen<5> E{U, FF, nullptr, nullptr, nullptr, 1.f, 0};
        pg8::gemm_phase<EpiGen<5>, StaticOrder, true, true>(ring, g, S, E);
    }
    if (IN(8) && IN(9)) GSYNC();

    }

    if (IN(9)) {
    {
        Gemm g{U, WDN, T, D, FF}; StaticOrder S; S.init(T, D, G, bx); EpiGen<4> E{Z, D, nullptr, nullptr, SS, 1.f, 0};
        pg8::gemm_phase<EpiGen<4>, StaticOrder, true, true>(ring, g, S, E);
    }
    if (IN(9) && IN(10)) GSYNC();

    }
#define X2B GT
#define PB ((bf16*)(ws + WS_PB))
    if (IN(10)) {
    { int ln_ = threadIdx.x; asm volatile("" : "+v"(ln_)); const int lane = ln_ & 63;
    for (int m = gw; m < T; m += NGW) {
        const float* sp = SS + (size_t)m * 16; float s = (lane < 16) ? sp[lane] : 0.f; const float rs = __builtin_amdgcn_rsqf(wave_sum(s) * (1.f / D) + EPS);
        const unsigned long long* x8 = (const unsigned long long*)((const bf16*)args.out + (size_t)m * D) + lane; const unsigned long long* zr = (const unsigned long long*)(Z + (size_t)m * D) + lane; const f32x4* gr = (const f32x4*)args.in[18] + lane;
        unsigned long long* h8 = (unsigned long long*)(X2B + (size_t)m * D) + lane;
#pragma unroll
        for (int j = 0; j < 4; ++j) { const unsigned long long zz = zr[64 * j]; const f32x4 gg = gr[64 * j]; const unsigned long long xb = x8[64 * j]; f32x4 xx; xx.x = __uint_as_float((unsigned)xb << 16); xx.y = __uint_as_float((unsigned)xb & 0xffff0000u); xx.z = __uint_as_float((unsigned)(xb >> 32) << 16); xx.w = __uint_as_float((unsigned)(xb >> 32) & 0xffff0000u);
            f32x4 z; z.x = __uint_as_float((unsigned)zz << 16); z.y = __uint_as_float((unsigned)zz & 0xffff0000u); z.z = __uint_as_float((unsigned)(zz >> 32) << 16); z.w = __uint_as_float((unsigned)(zz >> 32) & 0xffff0000u);
            const f32x4 v = xx + z * rs * gg; h8[64 * j] = (unsigned long long)pk2(v.x, v.y) | ((unsigned long long)pk2(v.z, v.w) << 32); }
        const float* prow = m < TP ? args.in[2] + (size_t)m * PLE : args.in[3] + (size_t)(m - TP) * PLE;
        const f32x4 pv = ((const f32x4*)prow)[lane];
        ((unsigned long long*)(PB + (size_t)m * PLE))[lane] = (unsigned long long)pk2(pv.x, pv.y) | ((unsigned long long)pk2(pv.z, pv.w) << 32);
    }
    }
    if (IN(10) && IN(11)) GSYNC();

    }
#define EP ((bf16*)(ws + WS_EP))
#define EB ((bf16*)(ws + WS_E))
    if (IN(11)) {
    {
        Gemm g{PB, WPLE, T, D, PLE}; StaticOrder S; S.init(T, D, G, bx); EpiGen<0> E{EP, D, nullptr, nullptr, nullptr, 1.f, 0};
        pg8::gemm_phase<EpiGen<0>, StaticOrder, true, true>(ring, g, S, E);
    }

    }

    if (IN(12)) {
    {
        Gemm g{X2B, WGATE, T, D, D}; StaticOrder S; S.init(T, D, G, bx); EpiGen<6> E{EB, D, EP, nullptr, SS, 1.f, 0};
        pg8::gemm_phase<EpiGen<6>, StaticOrder, true, true>(ring, g, S, E);
    }
    if (IN(12) && IN(13)) GSYNC();

    }

    if (IN(13)) {
    { int ln_ = threadIdx.x; asm volatile("" : "+v"(ln_)); const int lane = ln_ & 63;
    for (int m = gw; m < T; m += NGW) {
        const float* sp = SS + (size_t)m * 16; float s = (lane < 16) ? sp[lane] : 0.f; const float rs = __builtin_amdgcn_rsqf(wave_sum(s) * (1.f / D) + EPS);
        f32x4* orow = (f32x4*)(args.out + (size_t)m * D) + lane; const unsigned long long* x8 = (const unsigned long long*)(X2B + (size_t)m * D) + lane; const unsigned long long* zr = (const unsigned long long*)(EB + (size_t)m * D) + lane; const f32x4* gr = (const f32x4*)args.in[21] + lane;
#pragma unroll
        for (int j = 0; j < 4; ++j) { const unsigned long long zz = zr[64 * j]; const f32x4 gg = gr[64 * j]; const unsigned long long xb = x8[64 * j]; f32x4 xx; xx.x = __uint_as_float((unsigned)xb << 16); xx.y = __uint_as_float((unsigned)xb & 0xffff0000u); xx.z = __uint_as_float((unsigned)(xb >> 32) << 16); xx.w = __uint_as_float((unsigned)(xb >> 32) & 0xffff0000u);
            f32x4 z; z.x = __uint_as_float((unsigned)zz << 16); z.y = __uint_as_float((unsigned)zz & 0xffff0000u); z.z = __uint_as_float((unsigned)(zz >> 32) << 16); z.w = __uint_as_float((unsigned)(zz >> 32) & 0xffff0000u);
            orow[64 * j] = xx + z * rs * gg; }
    }
    }
    }

}


__global__ void __launch_bounds__(256) ck_kernel(const unsigned* buf, size_t nwords, unsigned* cs, int rep, unsigned* flag) {
    const size_t per = (nwords + gridDim.x - 1) / gridDim.x; const size_t lo = (size_t)blockIdx.x * per; size_t hi = lo + per; if (hi > nwords) hi = nwords;
    unsigned s = 0;
    for (size_t i = lo + threadIdx.x; i < hi; i += 256) { const unsigned w = buf[i]; s += w * 2654435761u + (w >> 7); }
    __shared__ unsigned red[256]; red[threadIdx.x] = s; __syncthreads();
    for (int o = 128; o > 0; o >>= 1) { if ((int)threadIdx.x < o) red[threadIdx.x] += red[threadIdx.x + o]; __syncthreads(); }
    if (threadIdx.x == 0) { if (rep == 0) cs[blockIdx.x] = red[0]; else if (cs[blockIdx.x] != red[0]) atomicOr(flag, 1u); }
}
__global__ void nanflag_kernel(float* out, const unsigned* flag) { if (*flag) out[0] = __builtin_nanf(""); }
__global__ void clrflag_kernel(unsigned* flag) { *flag = 0u; }
extern "C" void kernel_launch(void* const* d_in, const int* in_sizes, int n_in, void* d_out, int out_size, void* d_ws, size_t ws_size, hipStream_t stream) {
    static int grid = 0;
    if (grid == 0) {
        int dev = 0, cus = 0, per_cu = 0;
        hipGetDevice(&dev); hipDeviceGetAttribute(&cus, hipDeviceAttributeMultiprocessorCount, dev);
        hipFuncSetAttribute((const void*)fwd_mega, hipFuncAttributeMaxDynamicSharedMemorySize, LDS_BYTES);
        hipOccupancyMaxActiveBlocksPerMultiprocessor(&per_cu, (const void*)fwd_mega, NWAVES * 64, LDS_BYTES);
        if (per_cu < 1) per_cu = 1;
        grid = cus * per_cu;
        if (n_in != 22 || ws_size < (size_t)1008 * MiB) { fprintf(stderr, "kernel_launch: unexpected n_in %d / ws %zu\n", n_in, ws_size); }
    }
    hipMemsetAsync(d_ws, 0, 16384, stream);
    Args a{};
    for (int i = 0; i < 22; ++i) a.in[i] = (const float*)d_in[i];
    a.out = (float*)d_out; a.ws = (unsigned char*)d_ws;
#ifndef DBG_DOUBLE
#define DBG_DOUBLE 0
#endif
#ifndef N_LAUNCH_SPLIT
#define N_LAUNCH_SPLIT 0
#endif
    if (N_LAUNCH_SPLIT) {
#ifdef DBG_K
        unsigned char* w8 = (unsigned char*)d_ws; unsigned* flag = (unsigned*)(w8 + 512 * 1024); unsigned* cs = (unsigned*)(w8 + 600 * 1024);
        hipLaunchKernelGGL(clrflag_kernel, dim3(1), dim3(1), 0, stream, flag);
        for (int rep = 0; rep < 2; ++rep) {
            for (int p = (rep ? DBG_REP1_FROM : 0); p <= DBG_K; ++p) { a.ph_lo = p; a.ph_hi = p + 1; hipLaunchKernelGGL(fwd_mega, dim3(grid), dim3(NWAVES * 64), LDS_BYTES, stream, a); }
            const size_t offs[] = DBG_OFFS; const size_t lens[] = DBG_LENS; const int isout[] = DBG_ISOUT;
            for (int r = 0; r < (int)(sizeof(offs) / sizeof(offs[0])); ++r) {
                const unsigned char* base = isout[r] ? (const unsigned char*)d_out : w8;
                hipLaunchKernelGGL(ck_kernel, dim3(1024), dim3(256), 0, stream, (const unsigned*)(base + offs[r] * MiB), lens[r] * MiB / 4, cs + r * 1024, rep, flag); }
        }
        for (int p = DBG_K + 1; p < 14; ++p) { a.ph_lo = p; a.ph_hi = p + 1; hipLaunchKernelGGL(fwd_mega, dim3(grid), dim3(NWAVES * 64), LDS_BYTES, stream, a); }
        hipLaunchKernelGGL(nanflag_kernel, dim3(1), dim3(1), 0, stream, (float*)d_out, flag);
#else
        for (int p = 0; p < 14; ++p) { a.ph_lo = p; a.ph_hi = p + 1; const int reps = ((DBG_DOUBLE >> p) & 1) ? 2 : 1;
            for (int r = 0; r < reps; ++r) hipLaunchKernelGGL(fwd_mega, dim3(grid), dim3(NWAVES * 64), LDS_BYTES, stream, a); }
#endif
    } else {
        a.ph_lo = 0; a.ph_hi = 14;
        void* kargs[] = {&a};
        hipError_t e = hipLaunchCooperativeKernel((const void*)fwd_mega, dim3(grid), dim3(NWAVES * 64), kargs, LDS_BYTES, stream);
        if (e != hipSuccess) fprintf(stderr, "cooperative launch failed: %s (grid %d)\n", hipGetErrorString(e), grid);
    }
}
```

```cpp
#include <hip/hip_runtime.h>
#include <hip/hip_cooperative_groups.h>
#include <hip/hip_bf16.h>
#include <cstdio>
#include <cstdint>
namespace cg = cooperative_groups;

namespace xl {
__device__ __forceinline__ float dpp_f(float v, const int ctrl_sel) {
    int x = __builtin_bit_cast(int, v), r;
    if (ctrl_sel == 0) r = __builtin_amdgcn_mov_dpp(x, 0xB1, 0xF, 0xF, true);
    else if (ctrl_sel == 1) r = __builtin_amdgcn_mov_dpp(x, 0x4E, 0xF, 0xF, true);
    else if (ctrl_sel == 2) r = __builtin_amdgcn_mov_dpp(x, 0x141, 0xF, 0xF, true);
    else r = __builtin_amdgcn_mov_dpp(x, 0x140, 0xF, 0xF, true);
    return __builtin_bit_cast(float, r);
}
__device__ __forceinline__ float sum16(float v) { v += dpp_f(v, 0); v += dpp_f(v, 1); v += dpp_f(v, 2); v += dpp_f(v, 3); return v; }
__device__ __forceinline__ float add_x16(float v) { auto r = __builtin_amdgcn_permlane16_swap(__float_as_uint(v), __float_as_uint(v), false, false); return __uint_as_float(r[0]) + __uint_as_float(r[1]); }
__device__ __forceinline__ float add_x32(float v) { auto r = __builtin_amdgcn_permlane32_swap(__float_as_uint(v), __float_as_uint(v), false, false); return __uint_as_float(r[0]) + __uint_as_float(r[1]); }
__device__ __forceinline__ float get_x16(float v, bool odd_row) { auto r = __builtin_amdgcn_permlane16_swap(__float_as_uint(v), __float_as_uint(v), false, false); return __uint_as_float(odd_row ? r[0] : r[1]); }
__device__ __forceinline__ float sum32(float v) { return add_x16(sum16(v)); }
__device__ __forceinline__ float sum64(float v) { return add_x32(add_x16(sum16(v))); }
}
namespace pg8 {
#define PG8_LAS __attribute__((address_space(3)))
typedef unsigned short bf16_t;
typedef short bf16x8 __attribute__((ext_vector_type(8)));
typedef float f32x4 __attribute__((ext_vector_type(4)));
typedef unsigned u32x4 __attribute__((ext_vector_type(4)));
constexpr int BM = 256, BK = 64, HALF = 128, HTB = HALF * BK * 2  , STAGE_BYTES = 8 * HTB, NXCD = 8, WGM = 8;

__host__ __device__ __forceinline__ int lds_byte(int r, int c) { const int st = (r >> 4) * 2 + (c >> 5), rr = r & 15, cc = c & 31, ob = rr * 64 + cc * 2; return st * 1024 + (ob ^ (((ob >> 9) & 1) << 5)); }
__host__ __device__ __forceinline__ void stage_rc(int b, int& R, int& C) { const int st = b / 1024, sb = b % 1024, swz = sb ^ (((sb >> 9) & 1) << 5); R = (st >> 1) * 16 + swz / 64; C = (st & 1) * 32 + (swz % 64) / 2; }
__host__ __device__ __forceinline__ int perm32(int rho) { const int n = rho >> 4, i = rho & 15; return 8 * (i >> 2) + 4 * n + (i & 3); }

struct Unit { int pm, pn; };
struct Gemm { const bf16_t* A; const bf16_t* Bt; int M, N, K; };

struct StaticOrder {
    int nM, nN, nwg, G, c;
    __host__ __device__ void init(int M, int N, int G_, int c_) { nM = M / BM; nN = N / BM; nwg = nM * nN; G = G_; c = c_; }
    __host__ __device__ bool next(int i, Unit& u) const {
        const long L = (long)i * G + c; if (L >= nwg) return false;
        int wgid = (int)L; { const int q = nwg / NXCD, r = nwg % NXCD, xcd = wgid % NXCD, off = wgid / NXCD; wgid = (xcd < r ? xcd * (q + 1) : r * (q + 1) + (xcd - r) * q) + off; }
        const int nig = WGM * nN, gid = wgid / nig, fm = gid * WGM, gsz = (nM - fm) < WGM ? (nM - fm) : WGM;
        u.pm = fm + ((wgid % nig) % gsz); u.pn = (wgid % nig) / gsz; return true;
    }
    __device__ __forceinline__ void a_ready(const Unit&) const {}
    __device__ __forceinline__ void done(const Unit&) const {}
};

__device__ __forceinline__ unsigned cvt_pk_bf16(float lo, float hi) { unsigned r; asm volatile("s_nop 0\n\tv_cvt_pk_bf16_f32 %0, %1, %2" : "=v"(r) : "v"(lo), "v"(hi)); return r; }
__device__ __forceinline__ void unpack8(const u32x4 w, float (&f)[8]) {
#pragma unroll
    for (int i = 0; i < 4; ++i) { f[2 * i] = __uint_as_float(w[i] << 16); f[2 * i + 1] = __uint_as_float(w[i] & 0xffff0000u); }
}
__device__ __forceinline__ u32x4 pack8(const float (&f)[8]) { u32x4 w; w.x = cvt_pk_bf16(f[0], f[1]); w.y = cvt_pk_bf16(f[2], f[3]); w.z = cvt_pk_bf16(f[4], f[5]); w.w = cvt_pk_bf16(f[6], f[7]); return w; }
__device__ __forceinline__ float sigm(float x) { return __builtin_amdgcn_rcpf(1.0f + __builtin_amdgcn_exp2f(-1.4426950408889634f * x)); }
template <int MODE> struct EpiGen {
    static constexpr bool PERM = true, AFTER_DRAIN = false;
    bf16_t* O; int ldc; const bf16_t* X1; const bf16_t* X2; float* ss; float scale; size_t split_stride;
    __device__ __forceinline__ void operator()(const f32x4 (&acc)[2][2][4][2], const Unit& u, int wr_, int wc_, int fr_, int fq_) const {
        int t_ = threadIdx.x; asm volatile("" : "+v"(t_));
        const int wid_ = __builtin_amdgcn_readfirstlane(t_ >> 6), wr = wid_ >> 2, wc = wid_ & 3, fr = t_ & 15, fq = (t_ >> 4) & 3;
        const int row0 = u.pm * BM + wr * 64 + fr; int colt = u.pn * BM; bf16_t* base = O;
        if (MODE == 1) { const int t = colt >> 10; base += (size_t)t * split_stride; colt -= t << 10; }
        const int col0 = colt + wc * 32 + 8 * fq;
#pragma unroll
        for (int ai = 0; ai < 2; ++ai)
#pragma unroll
            for (int m = 0; m < 4; ++m) { const int row = row0 + ai * HALF + m * 16; const size_t ro = (size_t)row * ldc + col0; float sq = 0.f;
#pragma unroll
                for (int bj = 0; bj < 2; ++bj) { float v[8];
#pragma unroll
                    for (int i = 0; i < 4; ++i) { v[i] = acc[ai][bj][m][0][i]; v[4 + i] = acc[ai][bj][m][1][i]; }
                    const size_t off = ro + bj * HALF;
                    if (MODE == 1) {
#pragma unroll
                        for (int i = 0; i < 8; ++i) v[i] = sigm(v[i]); }
                    if (MODE == 2) { float a[8]; unpack8(*(const u32x4*)(X1 + off), a);
#pragma unroll
                        for (int i = 0; i < 8; ++i) v[i] *= a[i]; }
                    if (MODE == 3) { float a[8], b[8]; unpack8(*(const u32x4*)(X1 + off), a); unpack8(*(const u32x4*)(X2 + off), b);
#pragma unroll
                        for (int i = 0; i < 8; ++i) v[i] = a[i] + b[i] * v[i]; }
                    if (MODE == 5) {
#pragma unroll
                        for (int i = 0; i < 8; ++i) { const float r = fmaxf(v[i], 0.f); v[i] = r * r; } }
                    if (MODE == 6) { float a[8]; unpack8(*(const u32x4*)(X1 + off), a);
#pragma unroll
                        for (int i = 0; i < 8; ++i) v[i] = a[i] * sigm(v[i]); }
                    if (MODE == 4 || MODE == 6) {
#pragma unroll
                        for (int i = 0; i < 8; ++i) sq += v[i] * v[i]; }
                    *(u32x4*)(base + off) = pack8(v); }
                if (MODE == 4 || MODE == 6) { sq = xl::add_x32(xl::add_x16(sq)); if (fq == 0) ss[(size_t)row * 16 + u.pn * 4 + wc] = sq; }
            }
    }
};
struct EpiGT {
    static constexpr bool PERM = true, AFTER_DRAIN = false;
    bf16_t* GT;
    __device__ __forceinline__ void operator()(const f32x4 (&acc)[2][2][4][2], const Unit& u, int wr, int wc, int fr, int fq) const {
        const int n0 = u.pm * BM + wr * 64 + fr; const int t0 = u.pn * BM + wc * 32 + 8 * fq;
#pragma unroll
        for (int bj = 0; bj < 2; ++bj) { const int t = t0 + bj * HALF; size_t tb; int S, s, b;
            if (t < 65536) { b = t >> 11; s = t & 2047; S = 2048; tb = 0; } else { const int tt = t - 65536; b = tt >> 13; s = tt & 8191; S = 8192; tb = (size_t)65536 * 1024; }
#pragma unroll
            for (int ai = 0; ai < 2; ++ai)
#pragma unroll
                for (int m = 0; m < 4; ++m) { const int n = n0 + ai * HALF + m * 16, comp = n >> 9, c = n & 511; float v[8];
#pragma unroll
                    for (int i = 0; i < 4; ++i) { v[i] = acc[ai][bj][m][0][i]; v[4 + i] = acc[ai][bj][m][1][i]; }
                    *(u32x4*)(GT + tb + ((size_t)(b * 512 + c) * 2 + comp) * S + s) = pack8(v); } }
    }
};
struct EpiQKV {
    static constexpr bool PERM = true, AFTER_DRAIN = false;
    bf16_t* Gb; bf16_t* Q; bf16_t* K; size_t vstride; const float* rope;
    __device__ __forceinline__ void operator()(const f32x4 (&acc)[2][2][4][2], const Unit& u, int wr, int wc, int fr, int fq) const {
        const int row0 = u.pm * BM + wr * 64 + fr; int colt = u.pn * BM; const int t = colt >> 10; bf16_t* base = (t == 0) ? Gb : ((t == 1) ? Q : (K + (size_t)(t - 2) * vstride)); colt -= t << 10;
        const int col0 = colt + wc * 32 + 8 * fq; const bool rot = (t == 1 || t == 2) && ((wc & 1) == 0);
        if (rot) {
#pragma unroll
            for (int ai = 0; ai < 2; ++ai) {
                f32x4 rc[4][4];
#pragma unroll
                for (int m = 0; m < 4; ++m) { const int row = row0 + ai * HALF + m * 16; const int pos = row < 65536 ? (row & 2047) : (row & 8191); const f32x4* rp = (const f32x4*)(rope + (size_t)pos * 16);
#pragma unroll
                    for (int j = 0; j < 4; ++j) rc[m][j] = rp[j]; }
#pragma unroll
                for (int m = 0; m < 4; ++m) { const int row = row0 + ai * HALF + m * 16; const size_t ro = (size_t)row * 1024 + col0;
#pragma unroll
                    for (int bj = 0; bj < 2; ++bj) { float v[8];
#pragma unroll
                        for (int i = 0; i < 4; ++i) { v[i] = acc[ai][bj][m][0][i]; v[4 + i] = acc[ai][bj][m][1][i]; }
#pragma unroll
                        for (int i = 0; i < 8; ++i) { const float o = xl::get_x16(v[i], (fq & 1) != 0); const float c = rc[m][i >> 2][i & 3], s = rc[m][2 + (i >> 2)][i & 3];
                            const float r = (fq == 0) ? (v[i] * c - o * s) : (v[i] * c + o * s);
                            v[i] = (fq < 2) ? r : v[i]; }
                        *(u32x4*)(base + ro + bj * HALF) = pack8(v); } }
            }
        } else {
#pragma unroll
            for (int ai = 0; ai < 2; ++ai)
#pragma unroll
                for (int m = 0; m < 4; ++m) { const int row = row0 + ai * HALF + m * 16; const size_t ro = (size_t)row * 1024 + col0;
#pragma unroll
                    for (int bj = 0; bj < 2; ++bj) { float v[8];
#pragma unroll
                        for (int i = 0; i < 4; ++i) { v[i] = acc[ai][bj][m][0][i]; v[4 + i] = acc[ai][bj][m][1][i]; }
                        *(u32x4*)(base + ro + bj * HALF) = pack8(v); } }
        }
    }
};
struct EpiDFT {
    static constexpr bool PERM = true, AFTER_DRAIN = false;
    bf16_t* F; int S; float scale;
    __device__ __forceinline__ void operator()(const f32x4 (&acc)[2][2][4][2], const Unit& u, int wr, int wc, int fr, int fq) const {
        const int b = u.pn >> 1, ct = u.pn & 1; const int row0 = b * S + u.pm * BM + wr * 64 + fr; const int col0 = ct * BM + wc * 32 + 8 * fq;
#pragma unroll
        for (int ai = 0; ai < 2; ++ai)
#pragma unroll
            for (int m = 0; m < 4; ++m) { const size_t ro = (size_t)(row0 + ai * HALF + m * 16) * 512 + col0;
#pragma unroll
                for (int bj = 0; bj < 2; ++bj) { float v[8];
#pragma unroll
                    for (int i = 0; i < 4; ++i) { v[i] = acc[ai][bj][m][0][i] * scale; v[4 + i] = acc[ai][bj][m][1][i] * scale; }
                    *(u32x4*)(F + ro + bj * HALF) = pack8(v); } }
    }
};
struct ListOrder {
    int base, count, nfast; bool pnfast;
    __device__ bool next(int i, Unit& u) const { if (i >= count) return false; const int idx = base + i; if (pnfast) { u.pn = idx % nfast; u.pm = idx / nfast; } else { u.pm = idx % nfast; u.pn = idx / nfast; } return true; }
    __device__ __forceinline__ void a_ready(const Unit&) const {}
    __device__ __forceinline__ void done(const Unit&) const {}
};
template <class Epi, class Sched, bool ALIGN_EPI = false, bool SP2 = false>
__device__ __forceinline__ void gemm_phase(PG8_LAS unsigned char* lds, const Gemm g, const Sched& S, const Epi& E) {
    int tid_ = threadIdx.x; asm volatile("" : "+v"(tid_));
    const int tid = tid_, wid = __builtin_amdgcn_readfirstlane(tid >> 6), lane = tid & 63, wr = wid >> 2, wc = wid & 3, fr = lane & 15, fq = lane >> 4;
    const int K = g.K, nt = K / BK;
    unsigned voffA[2], voffB[2];
#pragma unroll
    for (int i = 0; i < 2; ++i) { int R, C; stage_rc(tid * 16 + i * 8192, R, C); const int Rb = Epi::PERM ? ((R & ~31) + perm32(R & 31)) : R;
        voffA[i] = (unsigned)(R * K + C) * 2u; voffB[i] = (unsigned)(Rb * K + C) * 2u; }
    const size_t kstep = (size_t)(BK * 2);
    const size_t hstep = (size_t)HALF * K * 2;
    const size_t tstep = 2 * hstep;
    const unsigned ldsw = (unsigned)wid * 1024u;
    const int aoff = lds_byte(wr * 64 + fr, fq * 8), boff = lds_byte(wc * 32 + fr, fq * 8);
#define PG8_SA(b, h) (((b) * 2 + (h)) * HTB)
#define PG8_SB(b, h) ((4 + (b) * 2 + (h)) * HTB)
#define PG8_STAGE(bufoff, gbase, voff) do { _Pragma("unroll") for (int _i = 0; _i < 2; ++_i) \
        __builtin_amdgcn_global_load_lds((const unsigned*)((const char*)(gbase) + (voff)[_i]), (PG8_LAS unsigned*)(lds + (bufoff) + ldsw + _i * 8192), 16, 0, 0); } while (0)
#define PG8_LDA(dst, b, h) do { _Pragma("unroll") for (int m = 0; m < 4; ++m) _Pragma("unroll") for (int k = 0; k < 2; ++k) dst[m][k] = *(const PG8_LAS bf16x8*)(lds + PG8_SA(b, h) + aoff + m * 2048 + k * 1024); } while (0)
#define PG8_LDB(dst, b, h) do { _Pragma("unroll") for (int n = 0; n < 2; ++n) _Pragma("unroll") for (int k = 0; k < 2; ++k) dst[n][k] = *(const PG8_LAS bf16x8*)(lds + PG8_SB(b, h) + boff + n * 2048 + k * 1024); } while (0)
#define PG8_MMA(ai, bj, At, Bt) do { __builtin_amdgcn_s_setprio(1); _Pragma("unroll") for (int m = 0; m < 4; ++m) _Pragma("unroll") for (int n = 0; n < 2; ++n) _Pragma("unroll") for (int k = 0; k < 2; ++k) \
        acc[ai][bj][m][n] = __builtin_amdgcn_mfma_f32_16x16x32_bf16(Bt[n][k], At[m][k], acc[ai][bj][m][n], 0, 0, 0); __builtin_amdgcn_s_setprio(0); } while (0)
#define PG8_WAIT_V(n) asm volatile("s_waitcnt vmcnt(" #n ")" ::: "memory")
#define PG8_WAIT_L(n) asm volatile("s_waitcnt lgkmcnt(" #n ")" ::: "memory")
#define PG8_BAR __builtin_amdgcn_s_barrier()
#define PG8_SCHED __builtin_amdgcn_sched_barrier(0)
    Unit cur, nxt; int ui = 0;
    if (!S.next(0, cur)) return;
    f32x4 acc[2][2][4][2];
#pragma unroll
    for (int a = 0; a < 2; ++a)
#pragma unroll
        for (int b = 0; b < 2; ++b)
#pragma unroll
            for (int m = 0; m < 4; ++m)
#pragma unroll
                for (int n = 0; n < 2; ++n) acc[a][b][m][n] = (f32x4){0.f, 0.f, 0.f, 0.f};
    bf16x8 At[4][2], B0[2][2], B1[2][2];
    const char* cA = (const char*)g.A + (size_t)cur.pm * tstep; const char* cB = (const char*)g.Bt + (size_t)cur.pn * tstep;
    S.a_ready(cur);
    if constexpr (SP2) {
        PG8_STAGE(PG8_SB(0, 0), cB, voffB); PG8_STAGE(PG8_SB(0, 1), cB + hstep, voffB); PG8_STAGE(PG8_SA(0, 0), cA, voffA); PG8_STAGE(PG8_SA(0, 1), cA + hstep, voffA);
        if (wr == 1) PG8_BAR;
        PG8_WAIT_V(2); PG8_BAR;
        PG8_STAGE(PG8_SB(1, 0), cB + kstep, voffB); PG8_STAGE(PG8_SA(1, 0), cA + kstep, voffA); PG8_STAGE(PG8_SB(1, 1), cB + hstep + kstep, voffB);
        PG8_WAIT_V(6); PG8_BAR;
    } else {
        PG8_STAGE(PG8_SB(0, 0), cB, voffB); PG8_STAGE(PG8_SA(0, 0), cA, voffA); PG8_STAGE(PG8_SB(0, 1), cB + hstep, voffB); PG8_STAGE(PG8_SA(0, 1), cA + hstep, voffA);
        if (wr == 1) PG8_BAR;
        PG8_WAIT_V(4); PG8_BAR;
        PG8_STAGE(PG8_SB(1, 0), cB + kstep, voffB); PG8_STAGE(PG8_SA(1, 0), cA + kstep, voffA); PG8_STAGE(PG8_SB(1, 1), cB + hstep + kstep, voffB);
        PG8_WAIT_V(6); PG8_BAR;
    }
    for (;;) {
        const bool has_next = S.next(ui + 1, nxt);
        const char* nA = has_next ? (const char*)g.A + (size_t)nxt.pm * tstep : cA; const char* nB = has_next ? (const char*)g.Bt + (size_t)nxt.pn * tstep : cB;
        for (int t = 0; t < nt; t += 2) {
            const bool last = (t == nt - 2);
            const char* a1 = cA + (size_t)(t + 1) * kstep;
            const char* a2 = last ? nA : cA + (size_t)(t + 2) * kstep; const char* b2 = last ? nB : cB + (size_t)(t + 2) * kstep;
            const char* a3 = a2 + kstep; const char* b3 = b2 + kstep;
            if (last && has_next) S.a_ready(nxt);
            if constexpr (SP2) {
            PG8_LDB(B0, 0, 0); PG8_LDB(B1, 0, 1); PG8_SCHED; PG8_LDA(At, 0, 0); PG8_STAGE(PG8_SA(1, 1), a1 + hstep, voffA);
            PG8_WAIT_V(8); PG8_WAIT_L(0); PG8_BAR; PG8_MMA(0, 0, At, B0); PG8_MMA(0, 1, At, B1); PG8_BAR; PG8_SCHED;
            PG8_LDA(At, 0, 1); PG8_STAGE(PG8_SB(0, 0), b2, voffB); PG8_STAGE(PG8_SB(0, 1), b2 + hstep, voffB); PG8_STAGE(PG8_SA(0, 0), a2, voffA);
            PG8_WAIT_V(8); PG8_WAIT_L(0); PG8_BAR; PG8_MMA(1, 0, At, B0); PG8_MMA(1, 1, At, B1); PG8_BAR; PG8_SCHED;
            PG8_LDB(B0, 1, 0); PG8_LDB(B1, 1, 1); PG8_SCHED; PG8_LDA(At, 1, 0); PG8_STAGE(PG8_SA(0, 1), a2 + hstep, voffA);
            PG8_WAIT_V(8); PG8_WAIT_L(0); PG8_BAR; PG8_MMA(0, 0, At, B0); PG8_MMA(0, 1, At, B1); PG8_BAR; PG8_SCHED;
            PG8_LDA(At, 1, 1); PG8_STAGE(PG8_SB(1, 0), b3, voffB); PG8_STAGE(PG8_SB(1, 1), b3 + hstep, voffB); PG8_STAGE(PG8_SA(1, 0), a3, voffA);
            PG8_WAIT_V(8); PG8_WAIT_L(0); PG8_BAR; PG8_MMA(1, 0, At, B0); PG8_MMA(1, 1, At, B1); PG8_BAR; PG8_SCHED;
            } else {
            PG8_LDB(B0, 0, 0); PG8_SCHED; PG8_LDA(At, 0, 0); PG8_STAGE(PG8_SA(1, 1), a1 + hstep, voffA);
            PG8_WAIT_L(8); PG8_BAR; PG8_WAIT_L(0); PG8_MMA(0, 0, At, B0); PG8_BAR; PG8_SCHED;
            PG8_LDB(B1, 0, 1); PG8_STAGE(PG8_SB(0, 0), b2, voffB);
            PG8_BAR; PG8_WAIT_L(0); PG8_MMA(0, 1, At, B1); PG8_BAR;
            PG8_LDA(At, 0, 1); PG8_STAGE(PG8_SA(0, 0), a2, voffA);
            PG8_BAR; PG8_WAIT_L(0); PG8_MMA(1, 0, At, B0); PG8_BAR; PG8_SCHED;
            PG8_STAGE(PG8_SB(0, 1), b2 + hstep, voffB);
            PG8_WAIT_V(6); PG8_BAR; PG8_MMA(1, 1, At, B1); PG8_BAR;
            PG8_LDB(B0, 1, 0); PG8_SCHED; PG8_LDA(At, 1, 0); PG8_STAGE(PG8_SA(0, 1), a2 + hstep, voffA);
            PG8_WAIT_L(8); PG8_BAR; PG8_WAIT_L(0); PG8_MMA(0, 0, At, B0); PG8_BAR; PG8_SCHED;
            PG8_LDB(B1, 1, 1); PG8_STAGE(PG8_SB(1, 0), b3, voffB);
            PG8_BAR; PG8_WAIT_L(0); PG8_MMA(0, 1, At, B1); PG8_BAR;
            PG8_LDA(At, 1, 1); PG8_STAGE(PG8_SA(1, 0), a3, voffA);
            PG8_BAR; PG8_WAIT_L(0); PG8_MMA(1, 0, At, B0); PG8_BAR; PG8_SCHED;
            PG8_STAGE(PG8_SB(1, 1), b3 + hstep, voffB);
            PG8_WAIT_V(6); PG8_BAR; PG8_MMA(1, 1, At, B1); PG8_BAR;
            }
        }
        if constexpr (ALIGN_EPI) { if (wr == 0) PG8_BAR; }
        if constexpr (!Epi::AFTER_DRAIN) { E(acc, cur, wr, wc, fr, fq); S.done(cur); }
        if (!has_next) break;
#pragma unroll
        for (int a = 0; a < 2; ++a)
#pragma unroll
            for (int b = 0; b < 2; ++b)
#pragma unroll
                for (int m = 0; m < 4; ++m)
#pragma unroll
                    for (int n = 0; n < 2; ++n) acc[a][b][m][n] = (f32x4){0.f, 0.f, 0.f, 0.f};
        cur = nxt; cA = nA; cB = nB; ++ui;
        if constexpr (ALIGN_EPI) { if (wr == 1) PG8_BAR; }
    }
    PG8_WAIT_V(0);
    if constexpr (!ALIGN_EPI) { if (wr == 0) PG8_BAR; }
    PG8_BAR;
    if constexpr (Epi::AFTER_DRAIN) { E.fused(acc, cur, wr, wc, fr, fq, lds, wid, lane); S.done(cur); }
#undef PG8_SA
#undef PG8_SB
#undef PG8_STAGE
#undef PG8_LDA
#undef PG8_LDB
#undef PG8_MMA
#undef PG8_WAIT_V
#undef PG8_WAIT_L
#undef PG8_BAR
#undef PG8_SCHED
}
}
namespace att {
using bf16x8 = __attribute__((ext_vector_type(8))) short;
using s16x4  = __attribute__((ext_vector_type(4))) short;
using f32x16 = __attribute__((ext_vector_type(16))) float;
using u32x4  = __attribute__((ext_vector_type(4))) unsigned;
using f32x4v = __attribute__((ext_vector_type(4))) float;
typedef unsigned short bf16_t;
constexpr int NW = 8, QBLK = 32, KVBLK = 64, LD = 1024;
constexpr float SCALE = 0.125f, THR = 8.f;
constexpr int SHM_V = KVBLK * 128 * 2, SHM_K = KVBLK * 64 * 2, SHM_ATTN = 3 * SHM_V + 3 * SHM_K + NW * 64 * 4;
#define KSWZ(row, colB) ((row) * 128 + ((colB) ^ ((((row) >> 1) & 7) << 4)))
#define SBAR() __builtin_amdgcn_sched_barrier(0)
__device__ __forceinline__ int crow(int r, int hi) { return (r & 3) + 8 * (r >> 2) + 4 * hi; }
__device__ __forceinline__ unsigned cvtpk(float lo, float hi) { unsigned r; asm volatile("s_nop 0\n\tv_cvt_pk_bf16_f32 %0, %1, %2" : "=v"(r) : "v"(lo), "v"(hi)); return r; }
__device__ __forceinline__ void partialSM(f32x16& p0, f32x16& p1, float& m_reg, float& mn, float& alpha) {
  constexpr float C = SCALE * 1.4426950408889634f;
  float pmax = p0[0];
#pragma unroll
  for (int r = 1; r < 16; ++r) pmax = fmaxf(pmax, p0[r]);
#pragma unroll
  for (int r = 0; r < 16; ++r) pmax = fmaxf(pmax, p1[r]);
  { auto rr = __builtin_amdgcn_permlane32_swap(__float_as_uint(pmax), __float_as_uint(pmax), false, false);
    pmax = fmaxf(__uint_as_float(rr[0]), __uint_as_float(rr[1])); }
  if (__builtin_expect(__all(pmax - m_reg <= THR / SCALE), 1)) { mn = m_reg; alpha = 1.f; }
  else { mn = fmaxf(m_reg, pmax); alpha = __builtin_amdgcn_exp2f((m_reg - mn) * C); m_reg = mn; }
  float mnC = -mn * C;
#pragma unroll
  for (int r = 0; r < 16; ++r) p0[r] = fmaf(p0[r], C, mnC);
#pragma unroll
  for (int r = 0; r < 16; ++r) p1[r] = fmaf(p1[r], C, mnC);
#pragma unroll
  for (int r = 0; r < 16; ++r) p0[r] = __builtin_amdgcn_exp2f(p0[r]);
}
__device__ __forceinline__ void finishSM(f32x16& p0, f32x16& p1, float alpha, float& l_reg, bf16x8& pa0, bf16x8& pa1, bf16x8& pa2, bf16x8& pa3) {
#pragma unroll
  for (int r = 0; r < 16; ++r) p1[r] = __builtin_amdgcn_exp2f(p1[r]);
  float ps = 0;
#pragma unroll
  for (int r = 0; r < 16; ++r) ps += p0[r];
#pragma unroll
  for (int r = 0; r < 16; ++r) ps += p1[r];
  { auto rr = __builtin_amdgcn_permlane32_swap(__float_as_uint(ps), __float_as_uint(ps), false, false);
    ps = __uint_as_float(rr[0]) + __uint_as_float(rr[1]); }
  l_reg = l_reg * alpha + ps;
#define PK4(P, BASE, OUT) do { unsigned a0 = cvtpk(P[BASE + 0], P[BASE + 1]), a1 = cvtpk(P[BASE + 2], P[BASE + 3]);   \
    unsigned b0 = cvtpk(P[BASE + 4], P[BASE + 5]), b1 = cvtpk(P[BASE + 6], P[BASE + 7]);                              \
    auto r0 = __builtin_amdgcn_permlane32_swap(a0, b0, false, false); auto r1 = __builtin_amdgcn_permlane32_swap(a1, b1, false, false); \
    u32x4 w = {r0[0], r1[0], r0[1], r1[1]}; OUT = *reinterpret_cast<bf16x8*>(&w); } while (0)
  PK4(p0, 0, pa0); PK4(p0, 8, pa1); PK4(p1, 0, pa2); PK4(p1, 8, pa3);
#undef PK4
}
__device__ __forceinline__ void qkt(f32x16& p0, f32x16& p1, const char* Ks, const bf16x8* qr, int r32, int hi) {
  p0 = f32x16{}; p1 = f32x16{};
#pragma unroll
  for (int d0 = 0; d0 < 4; ++d0) { int cb = (d0 * 16 + hi * 8) * 2;
    bf16x8 b0 = *reinterpret_cast<const bf16x8*>(Ks + KSWZ(r32, cb));
    bf16x8 b1 = *reinterpret_cast<const bf16x8*>(Ks + KSWZ(32 + r32, cb));
    p0 = __builtin_amdgcn_mfma_f32_32x32x16_bf16(b0, qr[d0], p0, 0, 0, 0);
    p1 = __builtin_amdgcn_mfma_f32_32x32x16_bf16(b1, qr[d0], p1, 0, 0, 0); }
}
__device__ __forceinline__ int v_st(int k, int c) { const int kk = (k & ~0xC) | ((k & 4) << 1) | ((k & 8) >> 1); return ((kk >> 3) * 4 + (c >> 5)) * 512 + ((kk & 7) * 32 + (c & 31)) * 2; }
__device__ __forceinline__ int v_rd_base(int lane) { return ((lane & 3) << 3) | (((lane >> 2) & 3) << 6) | (((lane >> 4) & 1) << 5) | (((lane >> 5) & 1) << 8); }
constexpr int v_rd_off(int d0, int ks, int half) { return d0 * 512 + ks * 4096 + half * 2048; }
template <int OFF> __device__ __forceinline__ s16x4 tr_read(int vb) {
  s16x4 r; asm volatile("ds_read_b64_tr_b16 %0, %1 offset:%2" : "=&v"(r) : "v"(vb), "i"(OFF) : "memory"); return r;
}
template <int D0> __device__ __forceinline__ void pv_one(f32x16& od, int vb, bf16x8 pa0, bf16x8 pa1, bf16x8 pa2, bf16x8 pa3) {
  const s16x4 l0 = tr_read<v_rd_off(D0, 0, 0)>(vb), h0 = tr_read<v_rd_off(D0, 0, 1)>(vb), l1 = tr_read<v_rd_off(D0, 1, 0)>(vb), h1 = tr_read<v_rd_off(D0, 1, 1)>(vb);
  const s16x4 l2 = tr_read<v_rd_off(D0, 2, 0)>(vb), h2 = tr_read<v_rd_off(D0, 2, 1)>(vb), l3 = tr_read<v_rd_off(D0, 3, 0)>(vb), h3 = tr_read<v_rd_off(D0, 3, 1)>(vb);
  asm volatile("s_waitcnt lgkmcnt(0)" ::: "memory"); SBAR();
#define PK(L, H) (bf16x8){L[0], L[1], L[2], L[3], H[0], H[1], H[2], H[3]}
  od = __builtin_amdgcn_mfma_f32_32x32x16_bf16(pa0, PK(l0, h0), od, 0, 0, 0);
  od = __builtin_amdgcn_mfma_f32_32x32x16_bf16(pa1, PK(l1, h1), od, 0, 0, 0);
  od = __builtin_amdgcn_mfma_f32_32x32x16_bf16(pa2, PK(l2, h2), od, 0, 0, 0);
  od = __builtin_amdgcn_mfma_f32_32x32x16_bf16(pa3, PK(l3, h3), od, 0, 0, 0);
#undef PK
}
__device__ __forceinline__ void pv_d0(f32x16* o, int vb, bf16x8 pa0, bf16x8 pa1, bf16x8 pa2, bf16x8 pa3) {
  pv_one<0>(o[0], vb, pa0, pa1, pa2, pa3); pv_one<1>(o[1], vb, pa0, pa1, pa2, pa3); pv_one<2>(o[2], vb, pa0, pa1, pa2, pa3); pv_one<3>(o[3], vb, pa0, pa1, pa2, pa3);
}
__device__ __forceinline__ void pv_sm(f32x16* o, int vb, bf16x8 pa0, bf16x8 pa1, bf16x8 pa2, bf16x8 pa3, f32x16& p0, f32x16& p1, float& m_reg, float& mn, float& alpha) {
  constexpr float C = SCALE * 1.4426950408889634f;
  pv_one<0>(o[0], vb, pa0, pa1, pa2, pa3);
  float pmax = p0[0];
#pragma unroll
  for (int r = 1; r < 16; ++r) pmax = fmaxf(pmax, p0[r]);
#pragma unroll
  for (int r = 0; r < 16; ++r) pmax = fmaxf(pmax, p1[r]);
  { auto rr = __builtin_amdgcn_permlane32_swap(__float_as_uint(pmax), __float_as_uint(pmax), false, false);
    pmax = fmaxf(__uint_as_float(rr[0]), __uint_as_float(rr[1])); }
  pv_one<1>(o[1], vb, pa0, pa1, pa2, pa3);
  const bool keep = __all(pmax - m_reg <= THR / SCALE);
  mn = keep ? m_reg : fmaxf(m_reg, pmax); alpha = __builtin_amdgcn_exp2f((m_reg - mn) * C); m_reg = mn;
  const float mnC = -mn * C;
#pragma unroll
  for (int r = 0; r < 16; ++r) p0[r] = fmaf(p0[r], C, mnC);
  pv_one<2>(o[2], vb, pa0, pa1, pa2, pa3);
#pragma unroll
  for (int r = 0; r < 16; ++r) p1[r] = fmaf(p1[r], C, mnC);
#pragma unroll
  for (int r = 0; r < 8; ++r) p0[r] = __builtin_amdgcn_exp2f(p0[r]);
  pv_one<3>(o[3], vb, pa0, pa1, pa2, pa3);
#pragma unroll
  for (int r = 8; r < 16; ++r) p0[r] = __builtin_amdgcn_exp2f(p0[r]);
}
__device__ __forceinline__ void attn_unit(const bf16_t* Qb, const bf16_t* Kb, const bf16_t* Vh, bf16_t* Ob, int seq, char* lds, float* stash, float lam, const float* subln) {
  int tid_ = threadIdx.x; asm volatile("" : "+v"(tid_));
  const int tid = tid_, wid = tid >> 6, lane = tid & 63, r32 = lane & 31, hi = lane >> 5;
  char* V_lds = lds; char* K_lds = lds + 3 * SHM_V;
  float* ws = (float*)(lds + 3 * SHM_V + 3 * SHM_K) + wid * 64; float* li_l = ws; float* al_l = ws + 32;
  const int sr = tid >> 4, sc = (tid & 15) * 8, vst0 = v_st(sr, sc), vst1 = v_st(32 + sr, sc);
  const int kr = tid >> 3, kc = (tid & 7) * 8, kst = KSWZ(kr, kc * 2);
  const int vb0 = (int)(uintptr_t)V_lds + v_rd_base(lane);
  const int NT = seq / KVBLK;
  f32x16 o[4];
  u32x4* const sl = (u32x4*)(lds + 3 * SHM_V + 3 * SHM_K + NW * 64 * 4) + tid;
  for (int comp = 0; comp < 2; ++comp) {
    const bf16_t* Kh = Kb + comp * 64;
    float m_reg = -1e30f, l_reg = 0; bf16x8 qr[4];
#pragma unroll
    for (int d = 0; d < 4; ++d) o[d] = f32x16{};
    const bf16_t* Qw = Qb + comp * 64 + (long)(wid * QBLK + r32) * LD + hi * 8;
#pragma unroll
    for (int d0 = 0; d0 < 4; ++d0) qr[d0] = *reinterpret_cast<const bf16x8*>(Qw + d0 * 16);
    struct { bf16x8 vs0, vs1, ks0; } sr_[2];
#define SLOAD(i, k0) do { sr_[i].vs0 = *reinterpret_cast<const bf16x8*>(&Vh[(long)((k0) + sr) * LD + sc]); sr_[i].vs1 = *reinterpret_cast<const bf16x8*>(&Vh[(long)((k0) + 32 + sr) * LD + sc]); \
    sr_[i].ks0 = *reinterpret_cast<const bf16x8*>(&Kh[(long)((k0) + kr) * LD + kc]); } while (0)
#define SWRITE(b, i) do { *(bf16x8*)(V_lds + (b) * SHM_V + vst0) = sr_[i].vs0; *(bf16x8*)(V_lds + (b) * SHM_V + vst1) = sr_[i].vs1; \
    *(bf16x8*)(K_lds + (b) * SHM_K + kst) = sr_[i].ks0; } while (0)
#define SWAIT() asm volatile("s_waitcnt vmcnt(3)" ::: "memory")
#define RESC(a) do { if (__any((a) < 1.f)) { if (hi == 0) al_l[r32] = (a); asm volatile("s_waitcnt lgkmcnt(0)" ::: "memory"); \
    _Pragma("unroll") for (int d = 0; d < 4; ++d) _Pragma("unroll") for (int r = 0; r < 16; ++r) o[d][r] *= al_l[crow(r, hi)]; } } while (0)
    f32x16 pA0, pA1, pB0, pB1; float mnA, mnB, alA, alB; bf16x8 pa0, pa1, pa2, pa3;
    int bp = 0, bc = 1, bn = 2;
#define ROT3() do { const int t_ = bp; bp = bc; bc = bn; bn = t_; } while (0)
    SLOAD(0, 0); asm volatile("s_waitcnt vmcnt(0)" ::: "memory"); SWRITE(0, 0); __syncthreads();
    qkt(pA0, pA1, K_lds, qr, r32, hi); partialSM(pA0, pA1, m_reg, mnA, alA);
    SLOAD(1, KVBLK); if (2 < NT) SLOAD(0, 2 * KVBLK);
    SWAIT(); SWRITE(1, 1); __syncthreads();
    for (int j = 1; j + 1 < NT; j += 2) {
      SBAR(); qkt(pB0, pB1, K_lds + bc * SHM_K, qr, r32, hi);
      finishSM(pA0, pA1, alA, l_reg, pa0, pa1, pa2, pa3); SBAR();
      SLOAD(1, (j + 2) * KVBLK); SBAR();
      pv_sm(o, vb0 + bp * SHM_V, pa0, pa1, pa2, pa3, pB0, pB1, m_reg, mnB, alB);
      SWAIT(); SWRITE(bn, 0);
      RESC(alB); __syncthreads(); ROT3();
      SBAR(); qkt(pA0, pA1, K_lds + bc * SHM_K, qr, r32, hi);
      finishSM(pB0, pB1, alB, l_reg, pa0, pa1, pa2, pa3); SBAR();
      if (j + 3 < NT) SLOAD(0, (j + 3) * KVBLK); SBAR();
      pv_sm(o, vb0 + bp * SHM_V, pa0, pa1, pa2, pa3, pA0, pA1, m_reg, mnA, alA);
      SWAIT(); SWRITE(bn, 1);
      RESC(alA); __syncthreads(); ROT3();
    }
    SBAR(); qkt(pB0, pB1, K_lds + bc * SHM_K, qr, r32, hi);
    finishSM(pA0, pA1, alA, l_reg, pa0, pa1, pa2, pa3); SBAR();
    pv_sm(o, vb0 + bp * SHM_V, pa0, pa1, pa2, pa3, pB0, pB1, m_reg, mnB, alB);
    RESC(alB);
    finishSM(pB0, pB1, alB, l_reg, pa0, pa1, pa2, pa3); SBAR();
    pv_d0(o, vb0 + bc * SHM_V, pa0, pa1, pa2, pa3);
#undef ROT3
    if (hi == 0) li_l[r32] = l_reg; asm volatile("s_waitcnt lgkmcnt(0)" ::: "memory");
#pragma unroll
    for (int r = 0; r < 16; ++r) { const float rl = __builtin_amdgcn_rcpf(li_l[crow(r, hi)]);
#pragma unroll
      for (int d0 = 0; d0 < 4; ++d0) o[d0][r] *= rl; }
    if (comp == 0) {
#pragma unroll
      for (int d0 = 0; d0 < 4; ++d0)
#pragma unroll
        for (int hf = 0; hf < 2; ++hf) { u32x4 t; t.x = cvtpk(o[d0][8 * hf], o[d0][8 * hf + 1]); t.y = cvtpk(o[d0][8 * hf + 2], o[d0][8 * hf + 3]); t.z = cvtpk(o[d0][8 * hf + 4], o[d0][8 * hf + 5]); t.w = cvtpk(o[d0][8 * hf + 6], o[d0][8 * hf + 7]); sl[(d0 * 2 + hf) * 512] = t; } }
    __syncthreads();
#undef SLOAD
#undef SWRITE
#undef SWAIT
#undef RESC
  }
  {
    bf16_t* stg = (bf16_t*)(lds + wid * 8704);
    float sg[4];
#pragma unroll
    for (int d0 = 0; d0 < 4; ++d0) sg[d0] = subln[d0 * 32 + r32] * 0.8f;
#pragma unroll
    for (int hf = 0; hf < 2; ++hf) {
      u32x4 t0[4];
#pragma unroll
      for (int d0 = 0; d0 < 4; ++d0) t0[d0] = sl[(d0 * 2 + hf) * 512];
#pragma unroll
      for (int k = 0; k < 8; ++k) { const int r = 8 * hf + k; float v[4]; float q = 0.f;
#pragma unroll
        for (int d0 = 0; d0 < 4; ++d0) { const unsigned w0 = t0[d0][k >> 1];
          const float a = __uint_as_float((k & 1) ? (w0 & 0xffff0000u) : (w0 << 16));
          v[d0] = a - lam * o[d0][r]; q += v[d0] * v[d0]; }
        q = xl::sum32(q);
        const float rs = __builtin_amdgcn_rsqf(q * (1.0f / 128.0f) + 1e-6f); const int orow = crow(r, hi);
#pragma unroll
        for (int d0 = 0; d0 < 4; ++d0) { const float w = v[d0] * rs * sg[d0]; stg[orow * 136 + d0 * 32 + r32] = (bf16_t)(cvtpk(w, w) & 0xffffu); } }
      asm volatile("" ::: "memory");
    }
    asm volatile("s_waitcnt lgkmcnt(0)" ::: "memory");
    bf16_t* Og = Ob + (long)(wid * QBLK) * LD;
#pragma unroll
    for (int i = 0; i < 8; ++i) { const int row = i * 4 + (lane >> 4), ch = lane & 15; const u32x4 t = *(const u32x4*)((const char*)stg + row * 272 + ch * 16); *(u32x4*)(Og + (long)row * LD + ch * 8) = t; }
  }
  __syncthreads();
}
#undef SBAR
#undef KSWZ
}

namespace ct {
using att::bf16x8; using att::f32x16; using att::bf16_t;
template <int MB> __device__ __forceinline__ void unit(const bf16_t* Amat, int K, const bf16_t* src, int P, long sA, long sB, bf16_t* dst, int Q, long sC, long sD, float scale, char* lds) {
  constexpr int NCH = 8 / MB;
  int tid_ = threadIdx.x; asm volatile("" : "+v"(tid_));
  const int tid = tid_, wid = tid >> 6, lane = tid & 63, r32 = lane & 31, hi = lane >> 5;
  const int rb = wid % MB, cc = wid / MB;
  const int sr = tid >> 4, sc = (tid & 15) * 8, vst0 = att::v_st(sr, sc), vst1 = att::v_st(32 + sr, sc);
  const int vb = (int)(uintptr_t)lds + cc * 16384 + att::v_rd_base(lane);
  const int NKT = K >> 6;
#pragma unroll 1
  for (int cs = 0; cs < 4 / NCH; ++cs) {
    f32x16 o[4] = {};
#pragma unroll 1
    for (int kt = 0; kt < NKT; ++kt) {
      const int k0 = kt * 64 + sr, k1 = k0 + 32;
      const bf16_t* r0 = src + (long)(k0 % P) * sA + (long)(k0 / P) * sB + cs * NCH * 128 + sc;
      const bf16_t* r1 = src + (long)(k1 % P) * sA + (long)(k1 / P) * sB + cs * NCH * 128 + sc;
      bf16x8 t0[NCH], t1[NCH];
#pragma unroll
      for (int ch = 0; ch < NCH; ++ch) { t0[ch] = *reinterpret_cast<const bf16x8*>(r0 + ch * 128); t1[ch] = *reinterpret_cast<const bf16x8*>(r1 + ch * 128); }
      const bf16_t* ap = Amat + (long)(rb * 32 + r32) * K + kt * 64 + hi * 8;
      const bf16x8 pa0 = *reinterpret_cast<const bf16x8*>(ap), pa1 = *reinterpret_cast<const bf16x8*>(ap + 16), pa2 = *reinterpret_cast<const bf16x8*>(ap + 32), pa3 = *reinterpret_cast<const bf16x8*>(ap + 48);
      __syncthreads();
#pragma unroll
      for (int ch = 0; ch < NCH; ++ch) { *(bf16x8*)(lds + ch * 16384 + vst0) = t0[ch]; *(bf16x8*)(lds + ch * 16384 + vst1) = t1[ch]; }
      __syncthreads();
      att::pv_d0(o, vb, pa0, pa1, pa2, pa3);
    }
    bf16_t* stg = (bf16_t*)(lds + 65536 + wid * 8704);
#pragma unroll
    for (int r = 0; r < 16; ++r) { const int orow = att::crow(r, hi);
#pragma unroll
      for (int d0 = 0; d0 < 4; ++d0) { const __bf16 hb = (__bf16)(o[d0][r] * scale); stg[orow * 136 + d0 * 32 + r32] = __builtin_bit_cast(bf16_t, hb); } }
    asm volatile("s_waitcnt lgkmcnt(0)" ::: "memory");
#pragma unroll
    for (int i = 0; i < 8; ++i) { const int row = i * 4 + (lane >> 4), ch = lane & 15, m = rb * 32 + row;
      const att::u32x4 t = *(const att::u32x4*)((const char*)stg + row * 272 + ch * 16);
      *(att::u32x4*)(dst + (long)(m % Q) * sC + (long)(m / Q) * sD + (cs * NCH + cc) * 128 + ch * 8) = t; }
    asm volatile("s_waitcnt lgkmcnt(0)" ::: "memory");
  }
  __syncthreads();
}
}
#define LAS __attribute__((address_space(3)))
typedef unsigned short bf16;
typedef unsigned v4u __attribute__((ext_vector_type(4)));
typedef float f32x4 __attribute__((ext_vector_type(4)));
constexpr int NWAVES = 8;
constexpr int T = 81920, TP = 65536, D = 1024, FF = 4096, PLE = 256, INW = 5632;
constexpr float EPS = 1e-6f;
constexpr size_t MiB = 1u << 20;
constexpr size_t WS_ROPE = 1 * MiB;
constexpr size_t WS_WF2 = 2 * MiB, WS_WQKV = 4 * MiB, WS_WG = 10 * MiB, WS_WF = 14 * MiB, WS_WA = 15 * MiB, WS_WO = 17 * MiB, WS_WUP = 19 * MiB, WS_WDN = 27 * MiB, WS_WPLE = 35 * MiB, WS_WGATE = 36 * MiB;
constexpr size_t WS_A1S = 42 * MiB, WS_A1P = 46 * MiB, WS_A2S = 47 * MiB, WS_A2P = 47 * MiB + 512 * 1024;
constexpr size_t WS_UC = 544 * MiB;
constexpr size_t WS_SS = 58 * MiB;
constexpr size_t WS_XH = 64 * MiB;
constexpr size_t WS_GT = 224 * MiB;
constexpr size_t WS_Q = 384 * MiB, WS_K = 544 * MiB, WS_V = 704 * MiB;
constexpr size_t WS_F = 864 * MiB;
constexpr size_t WS_STASH = 944 * MiB;
constexpr size_t WS_U = 384 * MiB;
constexpr size_t WS_PB = 384 * MiB;
constexpr size_t WS_EP = 424 * MiB, WS_E = 584 * MiB;
constexpr int LDS_BYTES = 147456;

#define XB_TMO      128
#define XB_XCNT(j)  (256  + 64 * (j))
#define XB_XSUB(j)  (1280 + 64 * (j))
#define XB_XGEN(j)  (2304 + 64 * (j))
#define XB_TOP      3328
#define XB_TOPGEN   3392
#define XCD_BAR_WORDS 3456
#define XB_SPIN_CAP (1u << 18)

__device__ __forceinline__ unsigned xb_ld(unsigned* p)              { return __hip_atomic_load(p, __ATOMIC_RELAXED, __HIP_MEMORY_SCOPE_AGENT); }
__device__ __forceinline__ unsigned xb_add(unsigned* p, unsigned v) { return __hip_atomic_fetch_add(p, v, __ATOMIC_RELAXED, __HIP_MEMORY_SCOPE_AGENT); }
__device__ __forceinline__ unsigned xb_xcc_id() { return (unsigned)__builtin_amdgcn_s_getreg((3 << 11) | 20) & 0xFu; }
#define XB_SPIN(cond, bar) do { unsigned _sp = 0; while (cond) { __builtin_amdgcn_s_sleep(1); \
    if ((++_sp & 255u) == 0u) { if (xb_ld(&(bar)[XB_TMO])) break; if (_sp > XB_SPIN_CAP) { atomicAdd(&(bar)[XB_TMO], 1u); break; } } } } while (0)

struct XcdBarrier {
    unsigned* bar; unsigned x;
    volatile LAS unsigned* st;
};

__device__ __forceinline__ XcdBarrier xcd_barrier_post(unsigned* bar, volatile LAS unsigned* st) {
    XcdBarrier b; b.bar = bar; b.x = xb_xcc_id(); b.st = st;
    if (threadIdx.x == 0) (void)xb_add(&bar[XB_XCNT(b.x)], 1u);
    return b;
}
__device__ __forceinline__ void xcd_barrier_complete(unsigned* bar, unsigned x, unsigned& nloc, unsigned& nx) {
    const unsigned G = gridDim.x * gridDim.y * gridDim.z;
    unsigned sum, cnt, mine, sp = 0u;
    for (;;) {
        sum = 0u; cnt = 0u; mine = 0u;
#pragma unroll
        for (unsigned j = 0; j < 16; ++j) { const unsigned c = xb_ld(&bar[XB_XCNT(j)]); sum += c; cnt += (c > 0u) ? 1u : 0u; mine = (j == x) ? c : mine; }
        if (sum == G) break;
        __builtin_amdgcn_s_sleep(1);
        if ((++sp & 255u) == 0u) { if (xb_ld(&bar[XB_TMO])) break; if (sp > XB_SPIN_CAP) { atomicAdd(&bar[XB_TMO], 1u); break; } }
    }
    nloc = mine > 0u ? mine : 1u; nx = cnt > 0u ? cnt : 1u;
}

__device__ __forceinline__ void xcd_barrier(const XcdBarrier& b) {
    asm volatile("s_waitcnt vmcnt(0)" ::: "memory");
    __syncthreads();
    if (threadIdx.x == 0) {
        unsigned* bar = b.bar;
        __builtin_amdgcn_s_waitcnt(0);
        unsigned nloc = b.st[0], nx = b.st[1];
        if (nloc == 0u) { xcd_barrier_complete(bar, b.x, nloc, nx); b.st[0] = nloc; b.st[1] = nx; }
        const unsigned old = xb_add(&bar[XB_XSUB(b.x)], 1u);
        const unsigned gen = old / nloc;
        if (old + 1u == (gen + 1u) * nloc) {
            __builtin_amdgcn_fence(__ATOMIC_RELEASE, "agent");
            asm volatile("s_waitcnt vmcnt(0)" ::: "memory");
            const unsigned og = xb_add(&bar[XB_TOP], 1u);
            const unsigned tg = og / nx;
            if (og + 1u == (tg + 1u) * nx) xb_add(&bar[XB_TOPGEN], 1u);
            else XB_SPIN(xb_ld(&bar[XB_TOPGEN]) == tg, bar);
            __builtin_amdgcn_fence(__ATOMIC_ACQUIRE, "agent");
            xb_add(&bar[XB_XGEN(b.x)], 1u);
            asm volatile("s_waitcnt vmcnt(0)" ::: "memory");
        } else {
            XB_SPIN(xb_ld(&bar[XB_XGEN(b.x)]) == gen, bar);
            __builtin_amdgcn_fence(__ATOMIC_ACQUIRE, "agent");
            asm volatile("s_waitcnt vmcnt(0)" ::: "memory");
        }
    }
    __syncthreads();
}

struct Args { const float* in[22]; float* out; unsigned char* ws; int ph_lo, ph_hi; };

__device__ __forceinline__ float wave_sum(float v) { return xl::sum64(v); }
__device__ __forceinline__ unsigned pk2(float lo, float hi) { return pg8::cvt_pk_bf16(lo, hi); }
__device__ __forceinline__ void p0_transpose_item(const float* W, int ldw, int col0, int K, int N, const float* gain, bf16* WT, LAS float* scr, int item, int lane) {
    const int nblk = N / 32, kb = item / nblk, nb = item % nblk, k0 = 64 * kb, n0 = 32 * nb;
#pragma unroll 8
    for (int i = 0; i < 32; ++i) { const int kk = 2 * i + (lane >> 5); const float g = gain ? gain[k0 + kk] : 1.f; scr[kk * 33 + (lane & 31)] = W[(size_t)(k0 + kk) * ldw + col0 + n0 + (lane & 31)] * g; }
    asm volatile("s_waitcnt lgkmcnt(0)" ::: "memory");
    const int c = lane & 7;
#pragma unroll
    for (int j = 0; j < 4; ++j) { const int n = (lane >> 3) + 8 * j; const LAS float* s = scr + (8 * c) * 33 + n;
        v4u o; o.x = pk2(s[0 * 33], s[1 * 33]); o.y = pk2(s[2 * 33], s[3 * 33]); o.z = pk2(s[4 * 33], s[5 * 33]); o.w = pk2(s[6 * 33], s[7 * 33]);
        *(v4u*)(WT + (size_t)(n0 + n) * K + k0 + 8 * c) = o; }
    asm volatile("s_waitcnt lgkmcnt(0)" ::: "memory");
}
__device__ __forceinline__ const float* xrow(const Args& a, int m) { return m < TP ? a.in[0] + (size_t)m * D : a.in[1] + (size_t)(m - TP) * D; }

__global__ void __launch_bounds__(NWAVES * 64, 2) fwd_mega(Args args) {
    extern __shared__ __attribute__((aligned(16))) unsigned char lds[];
    cg::grid_group grid = cg::this_grid();
#define IN(k) (args.ph_lo <= (k) && (k) < args.ph_hi)
    volatile LAS unsigned* xst = (volatile LAS unsigned*)((LAS unsigned char*)lds + (LDS_BYTES - 16));
    if (threadIdx.x == 0) { xst[0] = 0u; xst[1] = 0u; }
    __syncthreads();
    const XcdBarrier xbar = xcd_barrier_post((unsigned*)args.ws, xst);
#define GSYNC() xcd_barrier(xbar)
    const int tid = threadIdx.x, lane = tid & 63, wave = __builtin_amdgcn_readfirstlane(tid >> 6);
    const int G = gridDim.x, bx = blockIdx.x; const int vcu = (G % 8 == 0) ? (bx % 8) * (G / 8) + bx / 8 : bx;
    unsigned char* ws = args.ws;
    LAS unsigned char* ldsl = (LAS unsigned char*)lds;
#define WF2 ((bf16*)(ws + WS_WF2))
#define WQKV ((bf16*)(ws + WS_WQKV))
#define WG ((bf16*)(ws + WS_WG))
#define WF ((bf16*)(ws + WS_WF))
#define WA ((bf16*)(ws + WS_WA))
#define WO ((bf16*)(ws + WS_WO))
#define WUP ((bf16*)(ws + WS_WUP))
#define WDN ((bf16*)(ws + WS_WDN))
#define WPLE ((bf16*)(ws + WS_WPLE))
#define WGATE ((bf16*)(ws + WS_WGATE))
#define ROPE ((float*)(ws + WS_ROPE))
#define UC ((bf16*)(ws + WS_UC))
#define SS ((float*)(ws + WS_SS))
#define XH ((bf16*)(ws + WS_XH))
#define GT ((bf16*)(ws + WS_GT))
#define QB ((bf16*)(ws + WS_Q))
#define KB ((bf16*)(ws + WS_V))
#define VB ((bf16*)(ws + WS_V) + (size_t)T * D)
#define FB ((bf16*)(ws + WS_F))
    const int gw = vcu * NWAVES + wave, NGW = G * NWAVES;
    const int gtid = bx * (NWAVES * 64) + tid, NGT = G * NWAVES * 64;

    using pg8::Gemm; using pg8::StaticOrder; using pg8::EpiGen; using pg8::ListOrder;
    LAS unsigned char* ring = ldsl;
    if (IN(0)) {
    {
        LAS float* scr = (LAS float*)(ldsl + wave * 16384);
        const float* w_in = args.in[5];
        constexpr int I_QKV = 16 * 96, I_G = 16 * 64, I_F = 8 * 32, I_A = 16 * 32, I_O = 16 * 32, I_UP = 16 * 128, I_DN = 64 * 32, I_PLE = 4 * 32, I_GATE = 16 * 32;
        constexpr int NITEMS = I_QKV + I_G + I_F + I_A + I_O + I_UP + I_DN + I_PLE + I_GATE;
        for (int it = gw; it < NITEMS; it += NGW) {
            int r = it;
            if (r < I_QKV) { p0_transpose_item(w_in, INW, 512, D, 3072, args.in[4], WQKV, scr, r, lane); continue; } r -= I_QKV;
            if (r < I_G) { p0_transpose_item(w_in, INW, 3584, D, 2048, args.in[4], WG, scr, r, lane); continue; } r -= I_G;
            if (r < I_F) { p0_transpose_item(args.in[6], D, 0, 512, D, nullptr, WF, scr, r, lane); continue; } r -= I_F;
            if (r < I_A) { p0_transpose_item(args.in[7], D, 0, D, D, nullptr, WA, scr, r, lane); continue; } r -= I_A;
            if (r < I_O) { p0_transpose_item(args.in[8], D, 0, D, D, nullptr, WO, scr, r, lane); continue; } r -= I_O;
            if (r < I_UP) { p0_transpose_item(args.in[16], FF, 0, D, FF, args.in[15], WUP, scr, r, lane); continue; } r -= I_UP;
            if (r < I_DN) { p0_transpose_item(args.in[17], D, 0, FF, D, nullptr, WDN, scr, r, lane); continue; } r -= I_DN;
            if (r < I_PLE) { p0_transpose_item(args.in[19], D, 0, PLE, D, nullptr, WPLE, scr, r, lane); continue; } r -= I_PLE;
            p0_transpose_item(args.in[20], D, 0, D, D, nullptr, WGATE, scr, r, lane);
        }
        __syncthreads();
        {
            LAS float* Wt = (LAS float*)ldsl;
            LAS float* ctab = (LAS float*)(ldsl + 8192);
            for (int item = bx; item < 256; item += G) {
                const int grp = item >> 6, k0 = (item & 63) * 16;
                for (int e = tid; e < 2048; e += NWAVES * 64) { const int kk = e >> 7, c = e & 127; Wt[c * 16 + kk] = w_in[(size_t)(k0 + kk) * INW + grp * 128 + c] * args.in[4][k0 + kk]; }
                if (tid < 128) ctab[tid] = __builtin_amdgcn_cosf((float)tid * (1.0f / 128.0f));
                __syncthreads();
                const int m = tid & 127, comp = (tid >> 7) & 1, kh = tid >> 8;
                float acc[8];
#pragma unroll
                for (int i = 0; i < 8; ++i) acc[i] = 0.f;
                for (int c = 0; c < 128; ++c) { const float t = ctab[(c * m + (comp ? 96 : 0)) & 127]; const LAS f32x4* wp = (const LAS f32x4*)(Wt + c * 16 + kh * 8); const f32x4 w0 = wp[0], w1 = wp[1];
#pragma unroll
                    for (int i = 0; i < 4; ++i) { acc[i] += w0[i] * t; acc[4 + i] += w1[i] * t; } }
                v4u o; o.x = pk2(acc[0], acc[1]); o.y = pk2(acc[2], acc[3]); o.z = pk2(acc[4], acc[5]); o.w = pk2(acc[6], acc[7]);
                *(v4u*)(WF2 + (size_t)(comp * 512 + grp * 128 + m) * D + k0 + kh * 8) = o;
                __syncthreads();
            }
        }
        { bf16* A1S = (bf16*)(ws + WS_A1S); bf16* A1P = (bf16*)(ws + WS_A1P); bf16* A2S = (bf16*)(ws + WS_A2S); bf16* A2P = (bf16*)(ws + WS_A2P);
          for (int it = gtid; it < 128 * 128 * 128; it += NGT) { const int k = it & 127, m = (it >> 7) & 127, s2 = it >> 14; const int ri = m >> 6, k1 = m & 63, comp = k >> 6, s1 = k & 63;
              const float fr = (float)((k1 * (128 * s1 + s2)) & 8191) * (1.0f / 8192.0f); const float c = __builtin_amdgcn_cosf(fr), s = __builtin_amdgcn_sinf(fr);
              const float v = ri == 0 ? (comp == 0 ? c : -s) : (comp == 0 ? -s : -c); A1S[it] = (bf16)(pk2(v, v) & 0xffffu); }
          for (int it = gtid; it < 64 * 64 * 64; it += NGT) { const int k = it & 63, m = (it >> 6) & 63, s2 = it >> 12; const int ri = m >> 5, k1 = m & 31, comp = k >> 5, s1 = k & 31;
              const float fr = (float)((k1 * (64 * s1 + s2)) & 2047) * (1.0f / 2048.0f); const float c = __builtin_amdgcn_cosf(fr), s = __builtin_amdgcn_sinf(fr);
              const float v = ri == 0 ? (comp == 0 ? c : -s) : (comp == 0 ? -s : -c); A1P[it] = (bf16)(pk2(v, v) & 0xffffu); }
          for (int it = gtid; it < 128 * 256; it += NGT) { const int k = it & 255, k2 = it >> 8; const int ri = k >> 7, s2 = k & 127;
              const float fr = (float)((k2 * s2) & 127) * (1.0f / 128.0f); const float v = ri == 0 ? __builtin_amdgcn_cosf(fr) : __builtin_amdgcn_sinf(fr); A2S[it] = (bf16)(pk2(v, v) & 0xffffu); }
          for (int it = gtid; it < 64 * 128; it += NGT) { const int k = it & 127, k2 = it >> 7; const int ri = k >> 6, s2 = k & 63;
              const float fr = (float)((k2 * s2) & 63) * (1.0f / 64.0f); const float v = ri == 0 ? __builtin_amdgcn_cosf(fr) : __builtin_amdgcn_sinf(fr); A2P[it] = (bf16)(pk2(v, v) & 0xffffu); }
        }
        if (gtid < 65536) { const int pos = gtid >> 3, i = gtid & 7;
            const double ifr[8] = {0.15915494309189535, 0.03086376340470123, 0.005985185712713705, 0.001160663641240061, 0.00022507907903927653, 4.364795279280289e-05, 8.464330808241401e-06, 1.6414262627950345e-06};
            double rev = (double)pos * (i == 0 ? ifr[0] : i == 1 ? ifr[1] : i == 2 ? ifr[2] : i == 3 ? ifr[3] : i == 4 ? ifr[4] : i == 5 ? ifr[5] : i == 6 ? ifr[6] : ifr[7]);
            rev -= (double)(long long)rev; const float fr = (float)rev;
            ROPE[pos * 16 + i] = __builtin_amdgcn_cosf(fr); ROPE[pos * 16 + 8 + i] = __builtin_amdgcn_sinf(fr); }
        for (int m = gw; m < T; m += NGW) { const f32x4* xr = (const f32x4*)xrow(args, m) + lane; f32x4 v[4]; float s = 0.f;
#pragma unroll
            for (int j = 0; j < 4; ++j) { v[j] = xr[64 * j]; s += (v[j].x * v[j].x + v[j].y * v[j].y) + (v[j].z * v[j].z + v[j].w * v[j].w); }
            const float ms = wave_sum(s) * (1.f / D) + EPS; const float rs = __builtin_amdgcn_rsqf(ms);
            if (lane == 0) ((float*)(ws + 63 * MiB))[m] = ms * rs;
            unsigned long long* o8 = (unsigned long long*)(XH + (size_t)m * D) + lane;
#pragma unroll
            for (int j = 0; j < 4; ++j) o8[64 * j] = (unsigned long long)pk2(v[j].x * rs, v[j].y * rs) | ((unsigned long long)pk2(v[j].z * rs, v[j].w * rs) << 32); }
    }
    if (IN(0) && IN(1)) { asm volatile("s_waitcnt vmcnt(0)" ::: "memory"); grid.sync(); }

    }

    if (IN(1)) {
    {
        Gemm g{XH, WF2, T, 4096, D}; StaticOrder S; S.init(T, 4096, G, bx); pg8::EpiQKV E{GT, QB, KB, (size_t)T * D, ROPE};
        pg8::gemm_phase<pg8::EpiQKV, StaticOrder, true, true>(ring, g, S, E);
    }
    if (IN(1) && IN(2)) GSYNC();

    }
#define GF GT
#define GA ((bf16*)(ws + WS_V))
#define Y1 ((bf16*)(ws + WS_UC))
#define MG GT
#define ATT QB
    if (IN(2)) {
    {
        float lam;
        { const float a = wave_sum(args.in[9][lane] * args.in[10][lane]), b = wave_sum(args.in[11][lane] * args.in[12][lane]); lam = __expf(a) - __expf(b) + 0.2f; }
        float* stash = (float*)(ws + WS_STASH) + (size_t)bx * 32768;
        const int NCU = G;
        const int ppc = (2048 + NCU - 1) / NCU, spc = (512 + NCU - 1) / NCU;
#ifdef DBG_ATT2
        for (int pass2 = 0; pass2 < 2; ++pass2)
#else
        const int pass2 = 1;
#endif
        for (int i = 0; i < ppc + spc; ++i) { const bool smp = i >= ppc; int bh, qb;
            if (NCU == 256) { if (smp) { bh = (vcu >> 5) + 8 * (i - ppc); qb = vcu & 31; } else { bh = (vcu >> 3) + 32 * i; qb = vcu & 7; } }
            else { const int ui = smp ? vcu * spc + (i - ppc) : vcu * ppc + i; if (ui >= (smp ? 512 : 2048)) continue; const int lq = smp ? 5 : 3; bh = ui >> lq; qb = ui & ((1 << lq) - 1); }
            const int b = bh >> 3, h = bh & 7; const int seq = smp ? 8192 : 2048;
            const size_t r0 = (smp ? (size_t)TP : 0) + (size_t)b * seq; const size_t qo = (r0 + qb * 256) * D + h * 128, ko = r0 * D + h * 128;
            att::attn_unit(QB + qo, KB + ko, VB + ko, (pass2 ? QB : UC) + qo, seq, (char*)lds, stash, lam, args.in[13]); }
        __syncthreads();
        { const bf16* A1S = (const bf16*)(ws + WS_A1S); const bf16* A1P = (const bf16*)(ws + WS_A1P); bf16* US = UC + (size_t)131072 * 512;
          for (int ui = vcu; ui < 256 + 2048; ui += NCU) {
            if (ui < 256) { const int b = ui >> 7, s2 = ui & 127;
                ct::unit<4>(A1S + (size_t)s2 * 128 * 128, 128, GT + ((size_t)TP + (size_t)b * 8192 + s2) * 1024, 64, 128L * 1024, 512L, US + ((size_t)b * 64 * 2 * 128 + s2) * 512, 64, 2L * 128 * 512, 128L * 512, 1.0f, (char*)lds); }
            else { const int up = ui - 256, b = up >> 6, s2 = up & 63;
                ct::unit<2>(A1P + (size_t)s2 * 64 * 64, 64, GT + ((size_t)b * 2048 + s2) * 1024, 32, 64L * 1024, 512L, UC + ((size_t)b * 32 * 2 * 64 + s2) * 512, 32, 2L * 64 * 512, 64L * 512, 1.0f, (char*)lds); }
          } }
    }
    if (IN(2) && IN(3)) GSYNC();

    }

    if (IN(3)) {
    {
        const bf16* A2S = (const bf16*)(ws + WS_A2S); const bf16* A2P = (const bf16*)(ws + WS_A2P); const bf16* US = UC + (size_t)131072 * 512;
        for (int ui = vcu; ui < 128 + 1024; ui += G) {
            if (ui < 128) { const int b = ui >> 6, k1 = ui & 63;
                ct::unit<4>(A2S, 256, US + ((size_t)(b * 64 + k1) * 2 * 128) * 512, 256, 512L, 0L, FB + ((size_t)TP + (size_t)b * 8192 + k1) * 512, 128, 64L * 512, 0L, 1.0f / 1024.0f, (char*)lds); }
            else { const int up = ui - 128, b = up >> 5, k1 = up & 31;
                ct::unit<2>(A2P, 128, UC + ((size_t)(b * 32 + k1) * 2 * 64) * 512, 128, 512L, 0L, FB + ((size_t)b * 2048 + k1) * 512, 64, 32L * 512, 0L, 1.0f / 512.0f, (char*)lds); }
        }
    }
    {
        Gemm g{XH, WG, T, 2048, D}; StaticOrder S; S.init(T, 2048, G, bx); EpiGen<1> E{GF, D, nullptr, nullptr, nullptr, 1.f, (size_t)(WS_V - WS_GT) / 2};
        pg8::gemm_phase<EpiGen<1>, StaticOrder, true, true>(ring, g, S, E);
    }
    if (IN(3) && IN(4)) GSYNC();

    }

    if (IN(4)) {
    {
        Gemm g{FB, WF, T, D, 512}; StaticOrder S; S.init(T, D, G, bx); EpiGen<2> E{Y1, D, GF, nullptr, nullptr, 1.f, 0};
        pg8::gemm_phase<EpiGen<2>, StaticOrder, true, true>(ring, g, S, E);
    }

    }

    if (IN(5)) {
    {
        Gemm g{ATT, WA, T, D, D}; StaticOrder S; S.init(T, D, G, bx); EpiGen<3> E{MG, D, Y1, GA, nullptr, 1.f, 0};
        pg8::gemm_phase<EpiGen<3>, StaticOrder, true, true>(ring, g, S, E);
    }
    if (IN(5) && IN(6)) GSYNC();

    }
#define Z XH
#define Z4 UC
    if (IN(6)) {
    {
        Gemm g{MG, WO, T, D, D}; StaticOrder S; S.init(T, D, G, bx); EpiGen<4> E{Z4, D, nullptr, nullptr, SS, 1.f, 0};
        pg8::gemm_phase<EpiGen<4>, StaticOrder, true, true>(ring, g, S, E);
    }
    if (IN(6) && IN(7)) GSYNC();

    }
#define H2 GT
    if (IN(7)) {
    { int ln_ = threadIdx.x; asm volatile("" : "+v"(ln_)); const int lane = ln_ & 63;
    for (int m = gw; m < T; m += NGW) {
        const float* sp = SS + (size_t)m * 16; float s = (lane < 16) ? sp[lane] : 0.f; const float rs = __builtin_amdgcn_rsqf(wave_sum(s) * (1.f / D) + EPS);
        const unsigned long long* xr = (const unsigned long long*)(XH + (size_t)m * D) + lane; const float xs = ((const float*)(ws + 63 * MiB))[m]; const unsigned long long* zr = (const unsigned long long*)(Z4 + (size_t)m * D) + lane; const f32x4* gr = (const f32x4*)args.in[14] + lane;
        f32x4 v[4]; float s2 = 0.f;
#pragma unroll
        for (int j = 0; j < 4; ++j) { const unsigned long long zz = zr[64 * j]; const f32x4 gg = gr[64 * j]; const unsigned long long xq = xr[64 * j];
            f32x4 xx; xx.x = __uint_as_float((unsigned)xq << 16) * xs; xx.y = __uint_as_float((unsigned)xq & 0xffff0000u) * xs; xx.z = __uint_as_float((unsigned)(xq >> 32) << 16) * xs; xx.w = __uint_as_float((unsigned)(xq >> 32) & 0xffff0000u) * xs;
            f32x4 z; z.x = __uint_as_float((unsigned)zz << 16); z.y = __uint_as_float((unsigned)zz & 0xffff0000u); z.z = __uint_as_float((unsigned)(zz >> 32) << 16); z.w = __uint_as_float((unsigned)(zz >> 32) & 0xffff0000u);
            v[j] = xx + z * rs * gg; s2 += (v[j].x * v[j].x + v[j].y * v[j].y) + (v[j].z * v[j].z + v[j].w * v[j].w); }
        const float rs2 = __builtin_amdgcn_rsqf(wave_sum(s2) * (1.f / D) + EPS);
        unsigned long long* x8 = (unsigned long long*)((bf16*)args.out + (size_t)m * D) + lane; unsigned long long* h8 = (unsigned long long*)(H2 + (size_t)m * D) + lane;
#pragma unroll
        for (int j = 0; j < 4; ++j) { x8[64 * j] = (unsigned long long)pk2(v[j].x, v[j].y) | ((unsigned long long)pk2(v[j].z, v[j].w) << 32); h8[64 * j] = (unsigned long long)pk2(v[j].x * rs2, v[j].y * rs2) | ((unsigned long long)pk2(v[j].z * rs2, v[j].w * rs2) << 32); }
    }
    }
    if (IN(7) && IN(8)) GSYNC();

    }
#define U ((bf16*)(ws + WS_U))
    if (IN(8)) {
    {
        Gemm g{H2, WUP, T, FF, D}; StaticOrder S; S.init(T, FF, G, bx); EpiGen<5> E{U, FF, nullptr, nullptr, nullptr, 1.f, 0};
        pg8::gemm_phase<EpiGen<5>, StaticOrder, true, true>(ring, g, S, E);
    }
    if (IN(8) && IN(9)) GSYNC();

    }

    if (IN(9)) {
    {
        Gemm g{U, WDN, T, D, FF}; StaticOrder S; S.init(T, D, G, bx); EpiGen<4> E{Z, D, nullptr, nullptr, SS, 1.f, 0};
        pg8::gemm_phase<EpiGen<4>, StaticOrder, true, true>(ring, g, S, E);
    }
    if (IN(9) && IN(10)) GSYNC();

    }
#define X2B GT
#define PB ((bf16*)(ws + WS_PB))
    if (IN(10)) {
    { int ln_ = threadIdx.x; asm volatile("" : "+v"(ln_)); const int lane = ln_ & 63;
    for (int m = gw; m < T; m += NGW) {
        const float* sp = SS + (size_t)m * 16; float s = (lane < 16) ? sp[lane] : 0.f; const float rs = __builtin_amdgcn_rsqf(wave_sum(s) * (1.f / D) + EPS);
        const unsigned long long* x8 = (const unsigned long long*)((const bf16*)args.out + (size_t)m * D) + lane; const unsigned long long* zr = (const unsigned long long*)(Z + (size_t)m * D) + lane; const f32x4* gr = (const f32x4*)args.in[18] + lane;
        unsigned long long* h8 = (unsigned long long*)(X2B + (size_t)m * D) + lane;
#pragma unroll
        for (int j = 0; j < 4; ++j) { const unsigned long long zz = zr[64 * j]; const f32x4 gg = gr[64 * j]; const unsigned long long xb = x8[64 * j]; f32x4 xx; xx.x = __uint_as_float((unsigned)xb << 16); xx.y = __uint_as_float((unsigned)xb & 0xffff0000u); xx.z = __uint_as_float((unsigned)(xb >> 32) << 16); xx.w = __uint_as_float((unsigned)(xb >> 32) & 0xffff0000u);
            f32x4 z; z.x = __uint_as_float((unsigned)zz << 16); z.y = __uint_as_float((unsigned)zz & 0xffff0000u); z.z = __uint_as_float((unsigned)(zz >> 32) << 16); z.w = __uint_as_float((unsigned)(zz >> 32) & 0xffff0000u);
            const f32x4 v = xx + z * rs * gg; h8[64 * j] = (unsigned long long)pk2(v.x, v.y) | ((unsigned long long)pk2(v.z, v.w) << 32); }
        const float* prow = m < TP ? args.in[2] + (size_t)m * PLE : args.in[3] + (size_t)(m - TP) * PLE;
        const f32x4 pv = ((const f32x4*)prow)[lane];
        ((unsigned long long*)(PB + (size_t)m * PLE))[lane] = (unsigned long long)pk2(pv.x, pv.y) | ((unsigned long long)pk2(pv.z, pv.w) << 32);
    }
    }
    if (IN(10) && IN(11)) GSYNC();

    }
#define EP ((bf16*)(ws + WS_EP))
#define EB ((bf16*)(ws + WS_E))
    if (IN(11)) {
    {
        Gemm g{PB, WPLE, T, D, PLE}; StaticOrder S; S.init(T, D, G, bx); EpiGen<0> E{EP, D, nullptr, nullptr, nullptr, 1.f, 0};
        pg8::gemm_phase<EpiGen<0>, StaticOrder, true, true>(ring, g, S, E);
    }

    }

    if (IN(12)) {
    {
        Gemm g{X2B, WGATE, T, D, D}; StaticOrder S; S.init(T, D, G, bx); EpiGen<6> E{EB, D, EP, nullptr, SS, 1.f, 0};
        pg8::gemm_phase<EpiGen<6>, StaticOrder, true, true>(ring, g, S, E);
    }
    if (IN(12) && IN(13)) GSYNC();

    }

    if (IN(13)) {
    { int ln_ = threadIdx.x; asm volatile("" : "+v"(ln_)); const int lane = ln_ & 63;
    for (int m = gw; m < T; m += NGW) {
        const float* sp = SS + (size_t)m * 16; float s = (lane < 16) ? sp[lane] : 0.f; const float rs = __builtin_amdgcn_rsqf(wave_sum(s) * (1.f / D) + EPS);
        f32x4* orow = (f32x4*)(args.out + (size_t)m * D) + lane; const unsigned long long* x8 = (const unsigned long long*)(X2B + (size_t)m * D) + lane; const unsigned long long* zr = (const unsigned long long*)(EB + (size_t)m * D) + lane; const f32x4* gr = (const f32x4*)args.in[21] + lane;
#pragma unroll
        for (int j = 0; j < 4; ++j) { const unsigned long long zz = zr[64 * j]; const f32x4 gg = gr[64 * j]; const unsigned long long xb = x8[64 * j]; f32x4 xx; xx.x = __uint_as_float((unsigned)xb << 16); xx.y = __uint_as_float((unsigned)xb & 0xffff0000u); xx.z = __uint_as_float((unsigned)(xb >> 32) << 16); xx.w = __uint_as_float((unsigned)(xb >> 32) & 0xffff0000u);
            f32x4 z; z.x = __uint_as_float((unsigned)zz << 16); z.y = __uint_as_float((unsigned)zz & 0xffff0000u); z.z = __uint_as_float((unsigned)(zz >> 32) << 16); z.w = __uint_as_float((unsigned)(zz >> 32) & 0xffff0000u);
            orow[64 * j] = xx + z * rs * gg; }
    }
    }
    }

}


__global__ void __launch_bounds__(256) ck_kernel(const unsigned* buf, size_t nwords, unsigned* cs, int rep, unsigned* flag) {
    const size_t per = (nwords + gridDim.x - 1) / gridDim.x; const size_t lo = (size_t)blockIdx.x * per; size_t hi = lo + per; if (hi > nwords) hi = nwords;
    unsigned s = 0;
    for (size_t i = lo + threadIdx.x; i < hi; i += 256) { const unsigned w = buf[i]; s += w * 2654435761u + (w >> 7); }
    __shared__ unsigned red[256]; red[threadIdx.x] = s; __syncthreads();
    for (int o = 128; o > 0; o >>= 1) { if ((int)threadIdx.x < o) red[threadIdx.x] += red[threadIdx.x + o]; __syncthreads(); }
    if (threadIdx.x == 0) { if (rep == 0) cs[blockIdx.x] = red[0]; else if (cs[blockIdx.x] != red[0]) atomicOr(flag, 1u); }
}
__global__ void nanflag_kernel(float* out, const unsigned* flag) { if (*flag) out[0] = __builtin_nanf(""); }
__global__ void clrflag_kernel(unsigned* flag) { *flag = 0u; }
extern "C" void kernel_launch(void* const* d_in, const int* in_sizes, int n_in, void* d_out, int out_size, void* d_ws, size_t ws_size, hipStream_t stream) {
    static int grid = 0;
    if (grid == 0) {
        int dev = 0, cus = 0, per_cu = 0;
        hipGetDevice(&dev); hipDeviceGetAttribute(&cus, hipDeviceAttributeMultiprocessorCount, dev);
        hipFuncSetAttribute((const void*)fwd_mega, hipFuncAttributeMaxDynamicSharedMemorySize, LDS_BYTES);
        hipOccupancyMaxActiveBlocksPerMultiprocessor(&per_cu, (const void*)fwd_mega, NWAVES * 64, LDS_BYTES);
        if (per_cu < 1) per_cu = 1;
        grid = cus * per_cu;
        if (n_in != 22 || ws_size < (size_t)1008 * MiB) { fprintf(stderr, "kernel_launch: unexpected n_in %d / ws %zu\n", n_in, ws_size); }
    }
    hipMemsetAsync(d_ws, 0, 16384, stream);
    Args a{};
    for (int i = 0; i < 22; ++i) a.in[i] = (const float*)d_in[i];
    a.out = (float*)d_out; a.ws = (unsigned char*)d_ws;
#ifndef DBG_DOUBLE
#define DBG_DOUBLE 0
#endif
#ifndef N_LAUNCH_SPLIT
#define N_LAUNCH_SPLIT 0
#endif
    if (N_LAUNCH_SPLIT) {
#ifdef DBG_K
        unsigned char* w8 = (unsigned char*)d_ws; unsigned* flag = (unsigned*)(w8 + 512 * 1024); unsigned* cs = (unsigned*)(w8 + 600 * 1024);
        hipLaunchKernelGGL(clrflag_kernel, dim3(1), dim3(1), 0, stream, flag);
        for (int rep = 0; rep < 2; ++rep) {
            for (int p = (rep ? DBG_REP1_FROM : 0); p <= DBG_K; ++p) { a.ph_lo = p; a.ph_hi = p + 1; hipLaunchKernelGGL(fwd_mega, dim3(grid), dim3(NWAVES * 64), LDS_BYTES, stream, a); }
            const size_t offs[] = DBG_OFFS; const size_t lens[] = DBG_LENS; const int isout[] = DBG_ISOUT;
            for (int r = 0; r < (int)(sizeof(offs) / sizeof(offs[0])); ++r) {
                const unsigned char* base = isout[r] ? (const unsigned char*)d_out : w8;
                hipLaunchKernelGGL(ck_kernel, dim3(1024), dim3(256), 0, stream, (const unsigned*)(base + offs[r] * MiB), lens[r] * MiB / 4, cs + r * 1024, rep, flag); }
        }
        for (int p = DBG_K + 1; p < 14; ++p) { a.ph_lo = p; a.ph_hi = p + 1; hipLaunchKernelGGL(fwd_mega, dim3(grid), dim3(NWAVES * 64), LDS_BYTES, stream, a); }
        hipLaunchKernelGGL(nanflag_kernel, dim3(1), dim3(1), 0, stream, (float*)d_out, flag);
#else
        for (int p = 0; p < 14; ++p) { a.ph_lo = p; a.ph_hi = p + 1; const int reps = ((DBG_DOUBLE >> p) & 1) ? 2 : 1;
            for (int r = 0; r < reps; ++r) hipLaunchKernelGGL(fwd_mega, dim3(grid), dim3(NWAVES * 64), LDS_BYTES, stream, a); }
#endif
    } else {
        a.ph_lo = 0; a.ph_hi = 14;
        void* kargs[] = {&a};
        hipError_t e = hipLaunchCooperativeKernel((const void*)fwd_mega, dim3(grid), dim3(NWAVES * 64), kargs, LDS_BYTES, stream);
        if (e != hipSuccess) fprintf(stderr, "cooperative launch failed: %s (grid %d)\n", hipGetErrorString(e), grid);
    }
}
```

```cpp
#include <hip/hip_runtime.h>
#include <hip/hip_cooperative_groups.h>
#include <hip/hip_bf16.h>
#include <cstdio>
#include <cstdint>
namespace cg = cooperative_groups;

namespace xl {
__device__ __forceinline__ float dpp_f(float v, const int ctrl_sel) {
    int x = __builtin_bit_cast(int, v), r;
    if (ctrl_sel == 0) r = __builtin_amdgcn_mov_dpp(x, 0xB1, 0xF, 0xF, true);
    else if (ctrl_sel == 1) r = __builtin_amdgcn_mov_dpp(x, 0x4E, 0xF, 0xF, true);
    else if (ctrl_sel == 2) r = __builtin_amdgcn_mov_dpp(x, 0x141, 0xF, 0xF, true);
    else r = __builtin_amdgcn_mov_dpp(x, 0x140, 0xF, 0xF, true);
    return __builtin_bit_cast(float, r);
}
__device__ __forceinline__ float sum16(float v) { v += dpp_f(v, 0); v += dpp_f(v, 1); v += dpp_f(v, 2); v += dpp_f(v, 3); return v; }
__device__ __forceinline__ float add_x16(float v) { auto r = __builtin_amdgcn_permlane16_swap(__float_as_uint(v), __float_as_uint(v), false, false); return __uint_as_float(r[0]) + __uint_as_float(r[1]); }
__device__ __forceinline__ float add_x32(float v) { auto r = __builtin_amdgcn_permlane32_swap(__float_as_uint(v), __float_as_uint(v), false, false); return __uint_as_float(r[0]) + __uint_as_float(r[1]); }
__device__ __forceinline__ float get_x16(float v, bool odd_row) { auto r = __builtin_amdgcn_permlane16_swap(__float_as_uint(v), __float_as_uint(v), false, false); return __uint_as_float(odd_row ? r[0] : r[1]); }
__device__ __forceinline__ float sum32(float v) { return add_x16(sum16(v)); }
__device__ __forceinline__ float sum64(float v) { return add_x32(add_x16(sum16(v))); }
}
namespace pg8 {
#define PG8_LAS __attribute__((address_space(3)))
typedef unsigned short bf16_t;
typedef short bf16x8 __attribute__((ext_vector_type(8)));
typedef float f32x4 __attribute__((ext_vector_type(4)));
typedef unsigned u32x4 __attribute__((ext_vector_type(4)));
constexpr int BM = 256, BK = 64, HALF = 128, HTB = HALF * BK * 2  , STAGE_BYTES = 8 * HTB, NXCD = 8, WGM = 8;

__host__ __device__ __forceinline__ int lds_byte(int r, int c) { const int st = (r >> 4) * 2 + (c >> 5), rr = r & 15, cc = c & 31, ob = rr * 64 + cc * 2; return st * 1024 + (ob ^ (((ob >> 9) & 1) << 5)); }
__host__ __device__ __forceinline__ void stage_rc(int b, int& R, int& C) { const int st = b / 1024, sb = b % 1024, swz = sb ^ (((sb >> 9) & 1) << 5); R = (st >> 1) * 16 + swz / 64; C = (st & 1) * 32 + (swz % 64) / 2; }
__host__ __device__ __forceinline__ int perm32(int rho) { const int n = rho >> 4, i = rho & 15; return 8 * (i >> 2) + 4 * n + (i & 3); }

struct Unit { int pm, pn; };
struct Gemm { const bf16_t* A; const bf16_t* Bt; int M, N, K; };

struct StaticOrder {
    int nM, nN, nwg, G, c;
    __host__ __device__ void init(int M, int N, int G_, int c_) { nM = M / BM; nN = N / BM; nwg = nM * nN; G = G_; c = c_; }
    __host__ __device__ bool next(int i, Unit& u) const {
        const long L = (long)i * G + c; if (L >= nwg) return false;
        int wgid = (int)L; { const int q = nwg / NXCD, r = nwg % NXCD, xcd = wgid % NXCD, off = wgid / NXCD; wgid = (xcd < r ? xcd * (q + 1) : r * (q + 1) + (xcd - r) * q) + off; }
        const int nig = WGM * nN, gid = wgid / nig, fm = gid * WGM, gsz = (nM - fm) < WGM ? (nM - fm) : WGM;
        u.pm = fm + ((wgid % nig) % gsz); u.pn = (wgid % nig) / gsz; return true;
    }
    __device__ __forceinline__ void a_ready(const Unit&) const {}
    __device__ __forceinline__ void done(const Unit&) const {}
};

__device__ __forceinline__ unsigned cvt_pk_bf16(float lo, float hi) { unsigned r; asm volatile("s_nop 0\n\tv_cvt_pk_bf16_f32 %0, %1, %2" : "=v"(r) : "v"(lo), "v"(hi)); return r; }
__device__ __forceinline__ void unpack8(const u32x4 w, float (&f)[8]) {
#pragma unroll
    for (int i = 0; i < 4; ++i) { f[2 * i] = __uint_as_float(w[i] << 16); f[2 * i + 1] = __uint_as_float(w[i] & 0xffff0000u); }
}
__device__ __forceinline__ u32x4 pack8(const float (&f)[8]) { u32x4 w; w.x = cvt_pk_bf16(f[0], f[1]); w.y = cvt_pk_bf16(f[2], f[3]); w.z = cvt_pk_bf16(f[4], f[5]); w.w = cvt_pk_bf16(f[6], f[7]); return w; }
__device__ __forceinline__ float sigm(float x) { return __builtin_amdgcn_rcpf(1.0f + __builtin_amdgcn_exp2f(-1.4426950408889634f * x)); }
template <int MODE> struct EpiGen {
    static constexpr bool PERM = true, AFTER_DRAIN = false;
    bf16_t* O; int ldc; const bf16_t* X1; const bf16_t* X2; float* ss; float scale; size_t split_stride;
    __device__ __forceinline__ void operator()(const f32x4 (&acc)[2][2][4][2], const Unit& u, int wr_, int wc_, int fr_, int fq_) const {
        int t_ = threadIdx.x; asm volatile("" : "+v"(t_));
        const int wid_ = __builtin_amdgcn_readfirstlane(t_ >> 6), wr = wid_ >> 2, wc = wid_ & 3, fr = t_ & 15, fq = (t_ >> 4) & 3;
        const int row0 = u.pm * BM + wr * 64 + fr; int colt = u.pn * BM; bf16_t* base = O;
        if (MODE == 1) { const int t = colt >> 10; base += (size_t)t * split_stride; colt -= t << 10; }
        const int col0 = colt + wc * 32 + 8 * fq;
#pragma unroll
        for (int ai = 0; ai < 2; ++ai)
#pragma unroll
            for (int m = 0; m < 4; ++m) { const int row = row0 + ai * HALF + m * 16; const size_t ro = (size_t)row * ldc + col0; float sq = 0.f;
#pragma unroll
                for (int bj = 0; bj < 2; ++bj) { float v[8];
#pragma unroll
                    for (int i = 0; i < 4; ++i) { v[i] = acc[ai][bj][m][0][i]; v[4 + i] = acc[ai][bj][m][1][i]; }
                    const size_t off = ro + bj * HALF;
                    if (MODE == 1) {
#pragma unroll
                        for (int i = 0; i < 8; ++i) v[i] = sigm(v[i]); }
                    if (MODE == 2) { float a[8]; unpack8(*(const u32x4*)(X1 + off), a);
#pragma unroll
                        for (int i = 0; i < 8; ++i) v[i] *= a[i]; }
                    if (MODE == 3) { float a[8], b[8]; unpack8(*(const u32x4*)(X1 + off), a); unpack8(*(const u32x4*)(X2 + off), b);
#pragma unroll
                        for (int i = 0; i < 8; ++i) v[i] = a[i] + b[i] * v[i]; }
                    if (MODE == 5) {
#pragma unroll
                        for (int i = 0; i < 8; ++i) { const float r = fmaxf(v[i], 0.f); v[i] = r * r; } }
                    if (MODE == 6) { float a[8]; unpack8(*(const u32x4*)(X1 + off), a);
#pragma unroll
                        for (int i = 0; i < 8; ++i) v[i] = a[i] * sigm(v[i]); }
                    if (MODE == 4 || MODE == 6) {
#pragma unroll
                        for (int i = 0; i < 8; ++i) sq += v[i] * v[i]; }
                    *(u32x4*)(base + off) = pack8(v); }
                if (MODE == 4 || MODE == 6) { sq = xl::add_x32(xl::add_x16(sq)); if (fq == 0) ss[(size_t)row * 16 + u.pn * 4 + wc] = sq; }
            }
    }
};
struct EpiGT {
    static constexpr bool PERM = true, AFTER_DRAIN = false;
    bf16_t* GT;
    __device__ __forceinline__ void operator()(const f32x4 (&acc)[2][2][4][2], const Unit& u, int wr, int wc, int fr, int fq) const {
        const int n0 = u.pm * BM + wr * 64 + fr; const int t0 = u.pn * BM + wc * 32 + 8 * fq;
#pragma unroll
        for (int bj = 0; bj < 2; ++bj) { const int t = t0 + bj * HALF; size_t tb; int S, s, b;
            if (t < 65536) { b = t >> 11; s = t & 2047; S = 2048; tb = 0; } else { const int tt = t - 65536; b = tt >> 13; s = tt & 8191; S = 8192; tb = (size_t)65536 * 1024; }
#pragma unroll
            for (int ai = 0; ai < 2; ++ai)
#pragma unroll
                for (int m = 0; m < 4; ++m) { const int n = n0 + ai * HALF + m * 16, comp = n >> 9, c = n & 511; float v[8];
#pragma unroll
                    for (int i = 0; i < 4; ++i) { v[i] = acc[ai][bj][m][0][i]; v[4 + i] = acc[ai][bj][m][1][i]; }
                    *(u32x4*)(GT + tb + ((size_t)(b * 512 + c) * 2 + comp) * S + s) = pack8(v); } }
    }
};
struct EpiQKV {
    static constexpr bool PERM = true, AFTER_DRAIN = false;
    bf16_t* Gb; bf16_t* Q; bf16_t* K; size_t vstride; const float* rope;
    __device__ __forceinline__ void operator()(const f32x4 (&acc)[2][2][4][2], const Unit& u, int wr, int wc, int fr, int fq) const {
        const int row0 = u.pm * BM + wr * 64 + fr; int colt = u.pn * BM; const int t = colt >> 10; bf16_t* base = (t == 0) ? Gb : ((t == 1) ? Q : (K + (size_t)(t - 2) * vstride)); colt -= t << 10;
        const int col0 = colt + wc * 32 + 8 * fq; const bool rot = (t == 1 || t == 2) && ((wc & 1) == 0);
        if (rot) {
#pragma unroll
            for (int ai = 0; ai < 2; ++ai) {
                f32x4 rc[4][4];
#pragma unroll
                for (int m = 0; m < 4; ++m) { const int row = row0 + ai * HALF + m * 16; const int pos = row < 65536 ? (row & 2047) : (row & 8191); const f32x4* rp = (const f32x4*)(rope + (size_t)pos * 16);
#pragma unroll
                    for (int j = 0; j < 4; ++j) rc[m][j] = rp[j]; }
#pragma unroll
                for (int m = 0; m < 4; ++m) { const int row = row0 + ai * HALF + m * 16; const size_t ro = (size_t)row * 1024 + col0;
#pragma unroll
                    for (int bj = 0; bj < 2; ++bj) { float v[8];
#pragma unroll
                        for (int i = 0; i < 4; ++i) { v[i] = acc[ai][bj][m][0][i]; v[4 + i] = acc[ai][bj][m][1][i]; }
#pragma unroll
                        for (int i = 0; i < 8; ++i) { const float o = xl::get_x16(v[i], (fq & 1) != 0); const float c = rc[m][i >> 2][i & 3], s = rc[m][2 + (i >> 2)][i & 3];
                            const float r = (fq == 0) ? (v[i] * c - o * s) : (v[i] * c + o * s);
                            v[i] = (fq < 2) ? r : v[i]; }
                        *(u32x4*)(base + ro + bj * HALF) = pack8(v); } }
            }
        } else {
#pragma unroll
            for (int ai = 0; ai < 2; ++ai)
#pragma unroll
                for (int m = 0; m < 4; ++m) { const int row = row0 + ai * HALF + m * 16; const size_t ro = (size_t)row * 1024 + col0;
#pragma unroll
                    for (int bj = 0; bj < 2; ++bj) { float v[8];
#pragma unroll
                        for (int i = 0; i < 4; ++i) { v[i] = acc[ai][bj][m][0][i]; v[4 + i] = acc[ai][bj][m][1][i]; }
                        *(u32x4*)(base + ro + bj * HALF) = pack8(v); } }
        }
    }
};
struct EpiDFT {
    static constexpr bool PERM = true, AFTER_DRAIN = false;
    bf16_t* F; int S; float scale;
    __device__ __forceinline__ void operator()(const f32x4 (&acc)[2][2][4][2], const Unit& u, int wr, int wc, int fr, int fq) const {
        const int b = u.pn >> 1, ct = u.pn & 1; const int row0 = b * S + u.pm * BM + wr * 64 + fr; const int col0 = ct * BM + wc * 32 + 8 * fq;
#pragma unroll
        for (int ai = 0; ai < 2; ++ai)
#pragma unroll
            for (int m = 0; m < 4; ++m) { const size_t ro = (size_t)(row0 + ai * HALF + m * 16) * 512 + col0;
#pragma unroll
                for (int bj = 0; bj < 2; ++bj) { float v[8];
#pragma unroll
                    for (int i = 0; i < 4; ++i) { v[i] = acc[ai][bj][m][0][i] * scale; v[4 + i] = acc[ai][bj][m][1][i] * scale; }
                    *(u32x4*)(F + ro + bj * HALF) = pack8(v); } }
    }
};
struct ListOrder {
    int base, count, nfast; bool pnfast;
    __device__ bool next(int i, Unit& u) const { if (i >= count) return false; const int idx = base + i; if (pnfast) { u.pn = idx % nfast; u.pm = idx / nfast; } else { u.pm = idx % nfast; u.pn = idx / nfast; } return true; }
    __device__ __forceinline__ void a_ready(const Unit&) const {}
    __device__ __forceinline__ void done(const Unit&) const {}
};
template <class Epi, class Sched, bool ALIGN_EPI = false, bool SP2 = false>
__device__ __forceinline__ void gemm_phase(PG8_LAS unsigned char* lds, const Gemm g, const Sched& S, const Epi& E) {
    int tid_ = threadIdx.x; asm volatile("" : "+v"(tid_));
    const int tid = tid_, wid = __builtin_amdgcn_readfirstlane(tid >> 6), lane = tid & 63, wr = wid >> 2, wc = wid & 3, fr = lane & 15, fq = lane >> 4;
    const int K = g.K, nt = K / BK;
    unsigned voffA[2], voffB[2];
#pragma unroll
    for (int i = 0; i < 2; ++i) { int R, C; stage_rc(tid * 16 + i * 8192, R, C); const int Rb = Epi::PERM ? ((R & ~31) + perm32(R & 31)) : R;
        voffA[i] = (unsigned)(R * K + C) * 2u; voffB[i] = (unsigned)(Rb * K + C) * 2u; }
    const size_t kstep = (size_t)(BK * 2);
    const size_t hstep = (size_t)HALF * K * 2;
    const size_t tstep = 2 * hstep;
    const unsigned ldsw = (unsigned)wid * 1024u;
    const int aoff = lds_byte(wr * 64 + fr, fq * 8), boff = lds_byte(wc * 32 + fr, fq * 8);
#define PG8_SA(b, h) (((b) * 2 + (h)) * HTB)
#define PG8_SB(b, h) ((4 + (b) * 2 + (h)) * HTB)
#define PG8_STAGE(bufoff, gbase, voff) do { _Pragma("unroll") for (int _i = 0; _i < 2; ++_i) \
        __builtin_amdgcn_global_load_lds((const unsigned*)((const char*)(gbase) + (voff)[_i]), (PG8_LAS unsigned*)(lds + (bufoff) + ldsw + _i * 8192), 16, 0, 0); } while (0)
#define PG8_LDA(dst, b, h) do { _Pragma("unroll") for (int m = 0; m < 4; ++m) _Pragma("unroll") for (int k = 0; k < 2; ++k) dst[m][k] = *(const PG8_LAS bf16x8*)(lds + PG8_SA(b, h) + aoff + m * 2048 + k * 1024); } while (0)
#define PG8_LDB(dst, b, h) do { _Pragma("unroll") for (int n = 0; n < 2; ++n) _Pragma("unroll") for (int k = 0; k < 2; ++k) dst[n][k] = *(const PG8_LAS bf16x8*)(lds + PG8_SB(b, h) + boff + n * 2048 + k * 1024); } while (0)
#define PG8_MMA(ai, bj, At, Bt) do { __builtin_amdgcn_s_setprio(1); _Pragma("unroll") for (int m = 0; m < 4; ++m) _Pragma("unroll") for (int n = 0; n < 2; ++n) _Pragma("unroll") for (int k = 0; k < 2; ++k) \
        acc[ai][bj][m][n] = __builtin_amdgcn_mfma_f32_16x16x32_bf16(Bt[n][k], At[m][k], acc[ai][bj][m][n], 0, 0, 0); __builtin_amdgcn_s_setprio(0); } while (0)
#define PG8_WAIT_V(n) asm volatile("s_waitcnt vmcnt(" #n ")" ::: "memory")
#define PG8_WAIT_L(n) asm volatile("s_waitcnt lgkmcnt(" #n ")" ::: "memory")
#define PG8_BAR __builtin_amdgcn_s_barrier()
#define PG8_SCHED __builtin_amdgcn_sched_barrier(0)
    Unit cur, nxt; int ui = 0;
    if (!S.next(0, cur)) return;
    f32x4 acc[2][2][4][2];
#pragma unroll
    for (int a = 0; a < 2; ++a)
#pragma unroll
        for (int b = 0; b < 2; ++b)
#pragma unroll
            for (int m = 0; m < 4; ++m)
#pragma unroll
                for (int n = 0; n < 2; ++n) acc[a][b][m][n] = (f32x4){0.f, 0.f, 0.f, 0.f};
    bf16x8 At[4][2], B0[2][2], B1[2][2];
    const char* cA = (const char*)g.A + (size_t)cur.pm * tstep; const char* cB = (const char*)g.Bt + (size_t)cur.pn * tstep;
    S.a_ready(cur);
    if constexpr (SP2) {
        PG8_STAGE(PG8_SB(0, 0), cB, voffB); PG8_STAGE(PG8_SB(0, 1), cB + hstep, voffB); PG8_STAGE(PG8_SA(0, 0), cA, voffA); PG8_STAGE(PG8_SA(0, 1), cA + hstep, voffA);
        if (wr == 1) PG8_BAR;
        PG8_WAIT_V(2); PG8_BAR;
        PG8_STAGE(PG8_SB(1, 0), cB + kstep, voffB); PG8_STAGE(PG8_SA(1, 0), cA + kstep, voffA); PG8_STAGE(PG8_SB(1, 1), cB + hstep + kstep, voffB);
        PG8_WAIT_V(6); PG8_BAR;
    } else {
        PG8_STAGE(PG8_SB(0, 0), cB, voffB); PG8_STAGE(PG8_SA(0, 0), cA, voffA); PG8_STAGE(PG8_SB(0, 1), cB + hstep, voffB); PG8_STAGE(PG8_SA(0, 1), cA + hstep, voffA);
        if (wr == 1) PG8_BAR;
        PG8_WAIT_V(4); PG8_BAR;
        PG8_STAGE(PG8_SB(1, 0), cB + kstep, voffB); PG8_STAGE(PG8_SA(1, 0), cA + kstep, voffA); PG8_STAGE(PG8_SB(1, 1), cB + hstep + kstep, voffB);
        PG8_WAIT_V(6); PG8_BAR;
    }
    for (;;) {
        const bool has_next = S.next(ui + 1, nxt);
        const char* nA = has_next ? (const char*)g.A + (size_t)nxt.pm * tstep : cA; const char* nB = has_next ? (const char*)g.Bt + (size_t)nxt.pn * tstep : cB;
        for (int t = 0; t < nt; t += 2) {
            const bool last = (t == nt - 2);
            const char* a1 = cA + (size_t)(t + 1) * kstep;
            const char* a2 = last ? nA : cA + (size_t)(t + 2) * kstep; const char* b2 = last ? nB : cB + (size_t)(t + 2) * kstep;
            const char* a3 = a2 + kstep; const char* b3 = b2 + kstep;
            if (last && has_next) S.a_ready(nxt);
            if constexpr (SP2) {
            PG8_LDB(B0, 0, 0); PG8_LDB(B1, 0, 1); PG8_SCHED; PG8_LDA(At, 0, 0); PG8_STAGE(PG8_SA(1, 1), a1 + hstep, voffA);
            PG8_WAIT_V(8); PG8_WAIT_L(0); PG8_BAR; PG8_MMA(0, 0, At, B0); PG8_MMA(0, 1, At, B1); PG8_BAR; PG8_SCHED;
            PG8_LDA(At, 0, 1); PG8_STAGE(PG8_SB(0, 0), b2, voffB); PG8_STAGE(PG8_SB(0, 1), b2 + hstep, voffB); PG8_STAGE(PG8_SA(0, 0), a2, voffA);
            PG8_WAIT_V(8); PG8_WAIT_L(0); PG8_BAR; PG8_MMA(1, 0, At, B0); PG8_MMA(1, 1, At, B1); PG8_BAR; PG8_SCHED;
            PG8_LDB(B0, 1, 0); PG8_LDB(B1, 1, 1); PG8_SCHED; PG8_LDA(At, 1, 0); PG8_STAGE(PG8_SA(0, 1), a2 + hstep, voffA);
            PG8_WAIT_V(8); PG8_WAIT_L(0); PG8_BAR; PG8_MMA(0, 0, At, B0); PG8_MMA(0, 1, At, B1); PG8_BAR; PG8_SCHED;
            PG8_LDA(At, 1, 1); PG8_STAGE(PG8_SB(1, 0), b3, voffB); PG8_STAGE(PG8_SB(1, 1), b3 + hstep, voffB); PG8_STAGE(PG8_SA(1, 0), a3, voffA);
            PG8_WAIT_V(8); PG8_WAIT_L(0); PG8_BAR; PG8_MMA(1, 0, At, B0); PG8_MMA(1, 1, At, B1); PG8_BAR; PG8_SCHED;
            } else {
            PG8_LDB(B0, 0, 0); PG8_SCHED; PG8_LDA(At, 0, 0); PG8_STAGE(PG8_SA(1, 1), a1 + hstep, voffA);
            PG8_WAIT_L(8); PG8_BAR; PG8_WAIT_L(0); PG8_MMA(0, 0, At, B0); PG8_BAR; PG8_SCHED;
            PG8_LDB(B1, 0, 1); PG8_STAGE(PG8_SB(0, 0), b2, voffB);
            PG8_BAR; PG8_WAIT_L(0); PG8_MMA(0, 1, At, B1); PG8_BAR;
            PG8_LDA(At, 0, 1); PG8_STAGE(PG8_SA(0, 0), a2, voffA);
            PG8_BAR; PG8_WAIT_L(0); PG8_MMA(1, 0, At, B0); PG8_BAR; PG8_SCHED;
            PG8_STAGE(PG8_SB(0, 1), b2 + hstep, voffB);
            PG8_WAIT_V(6); PG8_BAR; PG8_MMA(1, 1, At, B1); PG8_BAR;
            PG8_LDB(B0, 1, 0); PG8_SCHED; PG8_LDA(At, 1, 0); PG8_STAGE(PG8_SA(0, 1), a2 + hstep, voffA);
            PG8_WAIT_L(8); PG8_BAR; PG8_WAIT_L(0); PG8_MMA(0, 0, At, B0); PG8_BAR; PG8_SCHED;
            PG8_LDB(B1, 1, 1); PG8_STAGE(PG8_SB(1, 0), b3, voffB);
            PG8_BAR; PG8_WAIT_L(0); PG8_MMA(0, 1, At, B1); PG8_BAR;
            PG8_LDA(At, 1, 1); PG8_STAGE(PG8_SA(1, 0), a3, voffA);
            PG8_BAR; PG8_WAIT_L(0); PG8_MMA(1, 0, At, B0); PG8_BAR; PG8_SCHED;
            PG8_STAGE(PG8_SB(1, 1), b3 + hstep, voffB);
            PG8_WAIT_V(6); PG8_BAR; PG8_MMA(1, 1, At, B1); PG8_BAR;
            }
        }
        if constexpr (ALIGN_EPI) { if (wr == 0) PG8_BAR; }
        if constexpr (!Epi::AFTER_DRAIN) { E(acc, cur, wr, wc, fr, fq); S.done(cur); }
        if (!has_next) break;
#pragma unroll
        for (int a = 0; a < 2; ++a)
#pragma unroll
            for (int b = 0; b < 2; ++b)
#pragma unroll
                for (int m = 0; m < 4; ++m)
#pragma unroll
                    for (int n = 0; n < 2; ++n) acc[a][b][m][n] = (f32x4){0.f, 0.f, 0.f, 0.f};
        cur = nxt; cA = nA; cB = nB; ++ui;
        if constexpr (ALIGN_EPI) { if (wr == 1) PG8_BAR; }
    }
    PG8_WAIT_V(0);
    if constexpr (!ALIGN_EPI) { if (wr == 0) PG8_BAR; }
    PG8_BAR;
    if constexpr (Epi::AFTER_DRAIN) { E.fused(acc, cur, wr, wc, fr, fq, lds, wid, lane); S.done(cur); }
#undef PG8_SA
#undef PG8_SB
#undef PG8_STAGE
#undef PG8_LDA
#undef PG8_LDB
#undef PG8_MMA
#undef PG8_WAIT_V
#undef PG8_WAIT_L
#undef PG8_BAR
#undef PG8_SCHED
}
}
namespace att {
using bf16x8 = __attribute__((ext_vector_type(8))) short;
using s16x4  = __attribute__((ext_vector_type(4))) short;
using f32x16 = __attribute__((ext_vector_type(16))) float;
using u32x4  = __attribute__((ext_vector_type(4))) unsigned;
using f32x4v = __attribute__((ext_vector_type(4))) float;
typedef unsigned short bf16_t;
constexpr int NW = 8, QBLK = 32, KVBLK = 64, LD = 1024;
constexpr float SCALE = 0.125f, THR = 8.f;
constexpr int SHM_V = KVBLK * 128 * 2, SHM_K = KVBLK * 64 * 2, SHM_ATTN = 3 * SHM_V + 3 * SHM_K + NW * 64 * 4;
#define KSWZ(row, colB) ((row) * 128 + ((colB) ^ ((((row) >> 1) & 7) << 4)))
#define SBAR() __builtin_amdgcn_sched_barrier(0)
__device__ __forceinline__ int crow(int r, int hi) { return (r & 3) + 8 * (r >> 2) + 4 * hi; }
__device__ __forceinline__ unsigned cvtpk(float lo, float hi) { unsigned r; asm volatile("s_nop 0\n\tv_cvt_pk_bf16_f32 %0, %1, %2" : "=v"(r) : "v"(lo), "v"(hi)); return r; }
__device__ __forceinline__ void partialSM(f32x16& p0, f32x16& p1, float& m_reg, float& mn, float& alpha) {
  constexpr float C = SCALE * 1.4426950408889634f;
  float pmax = p0[0];
#pragma unroll
  for (int r = 1; r < 16; ++r) pmax = fmaxf(pmax, p0[r]);
#pragma unroll
  for (int r = 0; r < 16; ++r) pmax = fmaxf(pmax, p1[r]);
  { auto rr = __builtin_amdgcn_permlane32_swap(__float_as_uint(pmax), __float_as_uint(pmax), false, false);
    pmax = fmaxf(__uint_as_float(rr[0]), __uint_as_float(rr[1])); }
  if (__builtin_expect(__all(pmax - m_reg <= THR / SCALE), 1)) { mn = m_reg; alpha = 1.f; }
  else { mn = fmaxf(m_reg, pmax); alpha = __builtin_amdgcn_exp2f((m_reg - mn) * C); m_reg = mn; }
  float mnC = -mn * C;
#pragma unroll
  for (int r = 0; r < 16; ++r) p0[r] = fmaf(p0[r], C, mnC);
#pragma unroll
  for (int r = 0; r < 16; ++r) p1[r] = fmaf(p1[r], C, mnC);
#pragma unroll
  for (int r = 0; r < 16; ++r) p0[r] = __builtin_amdgcn_exp2f(p0[r]);
}
__device__ __forceinline__ void finishSM(f32x16& p0, f32x16& p1, float alpha, float& l_reg, bf16x8& pa0, bf16x8& pa1, bf16x8& pa2, bf16x8& pa3) {
#pragma unroll
  for (int r = 0; r < 16; ++r) p1[r] = __builtin_amdgcn_exp2f(p1[r]);
  float ps = 0;
#pragma unroll
  for (int r = 0; r < 16; ++r) ps += p0[r];
#pragma unroll
  for (int r = 0; r < 16; ++r) ps += p1[r];
  { auto rr = __builtin_amdgcn_permlane32_swap(__float_as_uint(ps), __float_as_uint(ps), false, false);
    ps = __uint_as_float(rr[0]) + __uint_as_float(rr[1]); }
  l_reg = l_reg * alpha + ps;
#define PK4(P, BASE, OUT) do { unsigned a0 = cvtpk(P[BASE + 0], P[BASE + 1]), a1 = cvtpk(P[BASE + 2], P[BASE + 3]);   \
    unsigned b0 = cvtpk(P[BASE + 4], P[BASE + 5]), b1 = cvtpk(P[BASE + 6], P[BASE + 7]);                              \
    auto r0 = __builtin_amdgcn_permlane32_swap(a0, b0, false, false); auto r1 = __builtin_amdgcn_permlane32_swap(a1, b1, false, false); \
    u32x4 w = {r0[0], r1[0], r0[1], r1[1]}; OUT = *reinterpret_cast<bf16x8*>(&w); } while (0)
  PK4(p0, 0, pa0); PK4(p0, 8, pa1); PK4(p1, 0, pa2); PK4(p1, 8, pa3);
#undef PK4
}
__device__ __forceinline__ void qkt(f32x16& p0, f32x16& p1, const char* Ks, const bf16x8* qr, int r32, int hi) {
  p0 = f32x16{}; p1 = f32x16{};
#pragma unroll
  for (int d0 = 0; d0 < 4; ++d0) { int cb = (d0 * 16 + hi * 8) * 2;
    bf16x8 b0 = *reinterpret_cast<const bf16x8*>(Ks + KSWZ(r32, cb));
    bf16x8 b1 = *reinterpret_cast<const bf16x8*>(Ks + KSWZ(32 + r32, cb));
    p0 = __builtin_amdgcn_mfma_f32_32x32x16_bf16(b0, qr[d0], p0, 0, 0, 0);
    p1 = __builtin_amdgcn_mfma_f32_32x32x16_bf16(b1, qr[d0], p1, 0, 0, 0); }
}
__device__ __forceinline__ int v_st(int k, int c) { const int kk = (k & ~0xC) | ((k & 4) << 1) | ((k & 8) >> 1); return ((kk >> 3) * 4 + (c >> 5)) * 512 + ((kk & 7) * 32 + (c & 31)) * 2; }
__device__ __forceinline__ int v_rd_base(int lane) { return ((lane & 3) << 3) | (((lane >> 2) & 3) << 6) | (((lane >> 4) & 1) << 5) | (((lane >> 5) & 1) << 8); }
constexpr int v_rd_off(int d0, int ks, int half) { return d0 * 512 + ks * 4096 + half * 2048; }
template <int OFF> __device__ __forceinline__ s16x4 tr_read(int vb) {
  s16x4 r; asm volatile("ds_read_b64_tr_b16 %0, %1 offset:%2" : "=&v"(r) : "v"(vb), "i"(OFF) : "memory"); return r;
}
template <int D0> __device__ __forceinline__ void pv_one(f32x16& od, int vb, bf16x8 pa0, bf16x8 pa1, bf16x8 pa2, bf16x8 pa3) {
  const s16x4 l0 = tr_read<v_rd_off(D0, 0, 0)>(vb), h0 = tr_read<v_rd_off(D0, 0, 1)>(vb), l1 = tr_read<v_rd_off(D0, 1, 0)>(vb), h1 = tr_read<v_rd_off(D0, 1, 1)>(vb);
  const s16x4 l2 = tr_read<v_rd_off(D0, 2, 0)>(vb), h2 = tr_read<v_rd_off(D0, 2, 1)>(vb), l3 = tr_read<v_rd_off(D0, 3, 0)>(vb), h3 = tr_read<v_rd_off(D0, 3, 1)>(vb);
  asm volatile("s_waitcnt lgkmcnt(0)" ::: "memory"); SBAR();
#define PK(L, H) (bf16x8){L[0], L[1], L[2], L[3], H[0], H[1], H[2], H[3]}
  od = __builtin_amdgcn_mfma_f32_32x32x16_bf16(pa0, PK(l0, h0), od, 0, 0, 0);
  od = __builtin_amdgcn_mfma_f32_32x32x16_bf16(pa1, PK(l1, h1), od, 0, 0, 0);
  od = __builtin_amdgcn_mfma_f32_32x32x16_bf16(pa2, PK(l2, h2), od, 0, 0, 0);
  od = __builtin_amdgcn_mfma_f32_32x32x16_bf16(pa3, PK(l3, h3), od, 0, 0, 0);
#undef PK
}
__device__ __forceinline__ void pv_d0(f32x16* o, int vb, bf16x8 pa0, bf16x8 pa1, bf16x8 pa2, bf16x8 pa3) {
  pv_one<0>(o[0], vb, pa0, pa1, pa2, pa3); pv_one<1>(o[1], vb, pa0, pa1, pa2, pa3); pv_one<2>(o[2], vb, pa0, pa1, pa2, pa3); pv_one<3>(o[3], vb, pa0, pa1, pa2, pa3);
}
__device__ __forceinline__ void pv_sm(f32x16* o, int vb, bf16x8 pa0, bf16x8 pa1, bf16x8 pa2, bf16x8 pa3, f32x16& p0, f32x16& p1, float& m_reg, float& mn, float& alpha) {
  constexpr float C = SCALE * 1.4426950408889634f;
  pv_one<0>(o[0], vb, pa0, pa1, pa2, pa3);
  float pmax = p0[0];
#pragma unroll
  for (int r = 1; r < 16; ++r) pmax = fmaxf(pmax, p0[r]);
#pragma unroll
  for (int r = 0; r < 16; ++r) pmax = fmaxf(pmax, p1[r]);
  { auto rr = __builtin_amdgcn_permlane32_swap(__float_as_uint(pmax), __float_as_uint(pmax), false, false);
    pmax = fmaxf(__uint_as_float(rr[0]), __uint_as_float(rr[1])); }
  pv_one<1>(o[1], vb, pa0, pa1, pa2, pa3);
  const bool keep = __all(pmax - m_reg <= THR / SCALE);
  mn = keep ? m_reg : fmaxf(m_reg, pmax); alpha = __builtin_amdgcn_exp2f((m_reg - mn) * C); m_reg = mn;
  const float mnC = -mn * C;
#pragma unroll
  for (int r = 0; r < 16; ++r) p0[r] = fmaf(p0[r], C, mnC);
  pv_one<2>(o[2], vb, pa0, pa1, pa2, pa3);
#pragma unroll
  for (int r = 0; r < 16; ++r) p1[r] = fmaf(p1[r], C, mnC);
#pragma unroll
  for (int r = 0; r < 8; ++r) p0[r] = __builtin_amdgcn_exp2f(p0[r]);
  pv_one<3>(o[3], vb, pa0, pa1, pa2, pa3);
#pragma unroll
  for (int r = 8; r < 16; ++r) p0[r] = __builtin_amdgcn_exp2f(p0[r]);
}
__device__ __forceinline__ void attn_unit(const bf16_t* Qb, const bf16_t* Kb, const bf16_t* Vh, bf16_t* Ob, int seq, char* lds, float* stash, float lam, const float* subln) {
  int tid_ = threadIdx.x; asm volatile("" : "+v"(tid_));
  const int tid = tid_, wid = tid >> 6, lane = tid & 63, r32 = lane & 31, hi = lane >> 5;
  char* V_lds = lds; char* K_lds = lds + 3 * SHM_V;
  float* ws = (float*)(lds + 3 * SHM_V + 3 * SHM_K) + wid * 64; float* li_l = ws; float* al_l = ws + 32;
  const int sr = tid >> 4, sc = (tid & 15) * 8, vst0 = v_st(sr, sc), vst1 = v_st(32 + sr, sc);
  const int kr = tid >> 3, kc = (tid & 7) * 8, kst = KSWZ(kr, kc * 2);
  const int vb0 = (int)(uintptr_t)V_lds + v_rd_base(lane);
  const int NT = seq / KVBLK;
  f32x16 o[4];
  u32x4* const sl = (u32x4*)(lds + 3 * SHM_V + 3 * SHM_K + NW * 64 * 4) + tid;
  for (int comp = 0; comp < 2; ++comp) {
    const bf16_t* Kh = Kb + comp * 64;
    float m_reg = -1e30f, l_reg = 0; bf16x8 qr[4];
#pragma unroll
    for (int d = 0; d < 4; ++d) o[d] = f32x16{};
    const bf16_t* Qw = Qb + comp * 64 + (long)(wid * QBLK + r32) * LD + hi * 8;
#pragma unroll
    for (int d0 = 0; d0 < 4; ++d0) qr[d0] = *reinterpret_cast<const bf16x8*>(Qw + d0 * 16);
    struct { bf16x8 vs0, vs1, ks0; } sr_[2];
#define SLOAD(i, k0) do { sr_[i].vs0 = *reinterpret_cast<const bf16x8*>(&Vh[(long)((k0) + sr) * LD + sc]); sr_[i].vs1 = *reinterpret_cast<const bf16x8*>(&Vh[(long)((k0) + 32 + sr) * LD + sc]); \
    sr_[i].ks0 = *reinterpret_cast<const bf16x8*>(&Kh[(long)((k0) + kr) * LD + kc]); } while (0)
#define SWRITE(b, i) do { *(bf16x8*)(V_lds + (b) * SHM_V + vst0) = sr_[i].vs0; *(bf16x8*)(V_lds + (b) * SHM_V + vst1) = sr_[i].vs1; \
    *(bf16x8*)(K_lds + (b) * SHM_K + kst) = sr_[i].ks0; } while (0)
#define SWAIT() asm volatile("s_waitcnt vmcnt(3)" ::: "memory")
#define RESC(a) do { if (__any((a) < 1.f)) { if (hi == 0) al_l[r32] = (a); asm volatile("s_waitcnt lgkmcnt(0)" ::: "memory"); \
    _Pragma("unroll") for (int d = 0; d < 4; ++d) _Pragma("unroll") for (int r = 0; r < 16; ++r) o[d][r] *= al_l[crow(r, hi)]; } } while (0)
    f32x16 pA0, pA1, pB0, pB1; float mnA, mnB, alA, alB; bf16x8 pa0, pa1, pa2, pa3;
    int bp = 0, bc = 1, bn = 2;
#define ROT3() do { const int t_ = bp; bp = bc; bc = bn; bn = t_; } while (0)
    SLOAD(0, 0); asm volatile("s_waitcnt vmcnt(0)" ::: "memory"); SWRITE(0, 0); __syncthreads();
    qkt(pA0, pA1, K_lds, qr, r32, hi); partialSM(pA0, pA1, m_reg, mnA, alA);
    SLOAD(1, KVBLK); if (2 < NT) SLOAD(0, 2 * KVBLK);
    SWAIT(); SWRITE(1, 1); __syncthreads();
    for (int j = 1; j + 1 < NT; j += 2) {
      SBAR(); qkt(pB0, pB1, K_lds + bc * SHM_K, qr, r32, hi);
      finishSM(pA0, pA1, alA, l_reg, pa0, pa1, pa2, pa3); SBAR();
      SLOAD(1, (j + 2) * KVBLK); SBAR();
      pv_sm(o, vb0 + bp * SHM_V, pa0, pa1, pa2, pa3, pB0, pB1, m_reg, mnB, alB);
      SWAIT(); SWRITE(bn, 0);
      RESC(alB); __syncthreads(); ROT3();
      SBAR(); qkt(pA0, pA1, K_lds + bc * SHM_K, qr, r32, hi);
      finishSM(pB0, pB1, alB, l_reg, pa0, pa1, pa2, pa3); SBAR();
      if (j + 3 < NT) SLOAD(0, (j + 3) * KVBLK); SBAR();
      pv_sm(o, vb0 + bp * SHM_V, pa0, pa1, pa2, pa3, pA0, pA1, m_reg, mnA, alA);
      SWAIT(); SWRITE(bn, 1);
      RESC(alA); __syncthreads(); ROT3();
    }
    SBAR(); qkt(pB0, pB1, K_lds + bc * SHM_K, qr, r32, hi);
    finishSM(pA0, pA1, alA, l_reg, pa0, pa1, pa2, pa3); SBAR();
    pv_sm(o, vb0 + bp * SHM_V, pa0, pa1, pa2, pa3, pB0, pB1, m_reg, mnB, alB);
    RESC(alB);
    finishSM(pB0, pB1, alB, l_reg, pa0, pa1, pa2, pa3); SBAR();
    pv_d0(o, vb0 + bc * SHM_V, pa0, pa1, pa2, pa3);
#undef ROT3
    if (hi == 0) li_l[r32] = l_reg; asm volatile("s_waitcnt lgkmcnt(0)" ::: "memory");
#pragma unroll
    for (int r = 0; r < 16; ++r) { const float rl = __builtin_amdgcn_rcpf(li_l[crow(r, hi)]);
#pragma unroll
      for (int d0 = 0; d0 < 4; ++d0) o[d0][r] *= rl; }
    if (comp == 0) {
#pragma unroll
      for (int d0 = 0; d0 < 4; ++d0)
#pragma unroll
        for (int hf = 0; hf < 2; ++hf) { u32x4 t; t.x = cvtpk(o[d0][8 * hf], o[d0][8 * hf + 1]); t.y = cvtpk(o[d0][8 * hf + 2], o[d0][8 * hf + 3]); t.z = cvtpk(o[d0][8 * hf + 4], o[d0][8 * hf + 5]); t.w = cvtpk(o[d0][8 * hf + 6], o[d0][8 * hf + 7]); sl[(d0 * 2 + hf) * 512] = t; } }
    __syncthreads();
#undef SLOAD
#undef SWRITE
#undef SWAIT
#undef RESC
  }
  {
    bf16_t* stg = (bf16_t*)(lds + wid * 8704);
    float sg[4];
#pragma unroll
    for (int d0 = 0; d0 < 4; ++d0) sg[d0] = subln[d0 * 32 + r32] * 0.8f;
#pragma unroll
    for (int hf = 0; hf < 2; ++hf) {
      u32x4 t0[4];
#pragma unroll
      for (int d0 = 0; d0 < 4; ++d0) t0[d0] = sl[(d0 * 2 + hf) * 512];
#pragma unroll
      for (int k = 0; k < 8; ++k) { const int r = 8 * hf + k; float v[4]; float q = 0.f;
#pragma unroll
        for (int d0 = 0; d0 < 4; ++d0) { const unsigned w0 = t0[d0][k >> 1];
          const float a = __uint_as_float((k & 1) ? (w0 & 0xffff0000u) : (w0 << 16));
          v[d0] = a - lam * o[d0][r]; q += v[d0] * v[d0]; }
        q = xl::sum32(q);
        const float rs = __builtin_amdgcn_rsqf(q * (1.0f / 128.0f) + 1e-6f); const int orow = crow(r, hi);
#pragma unroll
        for (int d0 = 0; d0 < 4; ++d0) { const float w = v[d0] * rs * sg[d0]; stg[orow * 136 + d0 * 32 + r32] = (bf16_t)(cvtpk(w, w) & 0xffffu); } }
      asm volatile("" ::: "memory");
    }
    asm volatile("s_waitcnt lgkmcnt(0)" ::: "memory");
    bf16_t* Og = Ob + (long)(wid * QBLK) * LD;
#pragma unroll
    for (int i = 0; i < 8; ++i) { const int row = i * 4 + (lane >> 4), ch = lane & 15; const u32x4 t = *(const u32x4*)((const char*)stg + row * 272 + ch * 16); *(u32x4*)(Og + (long)row * LD + ch * 8) = t; }
  }
  __syncthreads();
}
#undef SBAR
#undef KSWZ
}

namespace ct {
using att::bf16x8; using att::f32x16; using att::bf16_t;
template <int MB> __device__ __forceinline__ void unit(const bf16_t* Amat, int K, const bf16_t* src, int P, long sA, long sB, bf16_t* dst, int Q, long sC, long sD, float scale, char* lds) {
  constexpr int NCH = 8 / MB;
  int tid_ = threadIdx.x; asm volatile("" : "+v"(tid_));
  const int tid = tid_, wid = tid >> 6, lane = tid & 63, r32 = lane & 31, hi = lane >> 5;
  const int rb = wid % MB, cc = wid / MB;
  const int sr = tid >> 4, sc = (tid & 15) * 8, vst0 = att::v_st(sr, sc), vst1 = att::v_st(32 + sr, sc);
  const int vb = (int)(uintptr_t)lds + cc * 16384 + att::v_rd_base(lane);
  const int NKT = K >> 6;
#pragma unroll 1
  for (int cs = 0; cs < 4 / NCH; ++cs) {
    f32x16 o[4] = {};
#pragma unroll 1
    for (int kt = 0; kt < NKT; ++kt) {
      const int k0 = kt * 64 + sr, k1 = k0 + 32;
      const bf16_t* r0 = src + (long)(k0 % P) * sA + (long)(k0 / P) * sB + cs * NCH * 128 + sc;
      const bf16_t* r1 = src + (long)(k1 % P) * sA + (long)(k1 / P) * sB + cs * NCH * 128 + sc;
      bf16x8 t0[NCH], t1[NCH];
#pragma unroll
      for (int ch = 0; ch < NCH; ++ch) { t0[ch] = *reinterpret_cast<const bf16x8*>(r0 + ch * 128); t1[ch] = *reinterpret_cast<const bf16x8*>(r1 + ch * 128); }
      const bf16_t* ap = Amat + (long)(rb * 32 + r32) * K + kt * 64 + hi * 8;
      const bf16x8 pa0 = *reinterpret_cast<const bf16x8*>(ap), pa1 = *reinterpret_cast<const bf16x8*>(ap + 16), pa2 = *reinterpret_cast<const bf16x8*>(ap + 32), pa3 = *reinterpret_cast<const bf16x8*>(ap + 48);
      __syncthreads();
#pragma unroll
      for (int ch = 0; ch < NCH; ++ch) { *(bf16x8*)(lds + ch * 16384 + vst0) = t0[ch]; *(bf16x8*)(lds + ch * 16384 + vst1) = t1[ch]; }
      __syncthreads();
      att::pv_d0(o, vb, pa0, pa1, pa2, pa3);
    }
    bf16_t* stg = (bf16_t*)(lds + 65536 + wid * 8704);
#pragma unroll
    for (int r = 0; r < 16; ++r) { const int orow = att::crow(r, hi);
#pragma unroll
      for (int d0 = 0; d0 < 4; ++d0) { const __bf16 hb = (__bf16)(o[d0][r] * scale); stg[orow * 136 + d0 * 32 + r32] = __builtin_bit_cast(bf16_t, hb); } }
    asm volatile("s_waitcnt lgkmcnt(0)" ::: "memory");
#pragma unroll
    for (int i = 0; i < 8; ++i) { const int row = i * 4 + (lane >> 4), ch = lane & 15, m = rb * 32 + row;
      const att::u32x4 t = *(const att::u32x4*)((const char*)stg + row * 272 + ch * 16);
      *(att::u32x4*)(dst + (long)(m % Q) * sC + (long)(m / Q) * sD + (cs * NCH + cc) * 128 + ch * 8) = t; }
    asm volatile("s_waitcnt lgkmcnt(0)" ::: "memory");
  }
  __syncthreads();
}
}
#define LAS __attribute__((address_space(3)))
typedef unsigned short bf16;
typedef unsigned v4u __attribute__((ext_vector_type(4)));
typedef float f32x4 __attribute__((ext_vector_type(4)));
constexpr int NWAVES = 8;
constexpr int T = 81920, TP = 65536, D = 1024, FF = 4096, PLE = 256, INW = 5632;
constexpr float EPS = 1e-6f;
constexpr size_t MiB = 1u << 20;
constexpr size_t WS_ROPE = 1 * MiB;
constexpr size_t WS_WF2 = 2 * MiB, WS_WQKV = 4 * MiB, WS_WG = 10 * MiB, WS_WF = 14 * MiB, WS_WA = 15 * MiB, WS_WO = 17 * MiB, WS_WUP = 19 * MiB, WS_WDN = 27 * MiB, WS_WPLE = 35 * MiB, WS_WGATE = 36 * MiB;
constexpr size_t WS_A1S = 42 * MiB, WS_A1P = 46 * MiB, WS_A2S = 47 * MiB, WS_A2P = 47 * MiB + 512 * 1024;
constexpr size_t WS_UC = 544 * MiB;
constexpr size_t WS_SS = 58 * MiB;
constexpr size_t WS_XH = 64 * MiB;
constexpr size_t WS_GT = 224 * MiB;
constexpr size_t WS_Q = 384 * MiB, WS_K = 544 * MiB, WS_V = 704 * MiB;
constexpr size_t WS_F = 864 * MiB;
constexpr size_t WS_STASH = 944 * MiB;
constexpr size_t WS_U = 384 * MiB;
constexpr size_t WS_PB = 384 * MiB;
constexpr size_t WS_EP = 424 * MiB, WS_E = 584 * MiB;
constexpr int LDS_BYTES = 147456;

#define XB_TMO      128
#define XB_XCNT(j)  (256  + 64 * (j))
#define XB_XSUB(j)  (1280 + 64 * (j))
#define XB_XGEN(j)  (2304 + 64 * (j))
#define XB_TOP      3328
#define XB_TOPGEN   3392
#define XCD_BAR_WORDS 3456
#define XB_SPIN_CAP (1u << 18)

__device__ __forceinline__ unsigned xb_ld(unsigned* p)              { return __hip_atomic_load(p, __ATOMIC_RELAXED, __HIP_MEMORY_SCOPE_AGENT); }
__device__ __forceinline__ unsigned xb_add(unsigned* p, unsigned v) { return __hip_atomic_fetch_add(p, v, __ATOMIC_RELAXED, __HIP_MEMORY_SCOPE_AGENT); }
__device__ __forceinline__ unsigned xb_xcc_id() { return (unsigned)__builtin_amdgcn_s_getreg((3 << 11) | 20) & 0xFu; }
#define XB_SPIN(cond, bar) do { unsigned _sp = 0; while (cond) { __builtin_amdgcn_s_sleep(1); \
    if ((++_sp & 255u) == 0u) { if (xb_ld(&(bar)[XB_TMO])) break; if (_sp > XB_SPIN_CAP) { atomicAdd(&(bar)[XB_TMO], 1u); break; } } } } while (0)

struct XcdBarrier {
    unsigned* bar; unsigned x;
    volatile LAS unsigned* st;
};

__device__ __forceinline__ XcdBarrier xcd_barrier_post(unsigned* bar, volatile LAS unsigned* st) {
    XcdBarrier b; b.bar = bar; b.x = xb_xcc_id(); b.st = st;
    if (threadIdx.x == 0) (void)xb_add(&bar[XB_XCNT(b.x)], 1u);
    return b;
}
__device__ __forceinline__ void xcd_barrier_complete(unsigned* bar, unsigned x, unsigned& nloc, unsigned& nx) {
    const unsigned G = gridDim.x * gridDim.y * gridDim.z;
    unsigned sum, cnt, mine, sp = 0u;
    for (;;) {
        sum = 0u; cnt = 0u; mine = 0u;
#pragma unroll
        for (unsigned j = 0; j < 16; ++j) { const unsigned c = xb_ld(&bar[XB_XCNT(j)]); sum += c; cnt += (c > 0u) ? 1u : 0u; mine = (j == x) ? c : mine; }
        if (sum == G) break;
        __builtin_amdgcn_s_sleep(1);
        if ((++sp & 255u) == 0u) { if (xb_ld(&bar[XB_TMO])) break; if (sp > XB_SPIN_CAP) { atomicAdd(&bar[XB_TMO], 1u); break; } }
    }
    nloc = mine > 0u ? mine : 1u; nx = cnt > 0u ? cnt : 1u;
}

__device__ __forceinline__ void xcd_barrier(const XcdBarrier& b) {
    asm volatile("s_waitcnt vmcnt(0)" ::: "memory");
    __syncthreads();
    if (threadIdx.x == 0) {
        unsigned* bar = b.bar;
        __builtin_amdgcn_s_waitcnt(0);
        unsigned nloc = b.st[0], nx = b.st[1];
        if (nloc == 0u) { xcd_barrier_complete(bar, b.x, nloc, nx); b.st[0] = nloc; b.st[1] = nx; }
        const unsigned old = xb_add(&bar[XB_XSUB(b.x)], 1u);
        const unsigned gen = old / nloc;
        if (old + 1u == (gen + 1u) * nloc) {
            __builtin_amdgcn_fence(__ATOMIC_RELEASE, "agent");
            asm volatile("s_waitcnt vmcnt(0)" ::: "memory");
            const unsigned og = xb_add(&bar[XB_TOP], 1u);
            const unsigned tg = og / nx;
            if (og + 1u == (tg + 1u) * nx) xb_add(&bar[XB_TOPGEN], 1u);
            else XB_SPIN(xb_ld(&bar[XB_TOPGEN]) == tg, bar);
            __builtin_amdgcn_fence(__ATOMIC_ACQUIRE, "agent");
            xb_add(&bar[XB_XGEN(b.x)], 1u);
            asm volatile("s_waitcnt vmcnt(0)" ::: "memory");
        } else {
            XB_SPIN(xb_ld(&bar[XB_XGEN(b.x)]) == gen, bar);
            __builtin_amdgcn_fence(__ATOMIC_ACQUIRE, "agent");
            asm volatile("s_waitcnt vmcnt(0)" ::: "memory");
        }
    }
    __syncthreads();
}

struct Args { const float* in[22]; float* out; unsigned char* ws; int ph_lo, ph_hi; };

__device__ __forceinline__ float wave_sum(float v) { return xl::sum64(v); }
__device__ __forceinline__ unsigned pk2(float lo, float hi) { return pg8::cvt_pk_bf16(lo, hi); }
__device__ __forceinline__ f32x4 unp4(unsigned long long q) { f32x4 r; r.x = __uint_as_float((unsigned)q << 16); r.y = __uint_as_float((unsigned)q & 0xffff0000u); r.z = __uint_as_float((unsigned)(q >> 32) << 16); r.w = __uint_as_float((unsigned)(q >> 32) & 0xffff0000u); return r; }
__device__ __forceinline__ unsigned long long pk4(f32x4 v) { return (unsigned long long)pk2(v.x, v.y) | ((unsigned long long)pk2(v.z, v.w) << 32); }
__device__ __forceinline__ void p0_transpose_item(const float* W, int ldw, int col0, int K, int N, const float* gain, bf16* WT, LAS float* scr, int item, int lane) {
    const int nblk = N / 32, kb = item / nblk, nb = item % nblk, k0 = 64 * kb, n0 = 32 * nb;
#pragma unroll 8
    for (int i = 0; i < 32; ++i) { const int kk = 2 * i + (lane >> 5); const float g = gain ? gain[k0 + kk] : 1.f; scr[kk * 33 + (lane & 31)] = W[(size_t)(k0 + kk) * ldw + col0 + n0 + (lane & 31)] * g; }
    asm volatile("s_waitcnt lgkmcnt(0)" ::: "memory");
    const int c = lane & 7;
#pragma unroll
    for (int j = 0; j < 4; ++j) { const int n = (lane >> 3) + 8 * j; const LAS float* s = scr + (8 * c) * 33 + n;
        v4u o; o.x = pk2(s[0 * 33], s[1 * 33]); o.y = pk2(s[2 * 33], s[3 * 33]); o.z = pk2(s[4 * 33], s[5 * 33]); o.w = pk2(s[6 * 33], s[7 * 33]);
        *(v4u*)(WT + (size_t)(n0 + n) * K + k0 + 8 * c) = o; }
    asm volatile("s_waitcnt lgkmcnt(0)" ::: "memory");
}
__device__ __forceinline__ const float* xrow(const Args& a, int m) { return m < TP ? a.in[0] + (size_t)m * D : a.in[1] + (size_t)(m - TP) * D; }

__global__ void __launch_bounds__(NWAVES * 64, 2) fwd_mega(Args args) {
    extern __shared__ __attribute__((aligned(16))) unsigned char lds[];
    cg::grid_group grid = cg::this_grid();
#define IN(k) (args.ph_lo <= (k) && (k) < args.ph_hi)
    volatile LAS unsigned* xst = (volatile LAS unsigned*)((LAS unsigned char*)lds + (LDS_BYTES - 16));
    if (threadIdx.x == 0) { xst[0] = 0u; xst[1] = 0u; }
    __syncthreads();
    const XcdBarrier xbar = xcd_barrier_post((unsigned*)args.ws, xst);
#define GSYNC() xcd_barrier(xbar)
    const int tid = threadIdx.x, lane = tid & 63, wave = __builtin_amdgcn_readfirstlane(tid >> 6);
    const int G = gridDim.x, bx = blockIdx.x; const int vcu = (G % 8 == 0) ? (bx % 8) * (G / 8) + bx / 8 : bx;
    unsigned char* ws = args.ws;
    LAS unsigned char* ldsl = (LAS unsigned char*)lds;
#define WF2 ((bf16*)(ws + WS_WF2))
#define WQKV ((bf16*)(ws + WS_WQKV))
#define WG ((bf16*)(ws + WS_WG))
#define WF ((bf16*)(ws + WS_WF))
#define WA ((bf16*)(ws + WS_WA))
#define WO ((bf16*)(ws + WS_WO))
#define WUP ((bf16*)(ws + WS_WUP))
#define WDN ((bf16*)(ws + WS_WDN))
#define WPLE ((bf16*)(ws + WS_WPLE))
#define WGATE ((bf16*)(ws + WS_WGATE))
#define ROPE ((float*)(ws + WS_ROPE))
#define UC ((bf16*)(ws + WS_UC))
#define SS ((float*)(ws + WS_SS))
#define XH ((bf16*)(ws + WS_XH))
#define GT ((bf16*)(ws + WS_GT))
#define QB ((bf16*)(ws + WS_Q))
#define KB ((bf16*)(ws + WS_V))
#define VB ((bf16*)(ws + WS_V) + (size_t)T * D)
#define FB ((bf16*)(ws + WS_F))
    const int gw = vcu * NWAVES + wave, NGW = G * NWAVES;
    const int gtid = bx * (NWAVES * 64) + tid, NGT = G * NWAVES * 64;

    using pg8::Gemm; using pg8::StaticOrder; using pg8::EpiGen; using pg8::ListOrder;
    LAS unsigned char* ring = ldsl;
    if (IN(0)) {
    {
        LAS float* scr = (LAS float*)(ldsl + wave * 16384);
        const float* w_in = args.in[5];
        constexpr int I_QKV = 16 * 96, I_G = 16 * 64, I_F = 8 * 32, I_A = 16 * 32, I_O = 16 * 32, I_UP = 16 * 128, I_DN = 64 * 32, I_PLE = 4 * 32, I_GATE = 16 * 32;
        constexpr int NITEMS = I_QKV + I_G + I_F + I_A + I_O + I_UP + I_DN + I_PLE + I_GATE;
        for (int it = gw; it < NITEMS; it += NGW) {
            int r = it;
            if (r < I_QKV) { p0_transpose_item(w_in, INW, 512, D, 3072, args.in[4], WQKV, scr, r, lane); continue; } r -= I_QKV;
            if (r < I_G) { p0_transpose_item(w_in, INW, 3584, D, 2048, args.in[4], WG, scr, r, lane); continue; } r -= I_G;
            if (r < I_F) { p0_transpose_item(args.in[6], D, 0, 512, D, nullptr, WF, scr, r, lane); continue; } r -= I_F;
            if (r < I_A) { p0_transpose_item(args.in[7], D, 0, D, D, nullptr, WA, scr, r, lane); continue; } r -= I_A;
            if (r < I_O) { p0_transpose_item(args.in[8], D, 0, D, D, nullptr, WO, scr, r, lane); continue; } r -= I_O;
            if (r < I_UP) { p0_transpose_item(args.in[16], FF, 0, D, FF, args.in[15], WUP, scr, r, lane); continue; } r -= I_UP;
            if (r < I_DN) { p0_transpose_item(args.in[17], D, 0, FF, D, nullptr, WDN, scr, r, lane); continue; } r -= I_DN;
            if (r < I_PLE) { p0_transpose_item(args.in[19], D, 0, PLE, D, nullptr, WPLE, scr, r, lane); continue; } r -= I_PLE;
            p0_transpose_item(args.in[20], D, 0, D, D, nullptr, WGATE, scr, r, lane);
        }
        __syncthreads();
        {
            LAS float* Wt = (LAS float*)ldsl;
            LAS float* ctab = (LAS float*)(ldsl + 8192);
            for (int item = bx; item < 256; item += G) {
                const int grp = item >> 6, k0 = (item & 63) * 16;
                for (int e = tid; e < 2048; e += NWAVES * 64) { const int kk = e >> 7, c = e & 127; Wt[c * 16 + kk] = w_in[(size_t)(k0 + kk) * INW + grp * 128 + c] * args.in[4][k0 + kk]; }
                if (tid < 128) ctab[tid] = __builtin_amdgcn_cosf((float)tid * (1.0f / 128.0f));
                __syncthreads();
                const int m = tid & 127, comp = (tid >> 7) & 1, kh = tid >> 8;
                float acc[8];
#pragma unroll
                for (int i = 0; i < 8; ++i) acc[i] = 0.f;
                for (int c = 0; c < 128; ++c) { const float t = ctab[(c * m + (comp ? 96 : 0)) & 127]; const LAS f32x4* wp = (const LAS f32x4*)(Wt + c * 16 + kh * 8); const f32x4 w0 = wp[0], w1 = wp[1];
#pragma unroll
                    for (int i = 0; i < 4; ++i) { acc[i] += w0[i] * t; acc[4 + i] += w1[i] * t; } }
                v4u o; o.x = pk2(acc[0], acc[1]); o.y = pk2(acc[2], acc[3]); o.z = pk2(acc[4], acc[5]); o.w = pk2(acc[6], acc[7]);
                *(v4u*)(WF2 + (size_t)(comp * 512 + grp * 128 + m) * D + k0 + kh * 8) = o;
                __syncthreads();
            }
        }
        { bf16* A1S = (bf16*)(ws + WS_A1S); bf16* A1P = (bf16*)(ws + WS_A1P); bf16* A2S = (bf16*)(ws + WS_A2S); bf16* A2P = (bf16*)(ws + WS_A2P);
          for (int it = gtid; it < 128 * 128 * 128; it += NGT) { const int k = it & 127, m = (it >> 7) & 127, s2 = it >> 14; const int ri = m >> 6, k1 = m & 63, comp = k >> 6, s1 = k & 63;
              const float fr = (float)((k1 * (128 * s1 + s2)) & 8191) * (1.0f / 8192.0f); const float c = __builtin_amdgcn_cosf(fr), s = __builtin_amdgcn_sinf(fr);
              const float v = ri == 0 ? (comp == 0 ? c : -s) : (comp == 0 ? -s : -c); A1S[it] = (bf16)(pk2(v, v) & 0xffffu); }
          for (int it = gtid; it < 64 * 64 * 64; it += NGT) { const int k = it & 63, m = (it >> 6) & 63, s2 = it >> 12; const int ri = m >> 5, k1 = m & 31, comp = k >> 5, s1 = k & 31;
              const float fr = (float)((k1 * (64 * s1 + s2)) & 2047) * (1.0f / 2048.0f); const float c = __builtin_amdgcn_cosf(fr), s = __builtin_amdgcn_sinf(fr);
              const float v = ri == 0 ? (comp == 0 ? c : -s) : (comp == 0 ? -s : -c); A1P[it] = (bf16)(pk2(v, v) & 0xffffu); }
          for (int it = gtid; it < 128 * 256; it += NGT) { const int k = it & 255, k2 = it >> 8; const int ri = k >> 7, s2 = k & 127;
              const float fr = (float)((k2 * s2) & 127) * (1.0f / 128.0f); const float v = ri == 0 ? __builtin_amdgcn_cosf(fr) : __builtin_amdgcn_sinf(fr); A2S[it] = (bf16)(pk2(v, v) & 0xffffu); }
          for (int it = gtid; it < 64 * 128; it += NGT) { const int k = it & 127, k2 = it >> 7; const int ri = k >> 6, s2 = k & 63;
              const float fr = (float)((k2 * s2) & 63) * (1.0f / 64.0f); const float v = ri == 0 ? __builtin_amdgcn_cosf(fr) : __builtin_amdgcn_sinf(fr); A2P[it] = (bf16)(pk2(v, v) & 0xffffu); }
        }
        if (gtid < 65536) { const int pos = gtid >> 3, i = gtid & 7;
            const double ifr[8] = {0.15915494309189535, 0.03086376340470123, 0.005985185712713705, 0.001160663641240061, 0.00022507907903927653, 4.364795279280289e-05, 8.464330808241401e-06, 1.6414262627950345e-06};
            double rev = (double)pos * (i == 0 ? ifr[0] : i == 1 ? ifr[1] : i == 2 ? ifr[2] : i == 3 ? ifr[3] : i == 4 ? ifr[4] : i == 5 ? ifr[5] : i == 6 ? ifr[6] : ifr[7]);
            rev -= (double)(long long)rev; const float fr = (float)rev;
            ROPE[pos * 16 + i] = __builtin_amdgcn_cosf(fr); ROPE[pos * 16 + 8 + i] = __builtin_amdgcn_sinf(fr); }
        for (int m = gw; m < T; m += NGW) { const f32x4* xr = (const f32x4*)xrow(args, m) + lane; f32x4 v[4]; float s = 0.f;
#pragma unroll
            for (int j = 0; j < 4; ++j) { v[j] = xr[64 * j]; s += (v[j].x * v[j].x + v[j].y * v[j].y) + (v[j].z * v[j].z + v[j].w * v[j].w); }
            const float ms = wave_sum(s) * (1.f / D) + EPS; const float rs = __builtin_amdgcn_rsqf(ms);
            if (lane == 0) ((float*)(ws + 63 * MiB))[m] = ms * rs;
            unsigned long long* o8 = (unsigned long long*)(XH + (size_t)m * D) + lane;
#pragma unroll
            for (int j = 0; j < 4; ++j) o8[64 * j] = (unsigned long long)pk2(v[j].x * rs, v[j].y * rs) | ((unsigned long long)pk2(v[j].z * rs, v[j].w * rs) << 32); }
    }
    if (IN(0) && IN(1)) { asm volatile("s_waitcnt vmcnt(0)" ::: "memory"); grid.sync(); }

    }

    if (IN(1)) {
    {
        Gemm g{XH, WF2, T, 4096, D}; StaticOrder S; S.init(T, 4096, G, bx); pg8::EpiQKV E{GT, QB, KB, (size_t)T * D, ROPE};
        pg8::gemm_phase<pg8::EpiQKV, StaticOrder, true, true>(ring, g, S, E);
    }
    if (IN(1) && IN(2)) GSYNC();

    }
#define GF GT
#define GA ((bf16*)(ws + WS_V))
#define Y1 ((bf16*)(ws + WS_UC))
#define MG GT
#define ATT QB
    if (IN(2)) {
    {
        float lam;
        { const float a = wave_sum(args.in[9][lane] * args.in[10][lane]), b = wave_sum(args.in[11][lane] * args.in[12][lane]); lam = __expf(a) - __expf(b) + 0.2f; }
        float* stash = (float*)(ws + WS_STASH) + (size_t)bx * 32768;
        const int NCU = G;
        const int ppc = (2048 + NCU - 1) / NCU, spc = (512 + NCU - 1) / NCU;
#ifdef DBG_ATT2
        for (int pass2 = 0; pass2 < 2; ++pass2)
#else
        const int pass2 = 1;
#endif
        for (int i = 0; i < ppc + spc; ++i) { const bool smp = i >= ppc; int bh, qb;
            if (NCU == 256) { if (smp) { bh = (vcu >> 5) + 8 * (i - ppc); qb = vcu & 31; } else { bh = (vcu >> 3) + 32 * i; qb = vcu & 7; } }
            else { const int ui = smp ? vcu * spc + (i - ppc) : vcu * ppc + i; if (ui >= (smp ? 512 : 2048)) continue; const int lq = smp ? 5 : 3; bh = ui >> lq; qb = ui & ((1 << lq) - 1); }
            const int b = bh >> 3, h = bh & 7; const int seq = smp ? 8192 : 2048;
            const size_t r0 = (smp ? (size_t)TP : 0) + (size_t)b * seq; const size_t qo = (r0 + qb * 256) * D + h * 128, ko = r0 * D + h * 128;
            att::attn_unit(QB + qo, KB + ko, VB + ko, (pass2 ? QB : UC) + qo, seq, (char*)lds, stash, lam, args.in[13]); }
        __syncthreads();
        { const bf16* A1S = (const bf16*)(ws + WS_A1S); const bf16* A1P = (const bf16*)(ws + WS_A1P); bf16* US = UC + (size_t)131072 * 512;
          for (int ui = vcu; ui < 256 + 2048; ui += NCU) {
            if (ui < 256) { const int b = ui >> 7, s2 = ui & 127;
                ct::unit<4>(A1S + (size_t)s2 * 128 * 128, 128, GT + ((size_t)TP + (size_t)b * 8192 + s2) * 1024, 64, 128L * 1024, 512L, US + ((size_t)b * 64 * 2 * 128 + s2) * 512, 64, 2L * 128 * 512, 128L * 512, 1.0f, (char*)lds); }
            else { const int up = ui - 256, b = up >> 6, s2 = up & 63;
                ct::unit<2>(A1P + (size_t)s2 * 64 * 64, 64, GT + ((size_t)b * 2048 + s2) * 1024, 32, 64L * 1024, 512L, UC + ((size_t)b * 32 * 2 * 64 + s2) * 512, 32, 2L * 64 * 512, 64L * 512, 1.0f, (char*)lds); }
          } }
    }
    if (IN(2) && IN(3)) GSYNC();

    }

    if (IN(3)) {
    {
        const bf16* A2S = (const bf16*)(ws + WS_A2S); const bf16* A2P = (const bf16*)(ws + WS_A2P); const bf16* US = UC + (size_t)131072 * 512;
        for (int ui = vcu; ui < 128 + 1024; ui += G) {
            if (ui < 128) { const int b = ui >> 6, k1 = ui & 63;
                ct::unit<4>(A2S, 256, US + ((size_t)(b * 64 + k1) * 2 * 128) * 512, 256, 512L, 0L, FB + ((size_t)TP + (size_t)b * 8192 + k1) * 512, 128, 64L * 512, 0L, 1.0f / 1024.0f, (char*)lds); }
            else { const int up = ui - 128, b = up >> 5, k1 = up & 31;
                ct::unit<2>(A2P, 128, UC + ((size_t)(b * 32 + k1) * 2 * 64) * 512, 128, 512L, 0L, FB + ((size_t)b * 2048 + k1) * 512, 64, 32L * 512, 0L, 1.0f / 512.0f, (char*)lds); }
        }
    }
    {
        Gemm g{XH, WG, T, 2048, D}; StaticOrder S; S.init(T, 2048, G, bx); EpiGen<1> E{GF, D, nullptr, nullptr, nullptr, 1.f, (size_t)(WS_V - WS_GT) / 2};
        pg8::gemm_phase<EpiGen<1>, StaticOrder, true, true>(ring, g, S, E);
    }
    if (IN(3) && IN(4)) GSYNC();

    }

    if (IN(4)) {
    {
        Gemm g{FB, WF, T, D, 512}; StaticOrder S; S.init(T, D, G, bx); EpiGen<2> E{Y1, D, GF, nullptr, nullptr, 1.f, 0};
        pg8::gemm_phase<EpiGen<2>, StaticOrder, true, true>(ring, g, S, E);
    }

    }

    if (IN(5)) {
    {
        Gemm g{ATT, WA, T, D, D}; StaticOrder S; S.init(T, D, G, bx); EpiGen<3> E{MG, D, Y1, GA, nullptr, 1.f, 0};
        pg8::gemm_phase<EpiGen<3>, StaticOrder, true, true>(ring, g, S, E);
    }
    if (IN(5) && IN(6)) GSYNC();

    }
#define Z XH
#define Z4 UC
    if (IN(6)) {
    {
        Gemm g{MG, WO, T, D, D}; StaticOrder S; S.init(T, D, G, bx); EpiGen<4> E{Z4, D, nullptr, nullptr, SS, 1.f, 0};
        pg8::gemm_phase<EpiGen<4>, StaticOrder, true, true>(ring, g, S, E);
    }
    if (IN(6) && IN(7)) GSYNC();

    }
#define H2 GT
    if (IN(7)) {
    { int ln_ = threadIdx.x; asm volatile("" : "+v"(ln_)); const int lane = ln_ & 63; constexpr int RB = 4;
    f32x4 gg[4];
#pragma unroll
    for (int j = 0; j < 4; ++j) gg[j] = ((const f32x4*)args.in[14] + lane)[64 * j];
    for (int m0 = gw; m0 < T; m0 += RB * NGW) {
        unsigned long long xq[RB][4], zq[RB][4]; float sv[RB], xsv[RB];
#pragma unroll
        for (int r = 0; r < RB; ++r) { const int m = m0 + r * NGW; if (m < T) {
            sv[r] = (lane < 16) ? SS[(size_t)m * 16 + lane] : 0.f; xsv[r] = ((const float*)(ws + 63 * MiB))[m];
            const unsigned long long* xr = (const unsigned long long*)(XH + (size_t)m * D) + lane; const unsigned long long* zr = (const unsigned long long*)(Z4 + (size_t)m * D) + lane;
#pragma unroll
            for (int j = 0; j < 4; ++j) { xq[r][j] = xr[64 * j]; zq[r][j] = zr[64 * j]; } } }
#pragma unroll
        for (int r = 0; r < RB; ++r) { const int m = m0 + r * NGW; if (m < T) {
            const float rs = __builtin_amdgcn_rsqf(wave_sum(sv[r]) * (1.f / D) + EPS); f32x4 v[4]; float s2 = 0.f;
#pragma unroll
            for (int j = 0; j < 4; ++j) { v[j] = unp4(xq[r][j]) * xsv[r] + unp4(zq[r][j]) * rs * gg[j]; s2 += (v[j].x * v[j].x + v[j].y * v[j].y) + (v[j].z * v[j].z + v[j].w * v[j].w); }
            const float rs2 = __builtin_amdgcn_rsqf(wave_sum(s2) * (1.f / D) + EPS);
            unsigned long long* x8 = (unsigned long long*)((bf16*)args.out + (size_t)m * D) + lane; unsigned long long* h8 = (unsigned long long*)(H2 + (size_t)m * D) + lane;
#pragma unroll
            for (int j = 0; j < 4; ++j) { x8[64 * j] = pk4(v[j]); h8[64 * j] = pk4(v[j] * rs2); } } }
    }
    }
    if (IN(7) && IN(8)) GSYNC();

    }
#define U ((bf16*)(ws + WS_U))
    if (IN(8)) {
    {
        Gemm g{H2, WUP, T, FF, D}; StaticOrder S; S.init(T, FF, G, bx); EpiGen<5> E{U, FF, nullptr, nullptr, nullptr, 1.f, 0};
        pg8::gemm_phase<EpiGen<5>, StaticOrder, true, true>(ring, g, S, E);
    }
    if (IN(8) && IN(9)) GSYNC();

    }

    if (IN(9)) {
    {
        Gemm g{U, WDN, T, D, FF}; StaticOrder S; S.init(T, D, G, bx); EpiGen<4> E{Z, D, nullptr, nullptr, SS, 1.f, 0};
        pg8::gemm_phase<EpiGen<4>, StaticOrder, true, true>(ring, g, S, E);
    }
    if (IN(9) && IN(10)) GSYNC();

    }
#define X2B GT
#define PB ((bf16*)(ws + WS_PB))
    if (IN(10)) {
    { int ln_ = threadIdx.x; asm volatile("" : "+v"(ln_)); const int lane = ln_ & 63; constexpr int RB = 4;
    f32x4 gg[4];
#pragma unroll
    for (int j = 0; j < 4; ++j) gg[j] = ((const f32x4*)args.in[18] + lane)[64 * j];
    for (int m0 = gw; m0 < T; m0 += RB * NGW) {
        unsigned long long xq[RB][4], zq[RB][4]; float sv[RB]; f32x4 pv[RB];
#pragma unroll
        for (int r = 0; r < RB; ++r) { const int m = m0 + r * NGW; if (m < T) {
            sv[r] = (lane < 16) ? SS[(size_t)m * 16 + lane] : 0.f;
            const unsigned long long* x8 = (const unsigned long long*)((const bf16*)args.out + (size_t)m * D) + lane; const unsigned long long* zr = (const unsigned long long*)(Z + (size_t)m * D) + lane;
#pragma unroll
            for (int j = 0; j < 4; ++j) { xq[r][j] = x8[64 * j]; zq[r][j] = zr[64 * j]; }
            const float* prow = m < TP ? args.in[2] + (size_t)m * PLE : args.in[3] + (size_t)(m - TP) * PLE; pv[r] = ((const f32x4*)prow)[lane]; } }
#pragma unroll
        for (int r = 0; r < RB; ++r) { const int m = m0 + r * NGW; if (m < T) {
            const float rs = __builtin_amdgcn_rsqf(wave_sum(sv[r]) * (1.f / D) + EPS);
            unsigned long long* h8 = (unsigned long long*)(X2B + (size_t)m * D) + lane;
#pragma unroll
            for (int j = 0; j < 4; ++j) h8[64 * j] = pk4(unp4(xq[r][j]) + unp4(zq[r][j]) * rs * gg[j]);
            ((unsigned long long*)(PB + (size_t)m * PLE))[lane] = pk4(pv[r]); } }
    }
    }
    if (IN(10) && IN(11)) GSYNC();

    }
#define EP ((bf16*)(ws + WS_EP))
#define EB ((bf16*)(ws + WS_E))
    if (IN(11)) {
    {
        Gemm g{PB, WPLE, T, D, PLE}; StaticOrder S; S.init(T, D, G, bx); EpiGen<0> E{EP, D, nullptr, nullptr, nullptr, 1.f, 0};
        pg8::gemm_phase<EpiGen<0>, StaticOrder, true, true>(ring, g, S, E);
    }

    }

    if (IN(12)) {
    {
        Gemm g{X2B, WGATE, T, D, D}; StaticOrder S; S.init(T, D, G, bx); EpiGen<6> E{EB, D, EP, nullptr, SS, 1.f, 0};
        pg8::gemm_phase<EpiGen<6>, StaticOrder, true, true>(ring, g, S, E);
    }
    if (IN(12) && IN(13)) GSYNC();

    }

    if (IN(13)) {
    { int ln_ = threadIdx.x; asm volatile("" : "+v"(ln_)); const int lane = ln_ & 63; constexpr int RB = 4;
    f32x4 gg[4];
#pragma unroll
    for (int j = 0; j < 4; ++j) gg[j] = ((const f32x4*)args.in[21] + lane)[64 * j];
    for (int m0 = gw; m0 < T; m0 += RB * NGW) {
        unsigned long long xq[RB][4], zq[RB][4]; float sv[RB];
#pragma unroll
        for (int r = 0; r < RB; ++r) { const int m = m0 + r * NGW; if (m < T) {
            sv[r] = (lane < 16) ? SS[(size_t)m * 16 + lane] : 0.f;
            const unsigned long long* x8 = (const unsigned long long*)(X2B + (size_t)m * D) + lane; const unsigned long long* zr = (const unsigned long long*)(EB + (size_t)m * D) + lane;
#pragma unroll
            for (int j = 0; j < 4; ++j) { xq[r][j] = x8[64 * j]; zq[r][j] = zr[64 * j]; } } }
#pragma unroll
        for (int r = 0; r < RB; ++r) { const int m = m0 + r * NGW; if (m < T) {
            const float rs = __builtin_amdgcn_rsqf(wave_sum(sv[r]) * (1.f / D) + EPS);
            f32x4* orow = (f32x4*)(args.out + (size_t)m * D) + lane;
#pragma unroll
            for (int j = 0; j < 4; ++j) orow[64 * j] = unp4(xq[r][j]) + unp4(zq[r][j]) * rs * gg[j]; } }
    }
    }
    }

}


__global__ void __launch_bounds__(256) ck_kernel(const unsigned* buf, size_t nwords, unsigned* cs, int rep, unsigned* flag) {
    const size_t per = (nwords + gridDim.x - 1) / gridDim.x; const size_t lo = (size_t)blockIdx.x * per; size_t hi = lo + per; if (hi > nwords) hi = nwords;
    unsigned s = 0;
    for (size_t i = lo + threadIdx.x; i < hi; i += 256) { const unsigned w = buf[i]; s += w * 2654435761u + (w >> 7); }
    __shared__ unsigned red[256]; red[threadIdx.x] = s; __syncthreads();
    for (int o = 128; o > 0; o >>= 1) { if ((int)threadIdx.x < o) red[threadIdx.x] += red[threadIdx.x + o]; __syncthreads(); }
    if (threadIdx.x == 0) { if (rep == 0) cs[blockIdx.x] = red[0]; else if (cs[blockIdx.x] != red[0]) atomicOr(flag, 1u); }
}
__global__ void nanflag_kernel(float* out, const unsigned* flag) { if (*flag) out[0] = __builtin_nanf(""); }
__global__ void clrflag_kernel(unsigned* flag) { *flag = 0u; }
extern "C" void kernel_launch(void* const* d_in, const int* in_sizes, int n_in, void* d_out, int out_size, void* d_ws, size_t ws_size, hipStream_t stream) {
    static int grid = 0;
    if (grid == 0) {
        int dev = 0, cus = 0, per_cu = 0;
        hipGetDevice(&dev); hipDeviceGetAttribute(&cus, hipDeviceAttributeMultiprocessorCount, dev);
        hipFuncSetAttribute((const void*)fwd_mega, hipFuncAttributeMaxDynamicSharedMemorySize, LDS_BYTES);
        hipOccupancyMaxActiveBlocksPerMultiprocessor(&per_cu, (const void*)fwd_mega, NWAVES * 64, LDS_BYTES);
        if (per_cu < 1) per_cu = 1;
        grid = cus * per_cu;
        if (n_in != 22 || ws_size < (size_t)1008 * MiB) { fprintf(stderr, "kernel_launch: unexpected n_in %d / ws %zu\n", n_in, ws_size); }
    }
    hipMemsetAsync(d_ws, 0, 16384, stream);
    Args a{};
    for (int i = 0; i < 22; ++i) a.in[i] = (const float*)d_in[i];
    a.out = (float*)d_out; a.ws = (unsigned char*)d_ws;
#ifndef DBG_DOUBLE
#define DBG_DOUBLE 0
#endif
#ifndef N_LAUNCH_SPLIT
#define N_LAUNCH_SPLIT 0
#endif
    if (N_LAUNCH_SPLIT) {
#ifdef DBG_K
        unsigned char* w8 = (unsigned char*)d_ws; unsigned* flag = (unsigned*)(w8 + 512 * 1024); unsigned* cs = (unsigned*)(w8 + 600 * 1024);
        hipLaunchKernelGGL(clrflag_kernel, dim3(1), dim3(1), 0, stream, flag);
        for (int rep = 0; rep < 2; ++rep) {
            for (int p = (rep ? DBG_REP1_FROM : 0); p <= DBG_K; ++p) { a.ph_lo = p; a.ph_hi = p + 1; hipLaunchKernelGGL(fwd_mega, dim3(grid), dim3(NWAVES * 64), LDS_BYTES, stream, a); }
            const size_t offs[] = DBG_OFFS; const size_t lens[] = DBG_LENS; const int isout[] = DBG_ISOUT;
            for (int r = 0; r < (int)(sizeof(offs) / sizeof(offs[0])); ++r) {
                const unsigned char* base = isout[r] ? (const unsigned char*)d_out : w8;
                hipLaunchKernelGGL(ck_kernel, dim3(1024), dim3(256), 0, stream, (const unsigned*)(base + offs[r] * MiB), lens[r] * MiB / 4, cs + r * 1024, rep, flag); }
        }
        for (int p = DBG_K + 1; p < 14; ++p) { a.ph_lo = p; a.ph_hi = p + 1; hipLaunchKernelGGL(fwd_mega, dim3(grid), dim3(NWAVES * 64), LDS_BYTES, stream, a); }
        hipLaunchKernelGGL(nanflag_kernel, dim3(1), dim3(1), 0, stream, (float*)d_out, flag);
#else
        for (int p = 0; p < 14; ++p) { a.ph_lo = p; a.ph_hi = p + 1; const int reps = ((DBG_DOUBLE >> p) & 1) ? 2 : 1;
            for (int r = 0; r < reps; ++r) hipLaunchKernelGGL(fwd_mega, dim3(grid), dim3(NWAVES * 64), LDS_BYTES, stream, a); }
#endif
    } else {
        a.ph_lo = 0; a.ph_hi = 14;
        void* kargs[] = {&a};
        hipError_t e = hipLaunchCooperativeKernel((const void*)fwd_mega, dim3(grid), dim3(NWAVES * 64), kargs, LDS_BYTES, stream);
        if (e != hipSuccess) fprintf(stderr, "cooperative launch failed: %s (grid %d)\n", hipGetErrorString(e), grid);
    }
}
```

```cpp
#include <hip/hip_runtime.h>
#include <hip/hip_cooperative_groups.h>
#include <hip/hip_bf16.h>
#include <cstdio>
#include <cstdint>
namespace cg = cooperative_groups;

namespace xl {
__device__ __forceinline__ float dpp_f(float v, const int ctrl_sel) {
    int x = __builtin_bit_cast(int, v), r;
    if (ctrl_sel == 0) r = __builtin_amdgcn_mov_dpp(x, 0xB1, 0xF, 0xF, true);
    else if (ctrl_sel == 1) r = __builtin_amdgcn_mov_dpp(x, 0x4E, 0xF, 0xF, true);
    else if (ctrl_sel == 2) r = __builtin_amdgcn_mov_dpp(x, 0x141, 0xF, 0xF, true);
    else r = __builtin_amdgcn_mov_dpp(x, 0x140, 0xF, 0xF, true);
    return __builtin_bit_cast(float, r);
}
__device__ __forceinline__ float sum16(float v) { v += dpp_f(v, 0); v += dpp_f(v, 1); v += dpp_f(v, 2); v += dpp_f(v, 3); return v; }
__device__ __forceinline__ float add_x16(float v) { auto r = __builtin_amdgcn_permlane16_swap(__float_as_uint(v), __float_as_uint(v), false, false); return __uint_as_float(r[0]) + __uint_as_float(r[1]); }
__device__ __forceinline__ float add_x32(float v) { auto r = __builtin_amdgcn_permlane32_swap(__float_as_uint(v), __float_as_uint(v), false, false); return __uint_as_float(r[0]) + __uint_as_float(r[1]); }
__device__ __forceinline__ float get_x16(float v, bool odd_row) { auto r = __builtin_amdgcn_permlane16_swap(__float_as_uint(v), __float_as_uint(v), false, false); return __uint_as_float(odd_row ? r[0] : r[1]); }
__device__ __forceinline__ float sum32(float v) { return add_x16(sum16(v)); }
__device__ __forceinline__ float sum64(float v) { return add_x32(add_x16(sum16(v))); }
}
namespace pg8 {
#define PG8_LAS __attribute__((address_space(3)))
typedef unsigned short bf16_t;
typedef short bf16x8 __attribute__((ext_vector_type(8)));
typedef float f32x4 __attribute__((ext_vector_type(4)));
typedef unsigned u32x4 __attribute__((ext_vector_type(4)));
constexpr int BM = 256, BK = 64, HALF = 128, HTB = HALF * BK * 2  , STAGE_BYTES = 8 * HTB, NXCD = 8, WGM = 8;

__host__ __device__ __forceinline__ int lds_byte(int r, int c) { const int st = (r >> 4) * 2 + (c >> 5), rr = r & 15, cc = c & 31, ob = rr * 64 + cc * 2; return st * 1024 + (ob ^ (((ob >> 9) & 1) << 5)); }
__host__ __device__ __forceinline__ void stage_rc(int b, int& R, int& C) { const int st = b / 1024, sb = b % 1024, swz = sb ^ (((sb >> 9) & 1) << 5); R = (st >> 1) * 16 + swz / 64; C = (st & 1) * 32 + (swz % 64) / 2; }
__host__ __device__ __forceinline__ int perm32(int rho) { const int n = rho >> 4, i = rho & 15; return 8 * (i >> 2) + 4 * n + (i & 3); }

struct Unit { int pm, pn; };
struct Gemm { const bf16_t* A; const bf16_t* Bt; int M, N, K; };

struct StaticOrder {
    int nM, nN, nwg, G, c;
    __host__ __device__ void init(int M, int N, int G_, int c_) { nM = M / BM; nN = N / BM; nwg = nM * nN; G = G_; c = c_; }
    __host__ __device__ bool next(int i, Unit& u) const {
        const long L = (long)i * G + c; if (L >= nwg) return false;
        int wgid = (int)L; { const int q = nwg / NXCD, r = nwg % NXCD, xcd = wgid % NXCD, off = wgid / NXCD; wgid = (xcd < r ? xcd * (q + 1) : r * (q + 1) + (xcd - r) * q) + off; }
        const int nig = WGM * nN, gid = wgid / nig, fm = gid * WGM, gsz = (nM - fm) < WGM ? (nM - fm) : WGM;
        u.pm = fm + ((wgid % nig) % gsz); u.pn = (wgid % nig) / gsz; return true;
    }
    __device__ __forceinline__ void a_ready(const Unit&) const {}
    __device__ __forceinline__ void done(const Unit&) const {}
};

__device__ __forceinline__ unsigned cvt_pk_bf16(float lo, float hi) { unsigned r; asm volatile("s_nop 0\n\tv_cvt_pk_bf16_f32 %0, %1, %2" : "=v"(r) : "v"(lo), "v"(hi)); return r; }
__device__ __forceinline__ void unpack8(const u32x4 w, float (&f)[8]) {
#pragma unroll
    for (int i = 0; i < 4; ++i) { f[2 * i] = __uint_as_float(w[i] << 16); f[2 * i + 1] = __uint_as_float(w[i] & 0xffff0000u); }
}
__device__ __forceinline__ u32x4 pack8(const float (&f)[8]) { u32x4 w; w.x = cvt_pk_bf16(f[0], f[1]); w.y = cvt_pk_bf16(f[2], f[3]); w.z = cvt_pk_bf16(f[4], f[5]); w.w = cvt_pk_bf16(f[6], f[7]); return w; }
__device__ __forceinline__ float sigm(float x) { return __builtin_amdgcn_rcpf(1.0f + __builtin_amdgcn_exp2f(-1.4426950408889634f * x)); }
template <int MODE> struct EpiGen {
    static constexpr bool PERM = true, AFTER_DRAIN = false;
    bf16_t* O; int ldc; const bf16_t* X1; const bf16_t* X2; float* ss; float scale; size_t split_stride;
    __device__ __forceinline__ void operator()(const f32x4 (&acc)[2][2][4][2], const Unit& u, int wr_, int wc_, int fr_, int fq_) const {
        int t_ = threadIdx.x; asm volatile("" : "+v"(t_));
        const int wid_ = __builtin_amdgcn_readfirstlane(t_ >> 6), wr = wid_ >> 2, wc = wid_ & 3, fr = t_ & 15, fq = (t_ >> 4) & 3;
        const int row0 = u.pm * BM + wr * 64 + fr; int colt = u.pn * BM; bf16_t* base = O;
        if (MODE == 1) { const int t = colt >> 10; base += (size_t)t * split_stride; colt -= t << 10; }
        const int col0 = colt + wc * 32 + 8 * fq;
#pragma unroll
        for (int ai = 0; ai < 2; ++ai)
#pragma unroll
            for (int m = 0; m < 4; ++m) { const int row = row0 + ai * HALF + m * 16; const size_t ro = (size_t)row * ldc + col0; float sq = 0.f;
#pragma unroll
                for (int bj = 0; bj < 2; ++bj) { float v[8];
#pragma unroll
                    for (int i = 0; i < 4; ++i) { v[i] = acc[ai][bj][m][0][i]; v[4 + i] = acc[ai][bj][m][1][i]; }
                    const size_t off = ro + bj * HALF;
                    if (MODE == 1) {
#pragma unroll
                        for (int i = 0; i < 8; ++i) v[i] = sigm(v[i]); }
                    if (MODE == 2) { float a[8]; unpack8(*(const u32x4*)(X1 + off), a);
#pragma unroll
                        for (int i = 0; i < 8; ++i) v[i] *= a[i]; }
                    if (MODE == 3) { float a[8], b[8]; unpack8(*(const u32x4*)(X1 + off), a); unpack8(*(const u32x4*)(X2 + off), b);
#pragma unroll
                        for (int i = 0; i < 8; ++i) v[i] = a[i] + b[i] * v[i]; }
                    if (MODE == 5) {
#pragma unroll
                        for (int i = 0; i < 8; ++i) { const float r = fmaxf(v[i], 0.f); v[i] = r * r; } }
                    if (MODE == 6) { float a[8]; unpack8(*(const u32x4*)(X1 + off), a);
#pragma unroll
                        for (int i = 0; i < 8; ++i) v[i] = a[i] * sigm(v[i]); }
                    if (MODE == 4 || MODE == 6) {
#pragma unroll
                        for (int i = 0; i < 8; ++i) sq += v[i] * v[i]; }
                    *(u32x4*)(base + off) = pack8(v); }
                if (MODE == 4 || MODE == 6) { sq = xl::add_x32(xl::add_x16(sq)); if (fq == 0) ss[(size_t)row * 16 + u.pn * 4 + wc] = sq; }
            }
    }
};
struct EpiGT {
    static constexpr bool PERM = true, AFTER_DRAIN = false;
    bf16_t* GT;
    __device__ __forceinline__ void operator()(const f32x4 (&acc)[2][2][4][2], const Unit& u, int wr, int wc, int fr, int fq) const {
        const int n0 = u.pm * BM + wr * 64 + fr; const int t0 = u.pn * BM + wc * 32 + 8 * fq;
#pragma unroll
        for (int bj = 0; bj < 2; ++bj) { const int t = t0 + bj * HALF; size_t tb; int S, s, b;
            if (t < 65536) { b = t >> 11; s = t & 2047; S = 2048; tb = 0; } else { const int tt = t - 65536; b = tt >> 13; s = tt & 8191; S = 8192; tb = (size_t)65536 * 1024; }
#pragma unroll
            for (int ai = 0; ai < 2; ++ai)
#pragma unroll
                for (int m = 0; m < 4; ++m) { const int n = n0 + ai * HALF + m * 16, comp = n >> 9, c = n & 511; float v[8];
#pragma unroll
                    for (int i = 0; i < 4; ++i) { v[i] = acc[ai][bj][m][0][i]; v[4 + i] = acc[ai][bj][m][1][i]; }
                    *(u32x4*)(GT + tb + ((size_t)(b * 512 + c) * 2 + comp) * S + s) = pack8(v); } }
    }
};
struct EpiQKV {
    static constexpr bool PERM = true, AFTER_DRAIN = false;
    bf16_t* Gb; bf16_t* Q; bf16_t* K; size_t vstride; const float* rope;
    __device__ __forceinline__ void operator()(const f32x4 (&acc)[2][2][4][2], const Unit& u, int wr, int wc, int fr, int fq) const {
        const int row0 = u.pm * BM + wr * 64 + fr; int colt = u.pn * BM; const int t = colt >> 10; bf16_t* base = (t == 0) ? Gb : ((t == 1) ? Q : (K + (size_t)(t - 2) * vstride)); colt -= t << 10;
        const int col0 = colt + wc * 32 + 8 * fq; const bool rot = (t == 1 || t == 2) && ((wc & 1) == 0);
        if (rot) {
#pragma unroll
            for (int ai = 0; ai < 2; ++ai) {
                f32x4 rc[4][4];
#pragma unroll
                for (int m = 0; m < 4; ++m) { const int row = row0 + ai * HALF + m * 16; const int pos = row < 65536 ? (row & 2047) : (row & 8191); const f32x4* rp = (const f32x4*)(rope + (size_t)pos * 16);
#pragma unroll
                    for (int j = 0; j < 4; ++j) rc[m][j] = rp[j]; }
#pragma unroll
                for (int m = 0; m < 4; ++m) { const int row = row0 + ai * HALF + m * 16; const size_t ro = (size_t)row * 1024 + col0;
#pragma unroll
                    for (int bj = 0; bj < 2; ++bj) { float v[8];
#pragma unroll
                        for (int i = 0; i < 4; ++i) { v[i] = acc[ai][bj][m][0][i]; v[4 + i] = acc[ai][bj][m][1][i]; }
#pragma unroll
                        for (int i = 0; i < 8; ++i) { const float o = xl::get_x16(v[i], (fq & 1) != 0); const float c = rc[m][i >> 2][i & 3], s = rc[m][2 + (i >> 2)][i & 3];
                            const float r = (fq == 0) ? (v[i] * c - o * s) : (v[i] * c + o * s);
                            v[i] = (fq < 2) ? r : v[i]; }
                        *(u32x4*)(base + ro + bj * HALF) = pack8(v); } }
            }
        } else {
#pragma unroll
            for (int ai = 0; ai < 2; ++ai)
#pragma unroll
                for (int m = 0; m < 4; ++m) { const int row = row0 + ai * HALF + m * 16; const size_t ro = (size_t)row * 1024 + col0;
#pragma unroll
                    for (int bj = 0; bj < 2; ++bj) { float v[8];
#pragma unroll
                        for (int i = 0; i < 4; ++i) { v[i] = acc[ai][bj][m][0][i]; v[4 + i] = acc[ai][bj][m][1][i]; }
                        *(u32x4*)(base + ro + bj * HALF) = pack8(v); } }
        }
    }
};
struct EpiDFT {
    static constexpr bool PERM = true, AFTER_DRAIN = false;
    bf16_t* F; int S; float scale;
    __device__ __forceinline__ void operator()(const f32x4 (&acc)[2][2][4][2], const Unit& u, int wr, int wc, int fr, int fq) const {
        const int b = u.pn >> 1, ct = u.pn & 1; const int row0 = b * S + u.pm * BM + wr * 64 + fr; const int col0 = ct * BM + wc * 32 + 8 * fq;
#pragma unroll
        for (int ai = 0; ai < 2; ++ai)
#pragma unroll
            for (int m = 0; m < 4; ++m) { const size_t ro = (size_t)(row0 + ai * HALF + m * 16) * 512 + col0;
#pragma unroll
                for (int bj = 0; bj < 2; ++bj) { float v[8];
#pragma unroll
                    for (int i = 0; i < 4; ++i) { v[i] = acc[ai][bj][m][0][i] * scale; v[4 + i] = acc[ai][bj][m][1][i] * scale; }
                    *(u32x4*)(F + ro + bj * HALF) = pack8(v); } }
    }
};
struct ListOrder {
    int base, count, nfast; bool pnfast;
    __device__ bool next(int i, Unit& u) const { if (i >= count) return false; const int idx = base + i; if (pnfast) { u.pn = idx % nfast; u.pm = idx / nfast; } else { u.pm = idx % nfast; u.pn = idx / nfast; } return true; }
    __device__ __forceinline__ void a_ready(const Unit&) const {}
    __device__ __forceinline__ void done(const Unit&) const {}
};
template <class Epi, class Sched, bool ALIGN_EPI = false, bool SP2 = false>
__device__ __forceinline__ void gemm_phase(PG8_LAS unsigned char* lds, const Gemm g, const Sched& S, const Epi& E) {
    int tid_ = threadIdx.x; asm volatile("" : "+v"(tid_));
    const int tid = tid_, wid = __builtin_amdgcn_readfirstlane(tid >> 6), lane = tid & 63, wr = wid >> 2, wc = wid & 3, fr = lane & 15, fq = lane >> 4;
    const int K = g.K, nt = K / BK;
    unsigned voffA[2], voffB[2];
#pragma unroll
    for (int i = 0; i < 2; ++i) { int R, C; stage_rc(tid * 16 + i * 8192, R, C); const int Rb = Epi::PERM ? ((R & ~31) + perm32(R & 31)) : R;
        voffA[i] = (unsigned)(R * K + C) * 2u; voffB[i] = (unsigned)(Rb * K + C) * 2u; }
    const size_t kstep = (size_t)(BK * 2);
    const size_t hstep = (size_t)HALF * K * 2;
    const size_t tstep = 2 * hstep;
    const unsigned ldsw = (unsigned)wid * 1024u;
    const int aoff = lds_byte(wr * 64 + fr, fq * 8), boff = lds_byte(wc * 32 + fr, fq * 8);
#define PG8_SA(b, h) (((b) * 2 + (h)) * HTB)
#define PG8_SB(b, h) ((4 + (b) * 2 + (h)) * HTB)
#define PG8_STAGE(bufoff, gbase, voff) do { _Pragma("unroll") for (int _i = 0; _i < 2; ++_i) \
        __builtin_amdgcn_global_load_lds((const unsigned*)((const char*)(gbase) + (voff)[_i]), (PG8_LAS unsigned*)(lds + (bufoff) + ldsw + _i * 8192), 16, 0, 0); } while (0)
#define PG8_LDA(dst, b, h) do { _Pragma("unroll") for (int m = 0; m < 4; ++m) _Pragma("unroll") for (int k = 0; k < 2; ++k) dst[m][k] = *(const PG8_LAS bf16x8*)(lds + PG8_SA(b, h) + aoff + m * 2048 + k * 1024); } while (0)
#define PG8_LDB(dst, b, h) do { _Pragma("unroll") for (int n = 0; n < 2; ++n) _Pragma("unroll") for (int k = 0; k < 2; ++k) dst[n][k] = *(const PG8_LAS bf16x8*)(lds + PG8_SB(b, h) + boff + n * 2048 + k * 1024); } while (0)
#define PG8_MMA(ai, bj, At, Bt) do { __builtin_amdgcn_s_setprio(1); _Pragma("unroll") for (int m = 0; m < 4; ++m) _Pragma("unroll") for (int n = 0; n < 2; ++n) _Pragma("unroll") for (int k = 0; k < 2; ++k) \
        acc[ai][bj][m][n] = __builtin_amdgcn_mfma_f32_16x16x32_bf16(Bt[n][k], At[m][k], acc[ai][bj][m][n], 0, 0, 0); __builtin_amdgcn_s_setprio(0); } while (0)
#define PG8_WAIT_V(n) asm volatile("s_waitcnt vmcnt(" #n ")" ::: "memory")
#define PG8_WAIT_L(n) asm volatile("s_waitcnt lgkmcnt(" #n ")" ::: "memory")
#define PG8_BAR __builtin_amdgcn_s_barrier()
#define PG8_SCHED __builtin_amdgcn_sched_barrier(0)
    Unit cur, nxt; int ui = 0;
    if (!S.next(0, cur)) return;
    f32x4 acc[2][2][4][2];
#pragma unroll
    for (int a = 0; a < 2; ++a)
#pragma unroll
        for (int b = 0; b < 2; ++b)
#pragma unroll
            for (int m = 0; m < 4; ++m)
#pragma unroll
                for (int n = 0; n < 2; ++n) acc[a][b][m][n] = (f32x4){0.f, 0.f, 0.f, 0.f};
    bf16x8 At[4][2], B0[2][2], B1[2][2];
    const char* cA = (const char*)g.A + (size_t)cur.pm * tstep; const char* cB = (const char*)g.Bt + (size_t)cur.pn * tstep;
    S.a_ready(cur);
    if constexpr (SP2) {
        PG8_STAGE(PG8_SB(0, 0), cB, voffB); PG8_STAGE(PG8_SB(0, 1), cB + hstep, voffB); PG8_STAGE(PG8_SA(0, 0), cA, voffA); PG8_STAGE(PG8_SA(0, 1), cA + hstep, voffA);
        if (wr == 1) PG8_BAR;
        PG8_WAIT_V(2); PG8_BAR;
        PG8_STAGE(PG8_SB(1, 0), cB + kstep, voffB); PG8_STAGE(PG8_SA(1, 0), cA + kstep, voffA); PG8_STAGE(PG8_SB(1, 1), cB + hstep + kstep, voffB);
        PG8_WAIT_V(6); PG8_BAR;
    } else {
        PG8_STAGE(PG8_SB(0, 0), cB, voffB); PG8_STAGE(PG8_SA(0, 0), cA, voffA); PG8_STAGE(PG8_SB(0, 1), cB + hstep, voffB); PG8_STAGE(PG8_SA(0, 1), cA + hstep, voffA);
        if (wr == 1) PG8_BAR;
        PG8_WAIT_V(4); PG8_BAR;
        PG8_STAGE(PG8_SB(1, 0), cB + kstep, voffB); PG8_STAGE(PG8_SA(1, 0), cA + kstep, voffA); PG8_STAGE(PG8_SB(1, 1), cB + hstep + kstep, voffB);
        PG8_WAIT_V(6); PG8_BAR;
    }
    for (;;) {
        const bool has_next = S.next(ui + 1, nxt);
        const char* nA = has_next ? (const char*)g.A + (size_t)nxt.pm * tstep : cA; const char* nB = has_next ? (const char*)g.Bt + (size_t)nxt.pn * tstep : cB;
        for (int t = 0; t < nt; t += 2) {
            const bool last = (t == nt - 2);
            const char* a1 = cA + (size_t)(t + 1) * kstep;
            const char* a2 = last ? nA : cA + (size_t)(t + 2) * kstep; const char* b2 = last ? nB : cB + (size_t)(t + 2) * kstep;
            const char* a3 = a2 + kstep; const char* b3 = b2 + kstep;
            if (last && has_next) S.a_ready(nxt);
            if constexpr (SP2) {
            PG8_LDB(B0, 0, 0); PG8_LDB(B1, 0, 1); PG8_SCHED; PG8_LDA(At, 0, 0); PG8_STAGE(PG8_SA(1, 1), a1 + hstep, voffA);
            PG8_WAIT_V(8); PG8_WAIT_L(0); PG8_BAR; PG8_MMA(0, 0, At, B0); PG8_MMA(0, 1, At, B1); PG8_BAR; PG8_SCHED;
            PG8_LDA(At, 0, 1); PG8_STAGE(PG8_SB(0, 0), b2, voffB); PG8_STAGE(PG8_SB(0, 1), b2 + hstep, voffB); PG8_STAGE(PG8_SA(0, 0), a2, voffA);
            PG8_WAIT_V(8); PG8_WAIT_L(0); PG8_BAR; PG8_MMA(1, 0, At, B0); PG8_MMA(1, 1, At, B1); PG8_BAR; PG8_SCHED;
            PG8_LDB(B0, 1, 0); PG8_LDB(B1, 1, 1); PG8_SCHED; PG8_LDA(At, 1, 0); PG8_STAGE(PG8_SA(0, 1), a2 + hstep, voffA);
            PG8_WAIT_V(8); PG8_WAIT_L(0); PG8_BAR; PG8_MMA(0, 0, At, B0); PG8_MMA(0, 1, At, B1); PG8_BAR; PG8_SCHED;
            PG8_LDA(At, 1, 1); PG8_STAGE(PG8_SB(1, 0), b3, voffB); PG8_STAGE(PG8_SB(1, 1), b3 + hstep, voffB); PG8_STAGE(PG8_SA(1, 0), a3, voffA);
            PG8_WAIT_V(8); PG8_WAIT_L(0); PG8_BAR; PG8_MMA(1, 0, At, B0); PG8_MMA(1, 1, At, B1); PG8_BAR; PG8_SCHED;
            } else {
            PG8_LDB(B0, 0, 0); PG8_SCHED; PG8_LDA(At, 0, 0); PG8_STAGE(PG8_SA(1, 1), a1 + hstep, voffA);
            PG8_WAIT_L(8); PG8_BAR; PG8_WAIT_L(0); PG8_MMA(0, 0, At, B0); PG8_BAR; PG8_SCHED;
            PG8_LDB(B1, 0, 1); PG8_STAGE(PG8_SB(0, 0), b2, voffB);
            PG8_BAR; PG8_WAIT_L(0); PG8_MMA(0, 1, At, B1); PG8_BAR;
            PG8_LDA(At, 0, 1); PG8_STAGE(PG8_SA(0, 0), a2, voffA);
            PG8_BAR; PG8_WAIT_L(0); PG8_MMA(1, 0, At, B0); PG8_BAR; PG8_SCHED;
            PG8_STAGE(PG8_SB(0, 1), b2 + hstep, voffB);
            PG8_WAIT_V(6); PG8_BAR; PG8_MMA(1, 1, At, B1); PG8_BAR;
            PG8_LDB(B0, 1, 0); PG8_SCHED; PG8_LDA(At, 1, 0); PG8_STAGE(PG8_SA(0, 1), a2 + hstep, voffA);
            PG8_WAIT_L(8); PG8_BAR; PG8_WAIT_L(0); PG8_MMA(0, 0, At, B0); PG8_BAR; PG8_SCHED;
            PG8_LDB(B1, 1, 1); PG8_STAGE(PG8_SB(1, 0), b3, voffB);
            PG8_BAR; PG8_WAIT_L(0); PG8_MMA(0, 1, At, B1); PG8_BAR;
            PG8_LDA(At, 1, 1); PG8_STAGE(PG8_SA(1, 0), a3, voffA);
            PG8_BAR; PG8_WAIT_L(0); PG8_MMA(1, 0, At, B0); PG8_BAR; PG8_SCHED;
            PG8_STAGE(PG8_SB(1, 1), b3 + hstep, voffB);
            PG8_WAIT_V(6); PG8_BAR; PG8_MMA(1, 1, At, B1); PG8_BAR;
            }
        }
        if constexpr (ALIGN_EPI) { if (wr == 0) PG8_BAR; }
        if constexpr (!Epi::AFTER_DRAIN) { E(acc, cur, wr, wc, fr, fq); S.done(cur); }
        if (!has_next) break;
#pragma unroll
        for (int a = 0; a < 2; ++a)
#pragma unroll
            for (int b = 0; b < 2; ++b)
#pragma unroll
                for (int m = 0; m < 4; ++m)
#pragma unroll
                    for (int n = 0; n < 2; ++n) acc[a][b][m][n] = (f32x4){0.f, 0.f, 0.f, 0.f};
        cur = nxt; cA = nA; cB = nB; ++ui;
        if constexpr (ALIGN_EPI) { if (wr == 1) PG8_BAR; }
    }
    PG8_WAIT_V(0);
    if constexpr (!ALIGN_EPI) { if (wr == 0) PG8_BAR; }
    PG8_BAR;
    if constexpr (Epi::AFTER_DRAIN) { E.fused(acc, cur, wr, wc, fr, fq, lds, wid, lane); S.done(cur); }
#undef PG8_SA
#undef PG8_SB
#undef PG8_STAGE
#undef PG8_LDA
#undef PG8_LDB
#undef PG8_MMA
#undef PG8_WAIT_V
#undef PG8_WAIT_L
#undef PG8_BAR
#undef PG8_SCHED
}
}
namespace att {
using bf16x8 = __attribute__((ext_vector_type(8))) short;
using s16x4  = __attribute__((ext_vector_type(4))) short;
using f32x16 = __attribute__((ext_vector_type(16))) float;
using u32x4  = __attribute__((ext_vector_type(4))) unsigned;
using f32x4v = __attribute__((ext_vector_type(4))) float;
typedef unsigned short bf16_t;
constexpr int NW = 8, QBLK = 32, KVBLK = 64, LD = 1024;
constexpr float SCALE = 0.125f, THR = 8.f;
constexpr int SHM_V = KVBLK * 128 * 2, SHM_K = KVBLK * 64 * 2, SHM_ATTN = 3 * SHM_V + 3 * SHM_K + NW * 64 * 4;
#define KSWZ(row, colB) ((row) * 128 + ((colB) ^ ((((row) >> 1) & 7) << 4)))
#define SBAR() __builtin_amdgcn_sched_barrier(0)
__device__ __forceinline__ int crow(int r, int hi) { return (r & 3) + 8 * (r >> 2) + 4 * hi; }
__device__ __forceinline__ unsigned cvtpk(float lo, float hi) { unsigned r; asm volatile("s_nop 0\n\tv_cvt_pk_bf16_f32 %0, %1, %2" : "=v"(r) : "v"(lo), "v"(hi)); return r; }
__device__ __forceinline__ void partialSM(f32x16& p0, f32x16& p1, float& m_reg, float& mn, float& alpha) {
  constexpr float C = SCALE * 1.4426950408889634f;
  float pmax = p0[0];
#pragma unroll
  for (int r = 1; r < 16; ++r) pmax = fmaxf(pmax, p0[r]);
#pragma unroll
  for (int r = 0; r < 16; ++r) pmax = fmaxf(pmax, p1[r]);
  { auto rr = __builtin_amdgcn_permlane32_swap(__float_as_uint(pmax), __float_as_uint(pmax), false, false);
    pmax = fmaxf(__uint_as_float(rr[0]), __uint_as_float(rr[1])); }
  if (__builtin_expect(__all(pmax - m_reg <= THR / SCALE), 1)) { mn = m_reg; alpha = 1.f; }
  else { mn = fmaxf(m_reg, pmax); alpha = __builtin_amdgcn_exp2f((m_reg - mn) * C); m_reg = mn; }
  float mnC = -mn * C;
#pragma unroll
  for (int r = 0; r < 16; ++r) p0[r] = fmaf(p0[r], C, mnC);
#pragma unroll
  for (int r = 0; r < 16; ++r) p1[r] = fmaf(p1[r], C, mnC);
#pragma unroll
  for (int r = 0; r < 16; ++r) p0[r] = __builtin_amdgcn_exp2f(p0[r]);
}
__device__ __forceinline__ void finishSM(f32x16& p0, f32x16& p1, float alpha, float& l_reg, bf16x8& pa0, bf16x8& pa1, bf16x8& pa2, bf16x8& pa3) {
#pragma unroll
  for (int r = 0; r < 16; ++r) p1[r] = __builtin_amdgcn_exp2f(p1[r]);
  float ps = 0;
#pragma unroll
  for (int r = 0; r < 16; ++r) ps += p0[r];
#pragma unroll
  for (int r = 0; r < 16; ++r) ps += p1[r];
  { auto rr = __builtin_amdgcn_permlane32_swap(__float_as_uint(ps), __float_as_uint(ps), false, false);
    ps = __uint_as_float(rr[0]) + __uint_as_float(rr[1]); }
  l_reg = l_reg * alpha + ps;
#define PK4(P, BASE, OUT) do { unsigned a0 = cvtpk(P[BASE + 0], P[BASE + 1]), a1 = cvtpk(P[BASE + 2], P[BASE + 3]);   \
    unsigned b0 = cvtpk(P[BASE + 4], P[BASE + 5]), b1 = cvtpk(P[BASE + 6], P[BASE + 7]);                              \
    auto r0 = __builtin_amdgcn_permlane32_swap(a0, b0, false, false); auto r1 = __builtin_amdgcn_permlane32_swap(a1, b1, false, false); \
    u32x4 w = {r0[0], r1[0], r0[1], r1[1]}; OUT = *reinterpret_cast<bf16x8*>(&w); } while (0)
  PK4(p0, 0, pa0); PK4(p0, 8, pa1); PK4(p1, 0, pa2); PK4(p1, 8, pa3);
#undef PK4
}
__device__ __forceinline__ void qkt(f32x16& p0, f32x16& p1, const char* Ks, const bf16x8* qr, int r32, int hi) {
  p0 = f32x16{}; p1 = f32x16{};
#pragma unroll
  for (int d0 = 0; d0 < 4; ++d0) { int cb = (d0 * 16 + hi * 8) * 2;
    bf16x8 b0 = *reinterpret_cast<const bf16x8*>(Ks + KSWZ(r32, cb));
    bf16x8 b1 = *reinterpret_cast<const bf16x8*>(Ks + KSWZ(32 + r32, cb));
    p0 = __builtin_amdgcn_mfma_f32_32x32x16_bf16(b0, qr[d0], p0, 0, 0, 0);
    p1 = __builtin_amdgcn_mfma_f32_32x32x16_bf16(b1, qr[d0], p1, 0, 0, 0); }
}
__device__ __forceinline__ int v_st(int k, int c) { const int kk = (k & ~0xC) | ((k & 4) << 1) | ((k & 8) >> 1); return ((kk >> 3) * 4 + (c >> 5)) * 512 + ((kk & 7) * 32 + (c & 31)) * 2; }
__device__ __forceinline__ int v_rd_base(int lane) { return ((lane & 3) << 3) | (((lane >> 2) & 3) << 6) | (((lane >> 4) & 1) << 5) | (((lane >> 5) & 1) << 8); }
constexpr int v_rd_off(int d0, int ks, int half) { return d0 * 512 + ks * 4096 + half * 2048; }
template <int OFF> __device__ __forceinline__ s16x4 tr_read(int vb) {
  s16x4 r; asm volatile("ds_read_b64_tr_b16 %0, %1 offset:%2" : "=&v"(r) : "v"(vb), "i"(OFF) : "memory"); return r;
}
template <int D0> __device__ __forceinline__ void pv_one(f32x16& od, int vb, bf16x8 pa0, bf16x8 pa1, bf16x8 pa2, bf16x8 pa3) {
  const s16x4 l0 = tr_read<v_rd_off(D0, 0, 0)>(vb), h0 = tr_read<v_rd_off(D0, 0, 1)>(vb), l1 = tr_read<v_rd_off(D0, 1, 0)>(vb), h1 = tr_read<v_rd_off(D0, 1, 1)>(vb);
  const s16x4 l2 = tr_read<v_rd_off(D0, 2, 0)>(vb), h2 = tr_read<v_rd_off(D0, 2, 1)>(vb), l3 = tr_read<v_rd_off(D0, 3, 0)>(vb), h3 = tr_read<v_rd_off(D0, 3, 1)>(vb);
  asm volatile("s_waitcnt lgkmcnt(0)" ::: "memory"); SBAR();
#define PK(L, H) (bf16x8){L[0], L[1], L[2], L[3], H[0], H[1], H[2], H[3]}
  od = __builtin_amdgcn_mfma_f32_32x32x16_bf16(pa0, PK(l0, h0), od, 0, 0, 0);
  od = __builtin_amdgcn_mfma_f32_32x32x16_bf16(pa1, PK(l1, h1), od, 0, 0, 0);
  od = __builtin_amdgcn_mfma_f32_32x32x16_bf16(pa2, PK(l2, h2), od, 0, 0, 0);
  od = __builtin_amdgcn_mfma_f32_32x32x16_bf16(pa3, PK(l3, h3), od, 0, 0, 0);
#undef PK
}
__device__ __forceinline__ void pv_d0(f32x16* o, int vb, bf16x8 pa0, bf16x8 pa1, bf16x8 pa2, bf16x8 pa3) {
  pv_one<0>(o[0], vb, pa0, pa1, pa2, pa3); pv_one<1>(o[1], vb, pa0, pa1, pa2, pa3); pv_one<2>(o[2], vb, pa0, pa1, pa2, pa3); pv_one<3>(o[3], vb, pa0, pa1, pa2, pa3);
}
__device__ __forceinline__ void pv_sm(f32x16* o, int vb, bf16x8 pa0, bf16x8 pa1, bf16x8 pa2, bf16x8 pa3, f32x16& p0, f32x16& p1, float& m_reg, float& mn, float& alpha) {
  constexpr float C = SCALE * 1.4426950408889634f;
  pv_one<0>(o[0], vb, pa0, pa1, pa2, pa3);
  float pmax = p0[0];
#pragma unroll
  for (int r = 1; r < 16; ++r) pmax = fmaxf(pmax, p0[r]);
#pragma unroll
  for (int r = 0; r < 16; ++r) pmax = fmaxf(pmax, p1[r]);
  { auto rr = __builtin_amdgcn_permlane32_swap(__float_as_uint(pmax), __float_as_uint(pmax), false, false);
    pmax = fmaxf(__uint_as_float(rr[0]), __uint_as_float(rr[1])); }
  pv_one<1>(o[1], vb, pa0, pa1, pa2, pa3);
  const bool keep = __all(pmax - m_reg <= THR / SCALE);
  mn = keep ? m_reg : fmaxf(m_reg, pmax); alpha = __builtin_amdgcn_exp2f((m_reg - mn) * C); m_reg = mn;
  const float mnC = -mn * C;
#pragma unroll
  for (int r = 0; r < 16; ++r) p0[r] = fmaf(p0[r], C, mnC);
  pv_one<2>(o[2], vb, pa0, pa1, pa2, pa3);
#pragma unroll
  for (int r = 0; r < 16; ++r) p1[r] = fmaf(p1[r], C, mnC);
#pragma unroll
  for (int r = 0; r < 8; ++r) p0[r] = __builtin_amdgcn_exp2f(p0[r]);
  pv_one<3>(o[3], vb, pa0, pa1, pa2, pa3);
#pragma unroll
  for (int r = 8; r < 16; ++r) p0[r] = __builtin_amdgcn_exp2f(p0[r]);
}
__device__ __forceinline__ void attn_unit(const bf16_t* Qb, const bf16_t* Kb, const bf16_t* Vh, bf16_t* Ob, int seq, char* lds, float* stash, float lam, const float* subln) {
  int tid_ = threadIdx.x; asm volatile("" : "+v"(tid_));
  const int tid = tid_, wid = tid >> 6, lane = tid & 63, r32 = lane & 31, hi = lane >> 5;
  char* V_lds = lds; char* K_lds = lds + 3 * SHM_V;
  float* ws = (float*)(lds + 3 * SHM_V + 3 * SHM_K) + wid * 64; float* li_l = ws; float* al_l = ws + 32;
  const int sr = tid >> 4, sc = (tid & 15) * 8, vst0 = v_st(sr, sc), vst1 = v_st(32 + sr, sc);
  const int kr = tid >> 3, kc = (tid & 7) * 8, kst = KSWZ(kr, kc * 2);
  const int vb0 = (int)(uintptr_t)V_lds + v_rd_base(lane);
  const int NT = seq / KVBLK;
  f32x16 o[4];
  u32x4* const sl = (u32x4*)(lds + 3 * SHM_V + 3 * SHM_K + NW * 64 * 4) + tid;
  for (int comp = 0; comp < 2; ++comp) {
    const bf16_t* Kh = Kb + comp * 64;
    float m_reg = -1e30f, l_reg = 0; bf16x8 qr[4];
#pragma unroll
    for (int d = 0; d < 4; ++d) o[d] = f32x16{};
    const bf16_t* Qw = Qb + comp * 64 + (long)(wid * QBLK + r32) * LD + hi * 8;
#pragma unroll
    for (int d0 = 0; d0 < 4; ++d0) qr[d0] = *reinterpret_cast<const bf16x8*>(Qw + d0 * 16);
    struct { bf16x8 vs0, vs1, ks0; } sr_[2];
#define SLOAD(i, k0) do { sr_[i].vs0 = *reinterpret_cast<const bf16x8*>(&Vh[(long)((k0) + sr) * LD + sc]); sr_[i].vs1 = *reinterpret_cast<const bf16x8*>(&Vh[(long)((k0) + 32 + sr) * LD + sc]); \
    sr_[i].ks0 = *reinterpret_cast<const bf16x8*>(&Kh[(long)((k0) + kr) * LD + kc]); } while (0)
#define SWRITE(b, i) do { *(bf16x8*)(V_lds + (b) * SHM_V + vst0) = sr_[i].vs0; *(bf16x8*)(V_lds + (b) * SHM_V + vst1) = sr_[i].vs1; \
    *(bf16x8*)(K_lds + (b) * SHM_K + kst) = sr_[i].ks0; } while (0)
#define SWAIT() asm volatile("s_waitcnt vmcnt(3)" ::: "memory")
#define RESC(a) do { if (__any((a) < 1.f)) { if (hi == 0) al_l[r32] = (a); asm volatile("s_waitcnt lgkmcnt(0)" ::: "memory"); \
    _Pragma("unroll") for (int d = 0; d < 4; ++d) _Pragma("unroll") for (int r = 0; r < 16; ++r) o[d][r] *= al_l[crow(r, hi)]; } } while (0)
    f32x16 pA0, pA1, pB0, pB1; float mnA, mnB, alA, alB; bf16x8 pa0, pa1, pa2, pa3;
    int bp = 0, bc = 1, bn = 2;
#define ROT3() do { const int t_ = bp; bp = bc; bc = bn; bn = t_; } while (0)
    SLOAD(0, 0); asm volatile("s_waitcnt vmcnt(0)" ::: "memory"); SWRITE(0, 0); __syncthreads();
    qkt(pA0, pA1, K_lds, qr, r32, hi); partialSM(pA0, pA1, m_reg, mnA, alA);
    SLOAD(1, KVBLK); if (2 < NT) SLOAD(0, 2 * KVBLK);
    SWAIT(); SWRITE(1, 1); __syncthreads();
    for (int j = 1; j + 1 < NT; j += 2) {
      SBAR(); qkt(pB0, pB1, K_lds + bc * SHM_K, qr, r32, hi);
      finishSM(pA0, pA1, alA, l_reg, pa0, pa1, pa2, pa3); SBAR();
      SLOAD(1, (j + 2) * KVBLK); SBAR();
      pv_sm(o, vb0 + bp * SHM_V, pa0, pa1, pa2, pa3, pB0, pB1, m_reg, mnB, alB);
      SWAIT(); SWRITE(bn, 0);
      RESC(alB); __syncthreads(); ROT3();
      SBAR(); qkt(pA0, pA1, K_lds + bc * SHM_K, qr, r32, hi);
      finishSM(pB0, pB1, alB, l_reg, pa0, pa1, pa2, pa3); SBAR();
      if (j + 3 < NT) SLOAD(0, (j + 3) * KVBLK); SBAR();
      pv_sm(o, vb0 + bp * SHM_V, pa0, pa1, pa2, pa3, pA0, pA1, m_reg, mnA, alA);
      SWAIT(); SWRITE(bn, 1);
      RESC(alA); __syncthreads(); ROT3();
    }
    SBAR(); qkt(pB0, pB1, K_lds + bc * SHM_K, qr, r32, hi);
    finishSM(pA0, pA1, alA, l_reg, pa0, pa1, pa2, pa3); SBAR();
    pv_sm(o, vb0 + bp * SHM_V, pa0, pa1, pa2, pa3, pB0, pB1, m_reg, mnB, alB);
    RESC(alB);
    finishSM(pB0, pB1, alB, l_reg, pa0, pa1, pa2, pa3); SBAR();
    pv_d0(o, vb0 + bc * SHM_V, pa0, pa1, pa2, pa3);
#undef ROT3
    if (hi == 0) li_l[r32] = l_reg; asm volatile("s_waitcnt lgkmcnt(0)" ::: "memory");
#pragma unroll
    for (int r = 0; r < 16; ++r) { const float rl = __builtin_amdgcn_rcpf(li_l[crow(r, hi)]);
#pragma unroll
      for (int d0 = 0; d0 < 4; ++d0) o[d0][r] *= rl; }
    if (comp == 0) {
#pragma unroll
      for (int d0 = 0; d0 < 4; ++d0)
#pragma unroll
        for (int hf = 0; hf < 2; ++hf) { u32x4 t; t.x = cvtpk(o[d0][8 * hf], o[d0][8 * hf + 1]); t.y = cvtpk(o[d0][8 * hf + 2], o[d0][8 * hf + 3]); t.z = cvtpk(o[d0][8 * hf + 4], o[d0][8 * hf + 5]); t.w = cvtpk(o[d0][8 * hf + 6], o[d0][8 * hf + 7]); sl[(d0 * 2 + hf) * 512] = t; } }
    __syncthreads();
#undef SLOAD
#undef SWRITE
#undef SWAIT
#undef RESC
  }
  {
    bf16_t* stg = (bf16_t*)(lds + wid * 8704);
    float sg[4];
#pragma unroll
    for (int d0 = 0; d0 < 4; ++d0) sg[d0] = subln[d0 * 32 + r32] * 0.8f;
#pragma unroll
    for (int hf = 0; hf < 2; ++hf) {
      u32x4 t0[4];
#pragma unroll
      for (int d0 = 0; d0 < 4; ++d0) t0[d0] = sl[(d0 * 2 + hf) * 512];
#pragma unroll
      for (int k = 0; k < 8; ++k) { const int r = 8 * hf + k; float v[4]; float q = 0.f;
#pragma unroll
        for (int d0 = 0; d0 < 4; ++d0) { const unsigned w0 = t0[d0][k >> 1];
          const float a = __uint_as_float((k & 1) ? (w0 & 0xffff0000u) : (w0 << 16));
          v[d0] = a - lam * o[d0][r]; q += v[d0] * v[d0]; }
        q = xl::sum32(q);
        const float rs = __builtin_amdgcn_rsqf(q * (1.0f / 128.0f) + 1e-6f); const int orow = crow(r, hi);
#pragma unroll
        for (int d0 = 0; d0 < 4; ++d0) { const float w = v[d0] * rs * sg[d0]; stg[orow * 136 + d0 * 32 + r32] = (bf16_t)(cvtpk(w, w) & 0xffffu); } }
      asm volatile("" ::: "memory");
    }
    asm volatile("s_waitcnt lgkmcnt(0)" ::: "memory");
    bf16_t* Og = Ob + (long)(wid * QBLK) * LD;
#pragma unroll
    for (int i = 0; i < 8; ++i) { const int row = i * 4 + (lane >> 4), ch = lane & 15; const u32x4 t = *(const u32x4*)((const char*)stg + row * 272 + ch * 16); *(u32x4*)(Og + (long)row * LD + ch * 8) = t; }
  }
  __syncthreads();
}
#undef SBAR
#undef KSWZ
}

namespace ct {
using att::bf16x8; using att::f32x16; using att::bf16_t;
template <int MB> __device__ __forceinline__ void unit(const bf16_t* Amat, int K, const bf16_t* src, int P, long sA, long sB, bf16_t* dst, int Q, long sC, long sD, float scale, char* lds) {
  constexpr int NCH = 8 / MB;
  int tid_ = threadIdx.x; asm volatile("" : "+v"(tid_));
  const int tid = tid_, wid = tid >> 6, lane = tid & 63, r32 = lane & 31, hi = lane >> 5;
  const int rb = wid % MB, cc = wid / MB;
  const int sr = tid >> 4, sc = (tid & 15) * 8, vst0 = att::v_st(sr, sc), vst1 = att::v_st(32 + sr, sc);
  const int vb = (int)(uintptr_t)lds + cc * 16384 + att::v_rd_base(lane);
  const int NKT = K >> 6;
#pragma unroll 1
  for (int cs = 0; cs < 4 / NCH; ++cs) {
    f32x16 o[4] = {};
#pragma unroll 1
    for (int kt = 0; kt < NKT; ++kt) {
      const int k0 = kt * 64 + sr, k1 = k0 + 32;
      const bf16_t* r0 = src + (long)(k0 % P) * sA + (long)(k0 / P) * sB + cs * NCH * 128 + sc;
      const bf16_t* r1 = src + (long)(k1 % P) * sA + (long)(k1 / P) * sB + cs * NCH * 128 + sc;
      bf16x8 t0[NCH], t1[NCH];
#pragma unroll
      for (int ch = 0; ch < NCH; ++ch) { t0[ch] = *reinterpret_cast<const bf16x8*>(r0 + ch * 128); t1[ch] = *reinterpret_cast<const bf16x8*>(r1 + ch * 128); }
      const bf16_t* ap = Amat + (long)(rb * 32 + r32) * K + kt * 64 + hi * 8;
      const bf16x8 pa0 = *reinterpret_cast<const bf16x8*>(ap), pa1 = *reinterpret_cast<const bf16x8*>(ap + 16), pa2 = *reinterpret_cast<const bf16x8*>(ap + 32), pa3 = *reinterpret_cast<const bf16x8*>(ap + 48);
      __syncthreads();
#pragma unroll
      for (int ch = 0; ch < NCH; ++ch) { *(bf16x8*)(lds + ch * 16384 + vst0) = t0[ch]; *(bf16x8*)(lds + ch * 16384 + vst1) = t1[ch]; }
      __syncthreads();
      att::pv_d0(o, vb, pa0, pa1, pa2, pa3);
    }
    bf16_t* stg = (bf16_t*)(lds + 65536 + wid * 8704);
#pragma unroll
    for (int r = 0; r < 16; ++r) { const int orow = att::crow(r, hi);
#pragma unroll
      for (int d0 = 0; d0 < 4; ++d0) { const __bf16 hb = (__bf16)(o[d0][r] * scale); stg[orow * 136 + d0 * 32 + r32] = __builtin_bit_cast(bf16_t, hb); } }
    asm volatile("s_waitcnt lgkmcnt(0)" ::: "memory");
#pragma unroll
    for (int i = 0; i < 8; ++i) { const int row = i * 4 + (lane >> 4), ch = lane & 15, m = rb * 32 + row;
      const att::u32x4 t = *(const att::u32x4*)((const char*)stg + row * 272 + ch * 16);
      *(att::u32x4*)(dst + (long)(m % Q) * sC + (long)(m / Q) * sD + (cs * NCH + cc) * 128 + ch * 8) = t; }
    asm volatile("s_waitcnt lgkmcnt(0)" ::: "memory");
  }
  __syncthreads();
}
}
#define LAS __attribute__((address_space(3)))
typedef unsigned short bf16;
typedef unsigned v4u __attribute__((ext_vector_type(4)));
typedef float f32x4 __attribute__((ext_vector_type(4)));
constexpr int NWAVES = 8;
constexpr int T = 81920, TP = 65536, D = 1024, FF = 4096, PLE = 256, INW = 5632;
constexpr float EPS = 1e-6f;
constexpr size_t MiB = 1u << 20;
constexpr size_t WS_ROPE = 1 * MiB;
constexpr size_t WS_WF2 = 2 * MiB, WS_WQKV = 4 * MiB, WS_WG = 10 * MiB, WS_WF = 14 * MiB, WS_WA = 15 * MiB, WS_WO = 17 * MiB, WS_WUP = 19 * MiB, WS_WDN = 27 * MiB, WS_WPLE = 35 * MiB, WS_WGATE = 36 * MiB;
constexpr size_t WS_A1S = 42 * MiB, WS_A1P = 46 * MiB, WS_A2S = 47 * MiB, WS_A2P = 47 * MiB + 512 * 1024;
constexpr size_t WS_UC = 544 * MiB;
constexpr size_t WS_SS = 58 * MiB;
constexpr size_t WS_XH = 64 * MiB;
constexpr size_t WS_GT = 224 * MiB;
constexpr size_t WS_Q = 384 * MiB, WS_K = 544 * MiB, WS_V = 704 * MiB;
constexpr size_t WS_F = 864 * MiB;
constexpr size_t WS_STASH = 944 * MiB;
constexpr size_t WS_U = 384 * MiB;
constexpr size_t WS_PB = 384 * MiB;
constexpr size_t WS_EP = 424 * MiB, WS_E = 584 * MiB;
constexpr int LDS_BYTES = 147456;

#define XB_TMO      128
#define XB_XCNT(j)  (256  + 64 * (j))
#define XB_XSUB(j)  (1280 + 64 * (j))
#define XB_XGEN(j)  (2304 + 64 * (j))
#define XB_TOP      3328
#define XB_TOPGEN   3392
#define XCD_BAR_WORDS 3456
#define XB_SPIN_CAP (1u << 18)

__device__ __forceinline__ unsigned xb_ld(unsigned* p)              { return __hip_atomic_load(p, __ATOMIC_RELAXED, __HIP_MEMORY_SCOPE_AGENT); }
__device__ __forceinline__ unsigned xb_add(unsigned* p, unsigned v) { return __hip_atomic_fetch_add(p, v, __ATOMIC_RELAXED, __HIP_MEMORY_SCOPE_AGENT); }
__device__ __forceinline__ unsigned xb_xcc_id() { return (unsigned)__builtin_amdgcn_s_getreg((3 << 11) | 20) & 0xFu; }
#define XB_SPIN(cond, bar) do { unsigned _sp = 0; while (cond) { __builtin_amdgcn_s_sleep(1); \
    if ((++_sp & 255u) == 0u) { if (xb_ld(&(bar)[XB_TMO])) break; if (_sp > XB_SPIN_CAP) { atomicAdd(&(bar)[XB_TMO], 1u); break; } } } } while (0)

struct XcdBarrier {
    unsigned* bar; unsigned x;
    volatile LAS unsigned* st;
};

__device__ __forceinline__ XcdBarrier xcd_barrier_post(unsigned* bar, volatile LAS unsigned* st) {
    XcdBarrier b; b.bar = bar; b.x = xb_xcc_id(); b.st = st;
    if (threadIdx.x == 0) (void)xb_add(&bar[XB_XCNT(b.x)], 1u);
    return b;
}
__device__ __forceinline__ void xcd_barrier_complete(unsigned* bar, unsigned x, unsigned& nloc, unsigned& nx) {
    const unsigned G = gridDim.x * gridDim.y * gridDim.z;
    unsigned sum, cnt, mine, sp = 0u;
    for (;;) {
        sum = 0u; cnt = 0u; mine = 0u;
#pragma unroll
        for (unsigned j = 0; j < 16; ++j) { const unsigned c = xb_ld(&bar[XB_XCNT(j)]); sum += c; cnt += (c > 0u) ? 1u : 0u; mine = (j == x) ? c : mine; }
        if (sum == G) break;
        __builtin_amdgcn_s_sleep(1);
        if ((++sp & 255u) == 0u) { if (xb_ld(&bar[XB_TMO])) break; if (sp > XB_SPIN_CAP) { atomicAdd(&bar[XB_TMO], 1u); break; } }
    }
    nloc = mine > 0u ? mine : 1u; nx = cnt > 0u ? cnt : 1u;
}

__device__ __forceinline__ void xcd_barrier(const XcdBarrier& b) {
    asm volatile("s_waitcnt vmcnt(0)" ::: "memory");
    __syncthreads();
    if (threadIdx.x == 0) {
        unsigned* bar = b.bar;
        __builtin_amdgcn_s_waitcnt(0);
        unsigned nloc = b.st[0], nx = b.st[1];
        if (nloc == 0u) { xcd_barrier_complete(bar, b.x, nloc, nx); b.st[0] = nloc; b.st[1] = nx; }
        const unsigned old = xb_add(&bar[XB_XSUB(b.x)], 1u);
        const unsigned gen = old / nloc;
        if (old + 1u == (gen + 1u) * nloc) {
            __builtin_amdgcn_fence(__ATOMIC_RELEASE, "agent");
            asm volatile("s_waitcnt vmcnt(0)" ::: "memory");
            const unsigned og = xb_add(&bar[XB_TOP], 1u);
            const unsigned tg = og / nx;
            if (og + 1u == (tg + 1u) * nx) xb_add(&bar[XB_TOPGEN], 1u);
            else XB_SPIN(xb_ld(&bar[XB_TOPGEN]) == tg, bar);
            __builtin_amdgcn_fence(__ATOMIC_ACQUIRE, "agent");
            xb_add(&bar[XB_XGEN(b.x)], 1u);
            asm volatile("s_waitcnt vmcnt(0)" ::: "memory");
        } else {
            XB_SPIN(xb_ld(&bar[XB_XGEN(b.x)]) == gen, bar);
            __builtin_amdgcn_fence(__ATOMIC_ACQUIRE, "agent");
            asm volatile("s_waitcnt vmcnt(0)" ::: "memory");
        }
    }
    __syncthreads();
}

struct Args { const float* in[22]; float* out; unsigned char* ws; int ph_lo, ph_hi; };

__device__ __forceinline__ float wave_sum(float v) { return xl::sum64(v); }
__device__ __forceinline__ unsigned pk2(float lo, float hi) { return pg8::cvt_pk_bf16(lo, hi); }
__device__ __forceinline__ f32x4 unp4(unsigned long long q) { f32x4 r; r.x = __uint_as_float((unsigned)q << 16); r.y = __uint_as_float((unsigned)q & 0xffff0000u); r.z = __uint_as_float((unsigned)(q >> 32) << 16); r.w = __uint_as_float((unsigned)(q >> 32) & 0xffff0000u); return r; }
__device__ __forceinline__ unsigned long long pk4(f32x4 v) { return (unsigned long long)pk2(v.x, v.y) | ((unsigned long long)pk2(v.z, v.w) << 32); }
__device__ __forceinline__ void p0_transpose_item(const float* W, int ldw, int col0, int K, int N, const float* gain, bf16* WT, LAS float* scr, int item, int lane) {
    const int nblk = N / 32, kb = item / nblk, nb = item % nblk, k0 = 64 * kb, n0 = 32 * nb;
#pragma unroll 8
    for (int i = 0; i < 32; ++i) { const int kk = 2 * i + (lane >> 5); const float g = gain ? gain[k0 + kk] : 1.f; scr[kk * 33 + (lane & 31)] = W[(size_t)(k0 + kk) * ldw + col0 + n0 + (lane & 31)] * g; }
    asm volatile("s_waitcnt lgkmcnt(0)" ::: "memory");
    const int c = lane & 7;
#pragma unroll
    for (int j = 0; j < 4; ++j) { const int n = (lane >> 3) + 8 * j; const LAS float* s = scr + (8 * c) * 33 + n;
        v4u o; o.x = pk2(s[0 * 33], s[1 * 33]); o.y = pk2(s[2 * 33], s[3 * 33]); o.z = pk2(s[4 * 33], s[5 * 33]); o.w = pk2(s[6 * 33], s[7 * 33]);
        *(v4u*)(WT + (size_t)(n0 + n) * K + k0 + 8 * c) = o; }
    asm volatile("s_waitcnt lgkmcnt(0)" ::: "memory");
}
__device__ __forceinline__ const float* xrow(const Args& a, int m) { return m < TP ? a.in[0] + (size_t)m * D : a.in[1] + (size_t)(m - TP) * D; }

__global__ void __launch_bounds__(NWAVES * 64, 2) fwd_mega(Args args) {
    extern __shared__ __attribute__((aligned(16))) unsigned char lds[];
    cg::grid_group grid = cg::this_grid();
#define IN(k) (args.ph_lo <= (k) && (k) < args.ph_hi)
    volatile LAS unsigned* xst = (volatile LAS unsigned*)((LAS unsigned char*)lds + (LDS_BYTES - 16));
    if (threadIdx.x == 0) { xst[0] = 0u; xst[1] = 0u; }
    __syncthreads();
    const XcdBarrier xbar = xcd_barrier_post((unsigned*)args.ws, xst);
#define GSYNC() xcd_barrier(xbar)
    const int tid = threadIdx.x, lane = tid & 63, wave = __builtin_amdgcn_readfirstlane(tid >> 6);
    const int G = gridDim.x, bx = blockIdx.x; const int vcu = (G % 8 == 0) ? (bx % 8) * (G / 8) + bx / 8 : bx;
    unsigned char* ws = args.ws;
    LAS unsigned char* ldsl = (LAS unsigned char*)lds;
#define WF2 ((bf16*)(ws + WS_WF2))
#define WQKV ((bf16*)(ws + WS_WQKV))
#define WG ((bf16*)(ws + WS_WG))
#define WF ((bf16*)(ws + WS_WF))
#define WA ((bf16*)(ws + WS_WA))
#define WO ((bf16*)(ws + WS_WO))
#define WUP ((bf16*)(ws + WS_WUP))
#define WDN ((bf16*)(ws + WS_WDN))
#define WPLE ((bf16*)(ws + WS_WPLE))
#define WGATE ((bf16*)(ws + WS_WGATE))
#define ROPE ((float*)(ws + WS_ROPE))
#define UC ((bf16*)(ws + WS_UC))
#define SS ((float*)(ws + WS_SS))
#define XH ((bf16*)(ws + WS_XH))
#define GT ((bf16*)(ws + WS_GT))
#define QB ((bf16*)(ws + WS_Q))
#define KB ((bf16*)(ws + WS_V))
#define VB ((bf16*)(ws + WS_V) + (size_t)T * D)
#define FB ((bf16*)(ws + WS_F))
    const int gw = vcu * NWAVES + wave, NGW = G * NWAVES;
    const int gtid = bx * (NWAVES * 64) + tid, NGT = G * NWAVES * 64;

    using pg8::Gemm; using pg8::StaticOrder; using pg8::EpiGen; using pg8::ListOrder;
    LAS unsigned char* ring = ldsl;
    if (IN(0)) {
    {
        LAS float* scr = (LAS float*)(ldsl + wave * 16384);
        const float* w_in = args.in[5];
        constexpr int I_QKV = 16 * 96, I_G = 16 * 64, I_F = 8 * 32, I_A = 16 * 32, I_O = 16 * 32, I_UP = 16 * 128, I_DN = 64 * 32, I_PLE = 4 * 32, I_GATE = 16 * 32;
        constexpr int NITEMS = I_QKV + I_G + I_F + I_A + I_O + I_UP + I_DN + I_PLE + I_GATE;
        for (int it = gw; it < NITEMS; it += NGW) {
            int r = it;
            if (r < I_QKV) { p0_transpose_item(w_in, INW, 512, D, 3072, args.in[4], WQKV, scr, r, lane); continue; } r -= I_QKV;
            if (r < I_G) { p0_transpose_item(w_in, INW, 3584, D, 2048, args.in[4], WG, scr, r, lane); continue; } r -= I_G;
            if (r < I_F) { p0_transpose_item(args.in[6], D, 0, 512, D, nullptr, WF, scr, r, lane); continue; } r -= I_F;
            if (r < I_A) { p0_transpose_item(args.in[7], D, 0, D, D, nullptr, WA, scr, r, lane); continue; } r -= I_A;
            if (r < I_O) { p0_transpose_item(args.in[8], D, 0, D, D, nullptr, WO, scr, r, lane); continue; } r -= I_O;
            if (r < I_UP) { p0_transpose_item(args.in[16], FF, 0, D, FF, args.in[15], WUP, scr, r, lane); continue; } r -= I_UP;
            if (r < I_DN) { p0_transpose_item(args.in[17], D, 0, FF, D, nullptr, WDN, scr, r, lane); continue; } r -= I_DN;
            if (r < I_PLE) { p0_transpose_item(args.in[19], D, 0, PLE, D, nullptr, WPLE, scr, r, lane); continue; } r -= I_PLE;
            p0_transpose_item(args.in[20], D, 0, D, D, nullptr, WGATE, scr, r, lane);
        }
        __syncthreads();
        {
            LAS float* Wt = (LAS float*)ldsl;
            LAS float* ctab = (LAS float*)(ldsl + 8192);
            for (int item = bx; item < 256; item += G) {
                const int grp = item >> 6, k0 = (item & 63) * 16;
                for (int e = tid; e < 2048; e += NWAVES * 64) { const int kk = e >> 7, c = e & 127; Wt[c * 16 + kk] = w_in[(size_t)(k0 + kk) * INW + grp * 128 + c] * args.in[4][k0 + kk]; }
                if (tid < 128) ctab[tid] = __builtin_amdgcn_cosf((float)tid * (1.0f / 128.0f));
                __syncthreads();
                const int m = tid & 127, comp = (tid >> 7) & 1, kh = tid >> 8;
                float acc[8];
#pragma unroll
                for (int i = 0; i < 8; ++i) acc[i] = 0.f;
                for (int c = 0; c < 128; ++c) { const float t = ctab[(c * m + (comp ? 96 : 0)) & 127]; const LAS f32x4* wp = (const LAS f32x4*)(Wt + c * 16 + kh * 8); const f32x4 w0 = wp[0], w1 = wp[1];
#pragma unroll
                    for (int i = 0; i < 4; ++i) { acc[i] += w0[i] * t; acc[4 + i] += w1[i] * t; } }
                v4u o; o.x = pk2(acc[0], acc[1]); o.y = pk2(acc[2], acc[3]); o.z = pk2(acc[4], acc[5]); o.w = pk2(acc[6], acc[7]);
                *(v4u*)(WF2 + (size_t)(comp * 512 + grp * 128 + m) * D + k0 + kh * 8) = o;
                __syncthreads();
            }
        }
        { bf16* A1S = (bf16*)(ws + WS_A1S); bf16* A1P = (bf16*)(ws + WS_A1P); bf16* A2S = (bf16*)(ws + WS_A2S); bf16* A2P = (bf16*)(ws + WS_A2P);
          for (int it = gtid; it < 128 * 128 * 128; it += NGT) { const int k = it & 127, m = (it >> 7) & 127, s2 = it >> 14; const int ri = m >> 6, k1 = m & 63, comp = k >> 6, s1 = k & 63;
              const float fr = (float)((k1 * (128 * s1 + s2)) & 8191) * (1.0f / 8192.0f); const float c = __builtin_amdgcn_cosf(fr), s = __builtin_amdgcn_sinf(fr);
              const float v = ri == 0 ? (comp == 0 ? c : -s) : (comp == 0 ? -s : -c); A1S[it] = (bf16)(pk2(v, v) & 0xffffu); }
          for (int it = gtid; it < 64 * 64 * 64; it += NGT) { const int k = it & 63, m = (it >> 6) & 63, s2 = it >> 12; const int ri = m >> 5, k1 = m & 31, comp = k >> 5, s1 = k & 31;
              const float fr = (float)((k1 * (64 * s1 + s2)) & 2047) * (1.0f / 2048.0f); const float c = __builtin_amdgcn_cosf(fr), s = __builtin_amdgcn_sinf(fr);
              const float v = ri == 0 ? (comp == 0 ? c : -s) : (comp == 0 ? -s : -c); A1P[it] = (bf16)(pk2(v, v) & 0xffffu); }
          for (int it = gtid; it < 128 * 256; it += NGT) { const int k = it & 255, k2 = it >> 8; const int ri = k >> 7, s2 = k & 127;
              const float fr = (float)((k2 * s2) & 127) * (1.0f / 128.0f); const float v = ri == 0 ? __builtin_amdgcn_cosf(fr) : __builtin_amdgcn_sinf(fr); A2S[it] = (bf16)(pk2(v, v) & 0xffffu); }
          for (int it = gtid; it < 64 * 128; it += NGT) { const int k = it & 127, k2 = it >> 7; const int ri = k >> 6, s2 = k & 63;
              const float fr = (float)((k2 * s2) & 63) * (1.0f / 64.0f); const float v = ri == 0 ? __builtin_amdgcn_cosf(fr) : __builtin_amdgcn_sinf(fr); A2P[it] = (bf16)(pk2(v, v) & 0xffffu); }
        }
        if (gtid < 65536) { const int pos = gtid >> 3, i = gtid & 7;
            const double ifr[8] = {0.15915494309189535, 0.03086376340470123, 0.005985185712713705, 0.001160663641240061, 0.00022507907903927653, 4.364795279280289e-05, 8.464330808241401e-06, 1.6414262627950345e-06};
            double rev = (double)pos * (i == 0 ? ifr[0] : i == 1 ? ifr[1] : i == 2 ? ifr[2] : i == 3 ? ifr[3] : i == 4 ? ifr[4] : i == 5 ? ifr[5] : i == 6 ? ifr[6] : ifr[7]);
            rev -= (double)(long long)rev; const float fr = (float)rev;
            ROPE[pos * 16 + i] = __builtin_amdgcn_cosf(fr); ROPE[pos * 16 + 8 + i] = __builtin_amdgcn_sinf(fr); }
        for (int m0 = gw; m0 < T; m0 += 4 * NGW) { f32x4 v[4][4];
#pragma unroll
            for (int r = 0; r < 4; ++r) { const int m = m0 + r * NGW; if (m < T) { const f32x4* xr = (const f32x4*)xrow(args, m) + lane;
#pragma unroll
                for (int j = 0; j < 4; ++j) v[r][j] = xr[64 * j]; } }
#pragma unroll
            for (int r = 0; r < 4; ++r) { const int m = m0 + r * NGW; if (m < T) { float s = 0.f;
#pragma unroll
                for (int j = 0; j < 4; ++j) s += (v[r][j].x * v[r][j].x + v[r][j].y * v[r][j].y) + (v[r][j].z * v[r][j].z + v[r][j].w * v[r][j].w);
                const float ms = wave_sum(s) * (1.f / D) + EPS; const float rs = __builtin_amdgcn_rsqf(ms);
                if (lane == 0) ((float*)(ws + 63 * MiB))[m] = ms * rs;
                unsigned long long* o8 = (unsigned long long*)(XH + (size_t)m * D) + lane;
#pragma unroll
                for (int j = 0; j < 4; ++j) o8[64 * j] = pk4(v[r][j] * rs); } } }
    }
    if (IN(0) && IN(1)) { asm volatile("s_waitcnt vmcnt(0)" ::: "memory"); grid.sync(); }

    }

    if (IN(1)) {
    {
        Gemm g{XH, WF2, T, 4096, D}; StaticOrder S; S.init(T, 4096, G, bx); pg8::EpiQKV E{GT, QB, KB, (size_t)T * D, ROPE};
        pg8::gemm_phase<pg8::EpiQKV, StaticOrder, true, true>(ring, g, S, E);
    }
    if (IN(1) && IN(2)) GSYNC();

    }
#define GF GT
#define GA ((bf16*)(ws + WS_V))
#define Y1 ((bf16*)(ws + WS_UC))
#define MG GT
#define ATT QB
    if (IN(2)) {
    {
        float lam;
        { const float a = wave_sum(args.in[9][lane] * args.in[10][lane]), b = wave_sum(args.in[11][lane] * args.in[12][lane]); lam = __expf(a) - __expf(b) + 0.2f; }
        float* stash = (float*)(ws + WS_STASH) + (size_t)bx * 32768;
        const int NCU = G;
        const int ppc = (2048 + NCU - 1) / NCU, spc = (512 + NCU - 1) / NCU;
#ifdef DBG_ATT2
        for (int pass2 = 0; pass2 < 2; ++pass2)
#else
        const int pass2 = 1;
#endif
        for (int i = 0; i < ppc + spc; ++i) { const bool smp = i >= ppc; int bh, qb;
            if (NCU == 256) { if (smp) { bh = (vcu >> 5) + 8 * (i - ppc); qb = vcu & 31; } else { bh = (vcu >> 3) + 32 * i; qb = vcu & 7; } }
            else { const int ui = smp ? vcu * spc + (i - ppc) : vcu * ppc + i; if (ui >= (smp ? 512 : 2048)) continue; const int lq = smp ? 5 : 3; bh = ui >> lq; qb = ui & ((1 << lq) - 1); }
            const int b = bh >> 3, h = bh & 7; const int seq = smp ? 8192 : 2048;
            const size_t r0 = (smp ? (size_t)TP : 0) + (size_t)b * seq; const size_t qo = (r0 + qb * 256) * D + h * 128, ko = r0 * D + h * 128;
            att::attn_unit(QB + qo, KB + ko, VB + ko, (pass2 ? QB : UC) + qo, seq, (char*)lds, stash, lam, args.in[13]); }
        __syncthreads();
        { const bf16* A1S = (const bf16*)(ws + WS_A1S); const bf16* A1P = (const bf16*)(ws + WS_A1P); bf16* US = UC + (size_t)131072 * 512;
          for (int ui = vcu; ui < 256 + 2048; ui += NCU) {
            if (ui < 256) { const int b = ui >> 7, s2 = ui & 127;
                ct::unit<4>(A1S + (size_t)s2 * 128 * 128, 128, GT + ((size_t)TP + (size_t)b * 8192 + s2) * 1024, 64, 128L * 1024, 512L, US + ((size_t)b * 64 * 2 * 128 + s2) * 512, 64, 2L * 128 * 512, 128L * 512, 1.0f, (char*)lds); }
            else { const int up = ui - 256, b = up >> 6, s2 = up & 63;
                ct::unit<2>(A1P + (size_t)s2 * 64 * 64, 64, GT + ((size_t)b * 2048 + s2) * 1024, 32, 64L * 1024, 512L, UC + ((size_t)b * 32 * 2 * 64 + s2) * 512, 32, 2L * 64 * 512, 64L * 512, 1.0f, (char*)lds); }
          } }
    }
    if (IN(2) && IN(3)) GSYNC();

    }

    if (IN(3)) {
    {
        const bf16* A2S = (const bf16*)(ws + WS_A2S); const bf16* A2P = (const bf16*)(ws + WS_A2P); const bf16* US = UC + (size_t)131072 * 512;
        for (int ui = vcu; ui < 128 + 1024; ui += G) {
            if (ui < 128) { const int b = ui >> 6, k1 = ui & 63;
                ct::unit<4>(A2S, 256, US + ((size_t)(b * 64 + k1) * 2 * 128) * 512, 256, 512L, 0L, FB + ((size_t)TP + (size_t)b * 8192 + k1) * 512, 128, 64L * 512, 0L, 1.0f / 1024.0f, (char*)lds); }
            else { const int up = ui - 128, b = up >> 5, k1 = up & 31;
                ct::unit<2>(A2P, 128, UC + ((size_t)(b * 32 + k1) * 2 * 64) * 512, 128, 512L, 0L, FB + ((size_t)b * 2048 + k1) * 512, 64, 32L * 512, 0L, 1.0f / 512.0f, (char*)lds); }
        }
    }
    {
        Gemm g{XH, WG, T, 2048, D}; StaticOrder S; S.init(T, 2048, G, bx); EpiGen<1> E{GF, D, nullptr, nullptr, nullptr, 1.f, (size_t)(WS_V - WS_GT) / 2};
        pg8::gemm_phase<EpiGen<1>, StaticOrder, true, true>(ring, g, S, E);
    }
    if (IN(3) && IN(4)) GSYNC();

    }

    if (IN(4)) {
    {
        Gemm g{FB, WF, T, D, 512}; StaticOrder S; S.init(T, D, G, bx); EpiGen<2> E{Y1, D, GF, nullptr, nullptr, 1.f, 0};
        pg8::gemm_phase<EpiGen<2>, StaticOrder, true, true>(ring, g, S, E);
    }

    }

    if (IN(5)) {
    {
        Gemm g{ATT, WA, T, D, D}; StaticOrder S; S.init(T, D, G, bx); EpiGen<3> E{MG, D, Y1, GA, nullptr, 1.f, 0};
        pg8::gemm_phase<EpiGen<3>, StaticOrder, true, true>(ring, g, S, E);
    }
    if (IN(5) && IN(6)) GSYNC();

    }
#define Z XH
#define Z4 UC
    if (IN(6)) {
    {
        Gemm g{MG, WO, T, D, D}; StaticOrder S; S.init(T, D, G, bx); EpiGen<4> E{Z4, D, nullptr, nullptr, SS, 1.f, 0};
        pg8::gemm_phase<EpiGen<4>, StaticOrder, true, true>(ring, g, S, E);
    }
    if (IN(6) && IN(7)) GSYNC();

    }
#define H2 GT
    if (IN(7)) {
    { int ln_ = threadIdx.x; asm volatile("" : "+v"(ln_)); const int lane = ln_ & 63; constexpr int RB = 4;
    f32x4 gg[4];
#pragma unroll
    for (int j = 0; j < 4; ++j) gg[j] = ((const f32x4*)args.in[14] + lane)[64 * j];
    for (int m0 = gw; m0 < T; m0 += RB * NGW) {
        unsigned long long xq[RB][4], zq[RB][4]; float sv[RB], xsv[RB];
#pragma unroll
        for (int r = 0; r < RB; ++r) { const int m = m0 + r * NGW; if (m < T) {
            sv[r] = (lane < 16) ? SS[(size_t)m * 16 + lane] : 0.f; xsv[r] = ((const float*)(ws + 63 * MiB))[m];
            const unsigned long long* xr = (const unsigned long long*)(XH + (size_t)m * D) + lane; const unsigned long long* zr = (const unsigned long long*)(Z4 + (size_t)m * D) + lane;
#pragma unroll
            for (int j = 0; j < 4; ++j) { xq[r][j] = xr[64 * j]; zq[r][j] = zr[64 * j]; } } }
#pragma unroll
        for (int r = 0; r < RB; ++r) { const int m = m0 + r * NGW; if (m < T) {
            const float rs = __builtin_amdgcn_rsqf(wave_sum(sv[r]) * (1.f / D) + EPS); f32x4 v[4]; float s2 = 0.f;
#pragma unroll
            for (int j = 0; j < 4; ++j) { v[j] = unp4(xq[r][j]) * xsv[r] + unp4(zq[r][j]) * rs * gg[j]; s2 += (v[j].x * v[j].x + v[j].y * v[j].y) + (v[j].z * v[j].z + v[j].w * v[j].w); }
            const float rs2 = __builtin_amdgcn_rsqf(wave_sum(s2) * (1.f / D) + EPS);
            unsigned long long* x8 = (unsigned long long*)((bf16*)args.out + (size_t)m * D) + lane; unsigned long long* h8 = (unsigned long long*)(H2 + (size_t)m * D) + lane;
#pragma unroll
            for (int j = 0; j < 4; ++j) { x8[64 * j] = pk4(v[j]); h8[64 * j] = pk4(v[j] * rs2); } } }
    }
    }
    if (IN(7) && IN(8)) GSYNC();

    }
#define U ((bf16*)(ws + WS_U))
    if (IN(8)) {
    {
        Gemm g{H2, WUP, T, FF, D}; StaticOrder S; S.init(T, FF, G, bx); EpiGen<5> E{U, FF, nullptr, nullptr, nullptr, 1.f, 0};
        pg8::gemm_phase<EpiGen<5>, StaticOrder, true, true>(ring, g, S, E);
    }
    if (IN(8) && IN(9)) GSYNC();

    }

    if (IN(9)) {
    {
        Gemm g{U, WDN, T, D, FF}; StaticOrder S; S.init(T, D, G, bx); EpiGen<4> E{Z, D, nullptr, nullptr, SS, 1.f, 0};
        pg8::gemm_phase<EpiGen<4>, StaticOrder, true, true>(ring, g, S, E);
    }
    if (IN(9) && IN(10)) GSYNC();

    }
#define X2B GT
#define PB ((bf16*)(ws + WS_PB))
    if (IN(10)) {
    { int ln_ = threadIdx.x; asm volatile("" : "+v"(ln_)); const int lane = ln_ & 63; constexpr int RB = 4;
    f32x4 gg[4];
#pragma unroll
    for (int j = 0; j < 4; ++j) gg[j] = ((const f32x4*)args.in[18] + lane)[64 * j];
    for (int m0 = gw; m0 < T; m0 += RB * NGW) {
        unsigned long long xq[RB][4], zq[RB][4]; float sv[RB]; f32x4 pv[RB];
#pragma unroll
        for (int r = 0; r < RB; ++r) { const int m = m0 + r * NGW; if (m < T) {
            sv[r] = (lane < 16) ? SS[(size_t)m * 16 + lane] : 0.f;
            const unsigned long long* x8 = (const unsigned long long*)((const bf16*)args.out + (size_t)m * D) + lane; const unsigned long long* zr = (const unsigned long long*)(Z + (size_t)m * D) + lane;
#pragma unroll
            for (int j = 0; j < 4; ++j) { xq[r][j] = x8[64 * j]; zq[r][j] = zr[64 * j]; }
            const float* prow = m < TP ? args.in[2] + (size_t)m * PLE : args.in[3] + (size_t)(m - TP) * PLE; pv[r] = ((const f32x4*)prow)[lane]; } }
#pragma unroll
        for (int r = 0; r < RB; ++r) { const int m = m0 + r * NGW; if (m < T) {
            const float rs = __builtin_amdgcn_rsqf(wave_sum(sv[r]) * (1.f / D) + EPS);
            unsigned long long* h8 = (unsigned long long*)(X2B + (size_t)m * D) + lane;
#pragma unroll
            for (int j = 0; j < 4; ++j) h8[64 * j] = pk4(unp4(xq[r][j]) + unp4(zq[r][j]) * rs * gg[j]);
            ((unsigned long long*)(PB + (size_t)m * PLE))[lane] = pk4(pv[r]); } }
    }
    }
    if (IN(10) && IN(11)) GSYNC();

    }
#define EP ((bf16*)(ws + WS_EP))
#define EB ((bf16*)(ws + WS_E))
    if (IN(11)) {
    {
        Gemm g{PB, WPLE, T, D, PLE}; StaticOrder S; S.init(T, D, G, bx); EpiGen<0> E{EP, D, nullptr, nullptr, nullptr, 1.f, 0};
        pg8::gemm_phase<EpiGen<0>, StaticOrder, true, true>(ring, g, S, E);
    }

    }

    if (IN(12)) {
    {
        Gemm g{X2B, WGATE, T, D, D}; StaticOrder S; S.init(T, D, G, bx); EpiGen<6> E{EB, D, EP, nullptr, SS, 1.f, 0};
        pg8::gemm_phase<EpiGen<6>, StaticOrder, true, true>(ring, g, S, E);
    }
    if (IN(12) && IN(13)) GSYNC();

    }

    if (IN(13)) {
    { int ln_ = threadIdx.x; asm volatile("" : "+v"(ln_)); const int lane = ln_ & 63; constexpr int RB = 4;
    f32x4 gg[4];
#pragma unroll
    for (int j = 0; j < 4; ++j) gg[j] = ((const f32x4*)args.in[21] + lane)[64 * j];
    for (int m0 = gw; m0 < T; m0 += RB * NGW) {
        unsigned long long xq[RB][4], zq[RB][4]; float sv[RB];
#pragma unroll
        for (int r = 0; r < RB; ++r) { const int m = m0 + r * NGW; if (m < T) {
            sv[r] = (lane < 16) ? SS[(size_t)m * 16 + lane] : 0.f;
            const unsigned long long* x8 = (const unsigned long long*)(X2B + (size_t)m * D) + lane; const unsigned long long* zr = (const unsigned long long*)(EB + (size_t)m * D) + lane;
#pragma unroll
            for (int j = 0; j < 4; ++j) { xq[r][j] = x8[64 * j]; zq[r][j] = zr[64 * j]; } } }
#pragma unroll
        for (int r = 0; r < RB; ++r) { const int m = m0 + r * NGW; if (m < T) {
            const float rs = __builtin_amdgcn_rsqf(wave_sum(sv[r]) * (1.f / D) + EPS);
            f32x4* orow = (f32x4*)(args.out + (size_t)m * D) + lane;
#pragma unroll
            for (int j = 0; j < 4; ++j) orow[64 * j] = unp4(xq[r][j]) + unp4(zq[r][j]) * rs * gg[j]; } }
    }
    }
    }

}


__global__ void __launch_bounds__(256) ck_kernel(const unsigned* buf, size_t nwords, unsigned* cs, int rep, unsigned* flag) {
    const size_t per = (nwords + gridDim.x - 1) / gridDim.x; const size_t lo = (size_t)blockIdx.x * per; size_t hi = lo + per; if (hi > nwords) hi = nwords;
    unsigned s = 0;
    for (size_t i = lo + threadIdx.x; i < hi; i += 256) { const unsigned w = buf[i]; s += w * 2654435761u + (w >> 7); }
    __shared__ unsigned red[256]; red[threadIdx.x] = s; __syncthreads();
    for (int o = 128; o > 0; o >>= 1) { if ((int)threadIdx.x < o) red[threadIdx.x] += red[threadIdx.x + o]; __syncthreads(); }
    if (threadIdx.x == 0) { if (rep == 0) cs[blockIdx.x] = red[0]; else if (cs[blockIdx.x] != red[0]) atomicOr(flag, 1u); }
}
__global__ void nanflag_kernel(float* out, const unsigned* flag) { if (*flag) out[0] = __builtin_nanf(""); }
__global__ void clrflag_kernel(unsigned* flag) { *flag = 0u; }
extern "C" void kernel_launch(void* const* d_in, const int* in_sizes, int n_in, void* d_out, int out_size, void* d_ws, size_t ws_size, hipStream_t stream) {
    static int grid = 0;
    if (grid == 0) {
        int dev = 0, cus = 0, per_cu = 0;
        hipGetDevice(&dev); hipDeviceGetAttribute(&cus, hipDeviceAttributeMultiprocessorCount, dev);
        hipFuncSetAttribute((const void*)fwd_mega, hipFuncAttributeMaxDynamicSharedMemorySize, LDS_BYTES);
        hipOccupancyMaxActiveBlocksPerMultiprocessor(&per_cu, (const void*)fwd_mega, NWAVES * 64, LDS_BYTES);
        if (per_cu < 1) per_cu = 1;
        grid = cus * per_cu;
        if (n_in != 22 || ws_size < (size_t)1008 * MiB) { fprintf(stderr, "kernel_launch: unexpected n_in %d / ws %zu\n", n_in, ws_size); }
    }
    hipMemsetAsync(d_ws, 0, 16384, stream);
    Args a{};
    for (int i = 0; i < 22; ++i) a.in[i] = (const float*)d_in[i];
    a.out = (float*)d_out; a.ws = (unsigned char*)d_ws;
#ifndef DBG_DOUBLE
#define DBG_DOUBLE 0
#endif
#ifndef N_LAUNCH_SPLIT
#define N_LAUNCH_SPLIT 0
#endif
    if (N_LAUNCH_SPLIT) {
#ifdef DBG_K
        unsigned char* w8 = (unsigned char*)d_ws; unsigned* flag = (unsigned*)(w8 + 512 * 1024); unsigned* cs = (unsigned*)(w8 + 600 * 1024);
        hipLaunchKernelGGL(clrflag_kernel, dim3(1), dim3(1), 0, stream, flag);
        for (int rep = 0; rep < 2; ++rep) {
            for (int p = (rep ? DBG_REP1_FROM : 0); p <= DBG_K; ++p) { a.ph_lo = p; a.ph_hi = p + 1; hipLaunchKernelGGL(fwd_mega, dim3(grid), dim3(NWAVES * 64), LDS_BYTES, stream, a); }
            const size_t offs[] = DBG_OFFS; const size_t lens[] = DBG_LENS; const int isout[] = DBG_ISOUT;
            for (int r = 0; r < (int)(sizeof(offs) / sizeof(offs[0])); ++r) {
                const unsigned char* base = isout[r] ? (const unsigned char*)d_out : w8;
                hipLaunchKernelGGL(ck_kernel, dim3(1024), dim3(256), 0, stream, (const unsigned*)(base + offs[r] * MiB), lens[r] * MiB / 4, cs + r * 1024, rep, flag); }
        }
        for (int p = DBG_K + 1; p < 14; ++p) { a.ph_lo = p; a.ph_hi = p + 1; hipLaunchKernelGGL(fwd_mega, dim3(grid), dim3(NWAVES * 64), LDS_BYTES, stream, a); }
        hipLaunchKernelGGL(nanflag_kernel, dim3(1), dim3(1), 0, stream, (float*)d_out, flag);
#else
        for (int p = 0; p < 14; ++p) { a.ph_lo = p; a.ph_hi = p + 1; const int reps = ((DBG_DOUBLE >> p) & 1) ? 2 : 1;
            for (int r = 0; r < reps; ++r) hipLaunchKernelGGL(fwd_mega, dim3(grid), dim3(NWAVES * 64), LDS_BYTES, stream, a); }
#endif
    } else {
        a.ph_lo = 0; a.ph_hi = 14;
        void* kargs[] = {&a};
        hipError_t e = hipLaunchCooperativeKernel((const void*)fwd_mega, dim3(grid), dim3(NWAVES * 64), kargs, LDS_BYTES, stream);
        if (e != hipSuccess) fprintf(stderr, "cooperative launch failed: %s (grid %d)\n", hipGetErrorString(e), grid);
    }
}
```

```cpp
#include <hip/hip_runtime.h>
#include <hip/hip_cooperative_groups.h>
#include <hip/hip_bf16.h>
#include <cstdio>
#include <cstdint>
namespace cg = cooperative_groups;

namespace xl {
__device__ __forceinline__ float dpp_f(float v, const int ctrl_sel) {
    int x = __builtin_bit_cast(int, v), r;
    if (ctrl_sel == 0) r = __builtin_amdgcn_mov_dpp(x, 0xB1, 0xF, 0xF, true);
    else if (ctrl_sel == 1) r = __builtin_amdgcn_mov_dpp(x, 0x4E, 0xF, 0xF, true);
    else if (ctrl_sel == 2) r = __builtin_amdgcn_mov_dpp(x, 0x141, 0xF, 0xF, true);
    else r = __builtin_amdgcn_mov_dpp(x, 0x140, 0xF, 0xF, true);
    return __builtin_bit_cast(float, r);
}
__device__ __forceinline__ float sum16(float v) { v += dpp_f(v, 0); v += dpp_f(v, 1); v += dpp_f(v, 2); v += dpp_f(v, 3); return v; }
__device__ __forceinline__ float add_x16(float v) { auto r = __builtin_amdgcn_permlane16_swap(__float_as_uint(v), __float_as_uint(v), false, false); return __uint_as_float(r[0]) + __uint_as_float(r[1]); }
__device__ __forceinline__ float add_x32(float v) { auto r = __builtin_amdgcn_permlane32_swap(__float_as_uint(v), __float_as_uint(v), false, false); return __uint_as_float(r[0]) + __uint_as_float(r[1]); }
__device__ __forceinline__ float get_x16(float v, bool odd_row) { auto r = __builtin_amdgcn_permlane16_swap(__float_as_uint(v), __float_as_uint(v), false, false); return __uint_as_float(odd_row ? r[0] : r[1]); }
__device__ __forceinline__ float sum32(float v) { return add_x16(sum16(v)); }
__device__ __forceinline__ float sum64(float v) { return add_x32(add_x16(sum16(v))); }
}
namespace pg8 {
#define PG8_LAS __attribute__((address_space(3)))
typedef unsigned short bf16_t;
typedef short bf16x8 __attribute__((ext_vector_type(8)));
typedef float f32x4 __attribute__((ext_vector_type(4)));
typedef unsigned u32x4 __attribute__((ext_vector_type(4)));
constexpr int BM = 256, BK = 64, HALF = 128, HTB = HALF * BK * 2  , STAGE_BYTES = 8 * HTB, NXCD = 8, WGM = 8;

__host__ __device__ __forceinline__ int lds_byte(int r, int c) { const int st = (r >> 4) * 2 + (c >> 5), rr = r & 15, cc = c & 31, ob = rr * 64 + cc * 2; return st * 1024 + (ob ^ (((ob >> 9) & 1) << 5)); }
__host__ __device__ __forceinline__ void stage_rc(int b, int& R, int& C) { const int st = b / 1024, sb = b % 1024, swz = sb ^ (((sb >> 9) & 1) << 5); R = (st >> 1) * 16 + swz / 64; C = (st & 1) * 32 + (swz % 64) / 2; }
__host__ __device__ __forceinline__ int perm32(int rho) { const int n = rho >> 4, i = rho & 15; return 8 * (i >> 2) + 4 * n + (i & 3); }

struct Unit { int pm, pn; };
struct Gemm { const bf16_t* A; const bf16_t* Bt; int M, N, K; };

struct StaticOrder {
    int nM, nN, nwg, G, c;
    __host__ __device__ void init(int M, int N, int G_, int c_) { nM = M / BM; nN = N / BM; nwg = nM * nN; G = G_; c = c_; }
    __host__ __device__ bool next(int i, Unit& u) const {
        const long L = (long)i * G + c; if (L >= nwg) return false;
        int wgid = (int)L; { const int q = nwg / NXCD, r = nwg % NXCD, xcd = wgid % NXCD, off = wgid / NXCD; wgid = (xcd < r ? xcd * (q + 1) : r * (q + 1) + (xcd - r) * q) + off; }
        const int nig = WGM * nN, gid = wgid / nig, fm = gid * WGM, gsz = (nM - fm) < WGM ? (nM - fm) : WGM;
        u.pm = fm + ((wgid % nig) % gsz); u.pn = (wgid % nig) / gsz; return true;
    }
    __device__ __forceinline__ void a_ready(const Unit&) const {}
    __device__ __forceinline__ void done(const Unit&) const {}
};

__device__ __forceinline__ unsigned cvt_pk_bf16(float lo, float hi) { unsigned r; asm volatile("s_nop 0\n\tv_cvt_pk_bf16_f32 %0, %1, %2" : "=v"(r) : "v"(lo), "v"(hi)); return r; }
__device__ __forceinline__ void unpack8(const u32x4 w, float (&f)[8]) {
#pragma unroll
    for (int i = 0; i < 4; ++i) { f[2 * i] = __uint_as_float(w[i] << 16); f[2 * i + 1] = __uint_as_float(w[i] & 0xffff0000u); }
}
__device__ __forceinline__ u32x4 pack8(const float (&f)[8]) { u32x4 w; w.x = cvt_pk_bf16(f[0], f[1]); w.y = cvt_pk_bf16(f[2], f[3]); w.z = cvt_pk_bf16(f[4], f[5]); w.w = cvt_pk_bf16(f[6], f[7]); return w; }
__device__ __forceinline__ float sigm(float x) { return __builtin_amdgcn_rcpf(1.0f + __builtin_amdgcn_exp2f(-1.4426950408889634f * x)); }
template <int MODE> struct EpiGen {
    static constexpr bool PERM = true, AFTER_DRAIN = false;
    bf16_t* O; int ldc; const bf16_t* X1; const bf16_t* X2; float* ss; float scale; size_t split_stride;
    __device__ __forceinline__ void operator()(const f32x4 (&acc)[2][2][4][2], const Unit& u, int wr_, int wc_, int fr_, int fq_) const {
        int t_ = threadIdx.x; asm volatile("" : "+v"(t_));
        const int wid_ = __builtin_amdgcn_readfirstlane(t_ >> 6), wr = wid_ >> 2, wc = wid_ & 3, fr = t_ & 15, fq = (t_ >> 4) & 3;
        const int row0 = u.pm * BM + wr * 64 + fr; int colt = u.pn * BM; bf16_t* base = O;
        if (MODE == 1) { const int t = colt >> 10; base += (size_t)t * split_stride; colt -= t << 10; }
        const int col0 = colt + wc * 32 + 8 * fq;
#pragma unroll
        for (int ai = 0; ai < 2; ++ai)
#pragma unroll
            for (int m = 0; m < 4; ++m) { const int row = row0 + ai * HALF + m * 16; const size_t ro = (size_t)row * ldc + col0; float sq = 0.f;
#pragma unroll
                for (int bj = 0; bj < 2; ++bj) { float v[8];
#pragma unroll
                    for (int i = 0; i < 4; ++i) { v[i] = acc[ai][bj][m][0][i]; v[4 + i] = acc[ai][bj][m][1][i]; }
                    const size_t off = ro + bj * HALF;
                    if (MODE == 1) {
#pragma unroll
                        for (int i = 0; i < 8; ++i) v[i] = sigm(v[i]); }
                    if (MODE == 2) { float a[8]; unpack8(*(const u32x4*)(X1 + off), a);
#pragma unroll
                        for (int i = 0; i < 8; ++i) v[i] *= a[i]; }
                    if (MODE == 3) { float a[8], b[8]; unpack8(*(const u32x4*)(X1 + off), a); unpack8(*(const u32x4*)(X2 + off), b);
#pragma unroll
                        for (int i = 0; i < 8; ++i) v[i] = a[i] + b[i] * v[i]; }
                    if (MODE == 5) {
#pragma unroll
                        for (int i = 0; i < 8; ++i) { const float r = fmaxf(v[i], 0.f); v[i] = r * r; } }
                    if (MODE == 6) { float a[8]; unpack8(*(const u32x4*)(X1 + off), a);
#pragma unroll
                        for (int i = 0; i < 8; ++i) v[i] = a[i] * sigm(v[i]); }
                    if (MODE == 4 || MODE == 6) {
#pragma unroll
                        for (int i = 0; i < 8; ++i) sq += v[i] * v[i]; }
                    *(u32x4*)(base + off) = pack8(v); }
                if (MODE == 4 || MODE == 6) { sq = xl::add_x32(xl::add_x16(sq)); if (fq == 0) ss[(size_t)row * 16 + u.pn * 4 + wc] = sq; }
            }
    }
};
struct EpiGT {
    static constexpr bool PERM = true, AFTER_DRAIN = false;
    bf16_t* GT;
    __device__ __forceinline__ void operator()(const f32x4 (&acc)[2][2][4][2], const Unit& u, int wr, int wc, int fr, int fq) const {
        const int n0 = u.pm * BM + wr * 64 + fr; const int t0 = u.pn * BM + wc * 32 + 8 * fq;
#pragma unroll
        for (int bj = 0; bj < 2; ++bj) { const int t = t0 + bj * HALF; size_t tb; int S, s, b;
            if (t < 65536) { b = t >> 11; s = t & 2047; S = 2048; tb = 0; } else { const int tt = t - 65536; b = tt >> 13; s = tt & 8191; S = 8192; tb = (size_t)65536 * 1024; }
#pragma unroll
            for (int ai = 0; ai < 2; ++ai)
#pragma unroll
                for (int m = 0; m < 4; ++m) { const int n = n0 + ai * HALF + m * 16, comp = n >> 9, c = n & 511; float v[8];
#pragma unroll
                    for (int i = 0; i < 4; ++i) { v[i] = acc[ai][bj][m][0][i]; v[4 + i] = acc[ai][bj][m][1][i]; }
                    *(u32x4*)(GT + tb + ((size_t)(b * 512 + c) * 2 + comp) * S + s) = pack8(v); } }
    }
};
struct EpiQKV {
    static constexpr bool PERM = true, AFTER_DRAIN = false;
    bf16_t* Gb; bf16_t* Q; bf16_t* K; size_t vstride; const float* rope;
    __device__ __forceinline__ void operator()(const f32x4 (&acc)[2][2][4][2], const Unit& u, int wr, int wc, int fr, int fq) const {
        const int row0 = u.pm * BM + wr * 64 + fr; int colt = u.pn * BM; const int t = colt >> 10; bf16_t* base = (t == 0) ? Gb : ((t == 1) ? Q : (K + (size_t)(t - 2) * vstride)); colt -= t << 10;
        const int col0 = colt + wc * 32 + 8 * fq; const bool rot = (t == 1 || t == 2) && ((wc & 1) == 0);
        if (rot) {
#pragma unroll
            for (int ai = 0; ai < 2; ++ai) {
                f32x4 rc[4][4];
#pragma unroll
                for (int m = 0; m < 4; ++m) { const int row = row0 + ai * HALF + m * 16; const int pos = row < 65536 ? (row & 2047) : (row & 8191); const f32x4* rp = (const f32x4*)(rope + (size_t)pos * 16);
#pragma unroll
                    for (int j = 0; j < 4; ++j) rc[m][j] = rp[j]; }
#pragma unroll
                for (int m = 0; m < 4; ++m) { const int row = row0 + ai * HALF + m * 16; const size_t ro = (size_t)row * 1024 + col0;
#pragma unroll
                    for (int bj = 0; bj < 2; ++bj) { float v[8];
#pragma unroll
                        for (int i = 0; i < 4; ++i) { v[i] = acc[ai][bj][m][0][i]; v[4 + i] = acc[ai][bj][m][1][i]; }
#pragma unroll
                        for (int i = 0; i < 8; ++i) { const float o = xl::get_x16(v[i], (fq & 1) != 0); const float c = rc[m][i >> 2][i & 3], s = rc[m][2 + (i >> 2)][i & 3];
                            const float r = (fq == 0) ? (v[i] * c - o * s) : (v[i] * c + o * s);
                            v[i] = (fq < 2) ? r : v[i]; }
                        *(u32x4*)(base + ro + bj * HALF) = pack8(v); } }
            }
        } else {
#pragma unroll
            for (int ai = 0; ai < 2; ++ai)
#pragma unroll
                for (int m = 0; m < 4; ++m) { const int row = row0 + ai * HALF + m * 16; const size_t ro = (size_t)row * 1024 + col0;
#pragma unroll
                    for (int bj = 0; bj < 2; ++bj) { float v[8];
#pragma unroll
                        for (int i = 0; i < 4; ++i) { v[i] = acc[ai][bj][m][0][i]; v[4 + i] = acc[ai][bj][m][1][i]; }
                        *(u32x4*)(base + ro + bj * HALF) = pack8(v); } }
        }
    }
};
struct EpiDFT {
    static constexpr bool PERM = true, AFTER_DRAIN = false;
    bf16_t* F; int S; float scale;
    __device__ __forceinline__ void operator()(const f32x4 (&acc)[2][2][4][2], const Unit& u, int wr, int wc, int fr, int fq) const {
        const int b = u.pn >> 1, ct = u.pn & 1; const int row0 = b * S + u.pm * BM + wr * 64 + fr; const int col0 = ct * BM + wc * 32 + 8 * fq;
#pragma unroll
        for (int ai = 0; ai < 2; ++ai)
#pragma unroll
            for (int m = 0; m < 4; ++m) { const size_t ro = (size_t)(row0 + ai * HALF + m * 16) * 512 + col0;
#pragma unroll
                for (int bj = 0; bj < 2; ++bj) { float v[8];
#pragma unroll
                    for (int i = 0; i < 4; ++i) { v[i] = acc[ai][bj][m][0][i] * scale; v[4 + i] = acc[ai][bj][m][1][i] * scale; }
                    *(u32x4*)(F + ro + bj * HALF) = pack8(v); } }
    }
};
struct ListOrder {
    int base, count, nfast; bool pnfast;
    __device__ bool next(int i, Unit& u) const { if (i >= count) return false; const int idx = base + i; if (pnfast) { u.pn = idx % nfast; u.pm = idx / nfast; } else { u.pm = idx % nfast; u.pn = idx / nfast; } return true; }
    __device__ __forceinline__ void a_ready(const Unit&) const {}
    __device__ __forceinline__ void done(const Unit&) const {}
};
template <class Epi, class Sched, bool ALIGN_EPI = false, bool SP2 = false>
__device__ __forceinline__ void gemm_phase(PG8_LAS unsigned char* lds, const Gemm g, const Sched& S, const Epi& E) {
    int tid_ = threadIdx.x; asm volatile("" : "+v"(tid_));
    const int tid = tid_, wid = __builtin_amdgcn_readfirstlane(tid >> 6), lane = tid & 63, wr = wid >> 2, wc = wid & 3, fr = lane & 15, fq = lane >> 4;
    const int K = g.K, nt = K / BK;
    unsigned voffA[2], voffB[2];
#pragma unroll
    for (int i = 0; i < 2; ++i) { int R, C; stage_rc(tid * 16 + i * 8192, R, C); const int Rb = Epi::PERM ? ((R & ~31) + perm32(R & 31)) : R;
        voffA[i] = (unsigned)(R * K + C) * 2u; voffB[i] = (unsigned)(Rb * K + C) * 2u; }
    const size_t kstep = (size_t)(BK * 2);
    const size_t hstep = (size_t)HALF * K * 2;
    const size_t tstep = 2 * hstep;
    const unsigned ldsw = (unsigned)wid * 1024u;
    const int aoff = lds_byte(wr * 64 + fr, fq * 8), boff = lds_byte(wc * 32 + fr, fq * 8);
#define PG8_SA(b, h) (((b) * 2 + (h)) * HTB)
#define PG8_SB(b, h) ((4 + (b) * 2 + (h)) * HTB)
#define PG8_STAGE(bufoff, gbase, voff) do { _Pragma("unroll") for (int _i = 0; _i < 2; ++_i) \
        __builtin_amdgcn_global_load_lds((const unsigned*)((const char*)(gbase) + (voff)[_i]), (PG8_LAS unsigned*)(lds + (bufoff) + ldsw + _i * 8192), 16, 0, 0); } while (0)
#define PG8_LDA(dst, b, h) do { _Pragma("unroll") for (int m = 0; m < 4; ++m) _Pragma("unroll") for (int k = 0; k < 2; ++k) dst[m][k] = *(const PG8_LAS bf16x8*)(lds + PG8_SA(b, h) + aoff + m * 2048 + k * 1024); } while (0)
#define PG8_LDB(dst, b, h) do { _Pragma("unroll") for (int n = 0; n < 2; ++n) _Pragma("unroll") for (int k = 0; k < 2; ++k) dst[n][k] = *(const PG8_LAS bf16x8*)(lds + PG8_SB(b, h) + boff + n * 2048 + k * 1024); } while (0)
#define PG8_MMA(ai, bj, At, Bt) do { __builtin_amdgcn_s_setprio(1); _Pragma("unroll") for (int m = 0; m < 4; ++m) _Pragma("unroll") for (int n = 0; n < 2; ++n) _Pragma("unroll") for (int k = 0; k < 2; ++k) \
        acc[ai][bj][m][n] = __builtin_amdgcn_mfma_f32_16x16x32_bf16(Bt[n][k], At[m][k], acc[ai][bj][m][n], 0, 0, 0); __builtin_amdgcn_s_setprio(0); } while (0)
#define PG8_WAIT_V(n) asm volatile("s_waitcnt vmcnt(" #n ")" ::: "memory")
#define PG8_WAIT_L(n) asm volatile("s_waitcnt lgkmcnt(" #n ")" ::: "memory")
#define PG8_BAR __builtin_amdgcn_s_barrier()
#define PG8_SCHED __builtin_amdgcn_sched_barrier(0)
    Unit cur, nxt; int ui = 0;
    if (!S.next(0, cur)) return;
    f32x4 acc[2][2][4][2];
#pragma unroll
    for (int a = 0; a < 2; ++a)
#pragma unroll
        for (int b = 0; b < 2; ++b)
#pragma unroll
            for (int m = 0; m < 4; ++m)
#pragma unroll
                for (int n = 0; n < 2; ++n) acc[a][b][m][n] = (f32x4){0.f, 0.f, 0.f, 0.f};
    bf16x8 At[4][2], B0[2][2], B1[2][2];
    const char* cA = (const char*)g.A + (size_t)cur.pm * tstep; const char* cB = (const char*)g.Bt + (size_t)cur.pn * tstep;
    S.a_ready(cur);
    if constexpr (SP2) {
        PG8_STAGE(PG8_SB(0, 0), cB, voffB); PG8_STAGE(PG8_SB(0, 1), cB + hstep, voffB); PG8_STAGE(PG8_SA(0, 0), cA, voffA); PG8_STAGE(PG8_SA(0, 1), cA + hstep, voffA);
        if (wr == 1) PG8_BAR;
        PG8_WAIT_V(2); PG8_BAR;
        PG8_STAGE(PG8_SB(1, 0), cB + kstep, voffB); PG8_STAGE(PG8_SA(1, 0), cA + kstep, voffA); PG8_STAGE(PG8_SB(1, 1), cB + hstep + kstep, voffB);
        PG8_WAIT_V(6); PG8_BAR;
    } else {
        PG8_STAGE(PG8_SB(0, 0), cB, voffB); PG8_STAGE(PG8_SA(0, 0), cA, voffA); PG8_STAGE(PG8_SB(0, 1), cB + hstep, voffB); PG8_STAGE(PG8_SA(0, 1), cA + hstep, voffA);
        if (wr == 1) PG8_BAR;
        PG8_WAIT_V(4); PG8_BAR;
        PG8_STAGE(PG8_SB(1, 0), cB + kstep, voffB); PG8_STAGE(PG8_SA(1, 0), cA + kstep, voffA); PG8_STAGE(PG8_SB(1, 1), cB + hstep + kstep, voffB);
        PG8_WAIT_V(6); PG8_BAR;
    }
    for (;;) {
        const bool has_next = S.next(ui + 1, nxt);
        const char* nA = has_next ? (const char*)g.A + (size_t)nxt.pm * tstep : cA; const char* nB = has_next ? (const char*)g.Bt + (size_t)nxt.pn * tstep : cB;
        for (int t = 0; t < nt; t += 2) {
            const bool last = (t == nt - 2);
            const char* a1 = cA + (size_t)(t + 1) * kstep;
            const char* a2 = last ? nA : cA + (size_t)(t + 2) * kstep; const char* b2 = last ? nB : cB + (size_t)(t + 2) * kstep;
            const char* a3 = a2 + kstep; const char* b3 = b2 + kstep;
            if (last && has_next) S.a_ready(nxt);
            if constexpr (SP2) {
            PG8_LDB(B0, 0, 0); PG8_LDB(B1, 0, 1); PG8_SCHED; PG8_LDA(At, 0, 0); PG8_STAGE(PG8_SA(1, 1), a1 + hstep, voffA);
            PG8_WAIT_V(8); PG8_WAIT_L(0); PG8_BAR; PG8_MMA(0, 0, At, B0); PG8_MMA(0, 1, At, B1); PG8_BAR; PG8_SCHED;
            PG8_LDA(At, 0, 1); PG8_STAGE(PG8_SB(0, 0), b2, voffB); PG8_STAGE(PG8_SB(0, 1), b2 + hstep, voffB); PG8_STAGE(PG8_SA(0, 0), a2, voffA);
            PG8_WAIT_V(8); PG8_WAIT_L(0); PG8_BAR; PG8_MMA(1, 0, At, B0); PG8_MMA(1, 1, At, B1); PG8_BAR; PG8_SCHED;
            PG8_LDB(B0, 1, 0); PG8_LDB(B1, 1, 1); PG8_SCHED; PG8_LDA(At, 1, 0); PG8_STAGE(PG8_SA(0, 1), a2 + hstep, voffA);
            PG8_WAIT_V(8); PG8_WAIT_L(0); PG8_BAR; PG8_MMA(0, 0, At, B0); PG8_MMA(0, 1, At, B1); PG8_BAR; PG8_SCHED;
            PG8_LDA(At, 1, 1); PG8_STAGE(PG8_SB(1, 0), b3, voffB); PG8_STAGE(PG8_SB(1, 1), b3 + hstep, voffB); PG8_STAGE(PG8_SA(1, 0), a3, voffA);
            PG8_WAIT_V(8); PG8_WAIT_L(0); PG8_BAR; PG8_MMA(1, 0, At, B0); PG8_MMA(1, 1, At, B1); PG8_BAR; PG8_SCHED;
            } else {
            PG8_LDB(B0, 0, 0); PG8_SCHED; PG8_LDA(At, 0, 0); PG8_STAGE(PG8_SA(1, 1), a1 + hstep, voffA);
            PG8_WAIT_L(8); PG8_BAR; PG8_WAIT_L(0); PG8_MMA(0, 0, At, B0); PG8_BAR; PG8_SCHED;
            PG8_LDB(B1, 0, 1); PG8_STAGE(PG8_SB(0, 0), b2, voffB);
            PG8_BAR; PG8_WAIT_L(0); PG8_MMA(0, 1, At, B1); PG8_BAR;
            PG8_LDA(At, 0, 1); PG8_STAGE(PG8_SA(0, 0), a2, voffA);
            PG8_BAR; PG8_WAIT_L(0); PG8_MMA(1, 0, At, B0); PG8_BAR; PG8_SCHED;
            PG8_STAGE(PG8_SB(0, 1), b2 + hstep, voffB);
            PG8_WAIT_V(6); PG8_BAR; PG8_MMA(1, 1, At, B1); PG8_BAR;
            PG8_LDB(B0, 1, 0); PG8_SCHED; PG8_LDA(At, 1, 0); PG8_STAGE(PG8_SA(0, 1), a2 + hstep, voffA);
            PG8_WAIT_L(8); PG8_BAR; PG8_WAIT_L(0); PG8_MMA(0, 0, At, B0); PG8_BAR; PG8_SCHED;
            PG8_LDB(B1, 1, 1); PG8_STAGE(PG8_SB(1, 0), b3, voffB);
            PG8_BAR; PG8_WAIT_L(0); PG8_MMA(0, 1, At, B1); PG8_BAR;
            PG8_LDA(At, 1, 1); PG8_STAGE(PG8_SA(1, 0), a3, voffA);
            PG8_BAR; PG8_WAIT_L(0); PG8_MMA(1, 0, At, B0); PG8_BAR; PG8_SCHED;
            PG8_STAGE(PG8_SB(1, 1), b3 + hstep, voffB);
            PG8_WAIT_V(6); PG8_BAR; PG8_MMA(1, 1, At, B1); PG8_BAR;
            }
        }
        if constexpr (ALIGN_EPI) { if (wr == 0) PG8_BAR; }
        if constexpr (!Epi::AFTER_DRAIN) { E(acc, cur, wr, wc, fr, fq); S.done(cur); }
        if (!has_next) break;
#pragma unroll
        for (int a = 0; a < 2; ++a)
#pragma unroll
            for (int b = 0; b < 2; ++b)
#pragma unroll
                for (int m = 0; m < 4; ++m)
#pragma unroll
                    for (int n = 0; n < 2; ++n) acc[a][b][m][n] = (f32x4){0.f, 0.f, 0.f, 0.f};
        cur = nxt; cA = nA; cB = nB; ++ui;
        if constexpr (ALIGN_EPI) { if (wr == 1) PG8_BAR; }
    }
    PG8_WAIT_V(0);
    if constexpr (!ALIGN_EPI) { if (wr == 0) PG8_BAR; }
    PG8_BAR;
    if constexpr (Epi::AFTER_DRAIN) { E.fused(acc, cur, wr, wc, fr, fq, lds, wid, lane); S.done(cur); }
#undef PG8_SA
#undef PG8_SB
#undef PG8_STAGE
#undef PG8_LDA
#undef PG8_LDB
#undef PG8_MMA
#undef PG8_WAIT_V
#undef PG8_WAIT_L
#undef PG8_BAR
#undef PG8_SCHED
}
}
namespace att {
using bf16x8 = __attribute__((ext_vector_type(8))) short;
using s16x4  = __attribute__((ext_vector_type(4))) short;
using f32x16 = __attribute__((ext_vector_type(16))) float;
using u32x4  = __attribute__((ext_vector_type(4))) unsigned;
using f32x4v = __attribute__((ext_vector_type(4))) float;
typedef unsigned short bf16_t;
constexpr int NW = 8, QBLK = 32, KVBLK = 64, LD = 1024;
constexpr float SCALE = 0.125f, THR = 8.f;
constexpr int SHM_V = KVBLK * 128 * 2, SHM_K = KVBLK * 64 * 2, SHM_ATTN = 3 * SHM_V + 3 * SHM_K + NW * 64 * 4;
#define KSWZ(row, colB) ((row) * 128 + ((colB) ^ ((((row) >> 1) & 7) << 4)))
#define SBAR() __builtin_amdgcn_sched_barrier(0)
__device__ __forceinline__ int crow(int r, int hi) { return (r & 3) + 8 * (r >> 2) + 4 * hi; }
__device__ __forceinline__ unsigned cvtpk(float lo, float hi) { unsigned r; asm volatile("s_nop 0\n\tv_cvt_pk_bf16_f32 %0, %1, %2" : "=v"(r) : "v"(lo), "v"(hi)); return r; }
__device__ __forceinline__ void partialSM(f32x16& p0, f32x16& p1, float& m_reg, float& mn, float& alpha) {
  constexpr float C = SCALE * 1.4426950408889634f;
  float pmax = p0[0];
#pragma unroll
  for (int r = 1; r < 16; ++r) pmax = fmaxf(pmax, p0[r]);
#pragma unroll
  for (int r = 0; r < 16; ++r) pmax = fmaxf(pmax, p1[r]);
  { auto rr = __builtin_amdgcn_permlane32_swap(__float_as_uint(pmax), __float_as_uint(pmax), false, false);
    pmax = fmaxf(__uint_as_float(rr[0]), __uint_as_float(rr[1])); }
  if (__builtin_expect(__all(pmax - m_reg <= THR / SCALE), 1)) { mn = m_reg; alpha = 1.f; }
  else { mn = fmaxf(m_reg, pmax); alpha = __builtin_amdgcn_exp2f((m_reg - mn) * C); m_reg = mn; }
  float mnC = -mn * C;
#pragma unroll
  for (int r = 0; r < 16; ++r) p0[r] = fmaf(p0[r], C, mnC);
#pragma unroll
  for (int r = 0; r < 16; ++r) p1[r] = fmaf(p1[r], C, mnC);
#pragma unroll
  for (int r = 0; r < 16; ++r) p0[r] = __builtin_amdgcn_exp2f(p0[r]);
}
__device__ __forceinline__ void finishSM(f32x16& p0, f32x16& p1, float alpha, float& l_reg, bf16x8& pa0, bf16x8& pa1, bf16x8& pa2, bf16x8& pa3) {
#pragma unroll
  for (int r = 0; r < 16; ++r) p1[r] = __builtin_amdgcn_exp2f(p1[r]);
  float ps = 0;
#pragma unroll
  for (int r = 0; r < 16; ++r) ps += p0[r];
#pragma unroll
  for (int r = 0; r < 16; ++r) ps += p1[r];
  { auto rr = __builtin_amdgcn_permlane32_swap(__float_as_uint(ps), __float_as_uint(ps), false, false);
    ps = __uint_as_float(rr[0]) + __uint_as_float(rr[1]); }
  l_reg = l_reg * alpha + ps;
#define PK4(P, BASE, OUT) do { unsigned a0 = cvtpk(P[BASE + 0], P[BASE + 1]), a1 = cvtpk(P[BASE + 2], P[BASE + 3]);   \
    unsigned b0 = cvtpk(P[BASE + 4], P[BASE + 5]), b1 = cvtpk(P[BASE + 6], P[BASE + 7]);                              \
    auto r0 = __builtin_amdgcn_permlane32_swap(a0, b0, false, false); auto r1 = __builtin_amdgcn_permlane32_swap(a1, b1, false, false); \
    u32x4 w = {r0[0], r1[0], r0[1], r1[1]}; OUT = *reinterpret_cast<bf16x8*>(&w); } while (0)
  PK4(p0, 0, pa0); PK4(p0, 8, pa1); PK4(p1, 0, pa2); PK4(p1, 8, pa3);
#undef PK4
}
__device__ __forceinline__ void qkt(f32x16& p0, f32x16& p1, const char* Ks, const bf16x8* qr, int r32, int hi) {
  p0 = f32x16{}; p1 = f32x16{};
#pragma unroll
  for (int d0 = 0; d0 < 4; ++d0) { int cb = (d0 * 16 + hi * 8) * 2;
    bf16x8 b0 = *reinterpret_cast<const bf16x8*>(Ks + KSWZ(r32, cb));
    bf16x8 b1 = *reinterpret_cast<const bf16x8*>(Ks + KSWZ(32 + r32, cb));
    p0 = __builtin_amdgcn_mfma_f32_32x32x16_bf16(b0, qr[d0], p0, 0, 0, 0);
    p1 = __builtin_amdgcn_mfma_f32_32x32x16_bf16(b1, qr[d0], p1, 0, 0, 0); }
}
__device__ __forceinline__ int v_st(int k, int c) { const int kk = (k & ~0xC) | ((k & 4) << 1) | ((k & 8) >> 1); return ((kk >> 3) * 4 + (c >> 5)) * 512 + ((kk & 7) * 32 + (c & 31)) * 2; }
__device__ __forceinline__ int v_rd_base(int lane) { return ((lane & 3) << 3) | (((lane >> 2) & 3) << 6) | (((lane >> 4) & 1) << 5) | (((lane >> 5) & 1) << 8); }
constexpr int v_rd_off(int d0, int ks, int half) { return d0 * 512 + ks * 4096 + half * 2048; }
template <int OFF> __device__ __forceinline__ s16x4 tr_read(int vb) {
  s16x4 r; asm volatile("ds_read_b64_tr_b16 %0, %1 offset:%2" : "=&v"(r) : "v"(vb), "i"(OFF) : "memory"); return r;
}
template <int D0> __device__ __forceinline__ void pv_one(f32x16& od, int vb, bf16x8 pa0, bf16x8 pa1, bf16x8 pa2, bf16x8 pa3) {
  const s16x4 l0 = tr_read<v_rd_off(D0, 0, 0)>(vb), h0 = tr_read<v_rd_off(D0, 0, 1)>(vb), l1 = tr_read<v_rd_off(D0, 1, 0)>(vb), h1 = tr_read<v_rd_off(D0, 1, 1)>(vb);
  const s16x4 l2 = tr_read<v_rd_off(D0, 2, 0)>(vb), h2 = tr_read<v_rd_off(D0, 2, 1)>(vb), l3 = tr_read<v_rd_off(D0, 3, 0)>(vb), h3 = tr_read<v_rd_off(D0, 3, 1)>(vb);
  asm volatile("s_waitcnt lgkmcnt(0)" ::: "memory"); SBAR();
#define PK(L, H) (bf16x8){L[0], L[1], L[2], L[3], H[0], H[1], H[2], H[3]}
  od = __builtin_amdgcn_mfma_f32_32x32x16_bf16(pa0, PK(l0, h0), od, 0, 0, 0);
  od = __builtin_amdgcn_mfma_f32_32x32x16_bf16(pa1, PK(l1, h1), od, 0, 0, 0);
  od = __builtin_amdgcn_mfma_f32_32x32x16_bf16(pa2, PK(l2, h2), od, 0, 0, 0);
  od = __builtin_amdgcn_mfma_f32_32x32x16_bf16(pa3, PK(l3, h3), od, 0, 0, 0);
#undef PK
}
__device__ __forceinline__ void pv_d0(f32x16* o, int vb, bf16x8 pa0, bf16x8 pa1, bf16x8 pa2, bf16x8 pa3) {
  pv_one<0>(o[0], vb, pa0, pa1, pa2, pa3); pv_one<1>(o[1], vb, pa0, pa1, pa2, pa3); pv_one<2>(o[2], vb, pa0, pa1, pa2, pa3); pv_one<3>(o[3], vb, pa0, pa1, pa2, pa3);
}
__device__ __forceinline__ void pv_sm(f32x16* o, int vb, bf16x8 pa0, bf16x8 pa1, bf16x8 pa2, bf16x8 pa3, f32x16& p0, f32x16& p1, float& m_reg, float& mn, float& alpha) {
  constexpr float C = SCALE * 1.4426950408889634f;
  pv_one<0>(o[0], vb, pa0, pa1, pa2, pa3);
  float pmax = p0[0];
#pragma unroll
  for (int r = 1; r < 16; ++r) pmax = fmaxf(pmax, p0[r]);
#pragma unroll
  for (int r = 0; r < 16; ++r) pmax = fmaxf(pmax, p1[r]);
  { auto rr = __builtin_amdgcn_permlane32_swap(__float_as_uint(pmax), __float_as_uint(pmax), false, false);
    pmax = fmaxf(__uint_as_float(rr[0]), __uint_as_float(rr[1])); }
  pv_one<1>(o[1], vb, pa0, pa1, pa2, pa3);
  const bool keep = __all(pmax - m_reg <= THR / SCALE);
  mn = keep ? m_reg : fmaxf(m_reg, pmax); alpha = __builtin_amdgcn_exp2f((m_reg - mn) * C); m_reg = mn;
  const float mnC = -mn * C;
#pragma unroll
  for (int r = 0; r < 16; ++r) p0[r] = fmaf(p0[r], C, mnC);
  pv_one<2>(o[2], vb, pa0, pa1, pa2, pa3);
#pragma unroll
  for (int r = 0; r < 16; ++r) p1[r] = fmaf(p1[r], C, mnC);
#pragma unroll
  for (int r = 0; r < 8; ++r) p0[r] = __builtin_amdgcn_exp2f(p0[r]);
  pv_one<3>(o[3], vb, pa0, pa1, pa2, pa3);
#pragma unroll
  for (int r = 8; r < 16; ++r) p0[r] = __builtin_amdgcn_exp2f(p0[r]);
}
__device__ __forceinline__ void attn_unit(const bf16_t* Qb, const bf16_t* Kb, const bf16_t* Vh, bf16_t* Ob, int seq, char* lds, float* stash, float lam, const float* subln) {
  int tid_ = threadIdx.x; asm volatile("" : "+v"(tid_));
  const int tid = tid_, wid = tid >> 6, lane = tid & 63, r32 = lane & 31, hi = lane >> 5;
  char* V_lds = lds; char* K_lds = lds + 3 * SHM_V;
  float* ws = (float*)(lds + 3 * SHM_V + 3 * SHM_K) + wid * 64; float* li_l = ws; float* al_l = ws + 32;
  const int sr = tid >> 4, sc = (tid & 15) * 8, vst0 = v_st(sr, sc), vst1 = v_st(32 + sr, sc);
  const int kr = tid >> 3, kc = (tid & 7) * 8, kst = KSWZ(kr, kc * 2);
  const int vb0 = (int)(uintptr_t)V_lds + v_rd_base(lane);
  const int NT = seq / KVBLK;
  f32x16 o[4];
  u32x4* const sl = (u32x4*)(lds + 3 * SHM_V + 3 * SHM_K + NW * 64 * 4) + tid;
  for (int comp = 0; comp < 2; ++comp) {
    const bf16_t* Kh = Kb + comp * 64;
    float m_reg = -1e30f, l_reg = 0; bf16x8 qr[4];
#pragma unroll
    for (int d = 0; d < 4; ++d) o[d] = f32x16{};
    const bf16_t* Qw = Qb + comp * 64 + (long)(wid * QBLK + r32) * LD + hi * 8;
#pragma unroll
    for (int d0 = 0; d0 < 4; ++d0) qr[d0] = *reinterpret_cast<const bf16x8*>(Qw + d0 * 16);
    struct { bf16x8 vs0, vs1, ks0; } sr_[2];
#define SLOAD(i, k0) do { sr_[i].vs0 = *reinterpret_cast<const bf16x8*>(&Vh[(long)((k0) + sr) * LD + sc]); sr_[i].vs1 = *reinterpret_cast<const bf16x8*>(&Vh[(long)((k0) + 32 + sr) * LD + sc]); \
    sr_[i].ks0 = *reinterpret_cast<const bf16x8*>(&Kh[(long)((k0) + kr) * LD + kc]); } while (0)
#define SWRITE(b, i) do { *(bf16x8*)(V_lds + (b) * SHM_V + vst0) = sr_[i].vs0; *(bf16x8*)(V_lds + (b) * SHM_V + vst1) = sr_[i].vs1; \
    *(bf16x8*)(K_lds + (b) * SHM_K + kst) = sr_[i].ks0; } while (0)
#define SWAIT() asm volatile("s_waitcnt vmcnt(3)" ::: "memory")
#define RESC(a) do { if (__any((a) < 1.f)) { if (hi == 0) al_l[r32] = (a); asm volatile("s_waitcnt lgkmcnt(0)" ::: "memory"); \
    _Pragma("unroll") for (int d = 0; d < 4; ++d) _Pragma("unroll") for (int r = 0; r < 16; ++r) o[d][r] *= al_l[crow(r, hi)]; } } while (0)
    f32x16 pA0, pA1, pB0, pB1; float mnA, mnB, alA, alB; bf16x8 pa0, pa1, pa2, pa3;
    int bp = 0, bc = 1, bn = 2;
#define ROT3() do { const int t_ = bp; bp = bc; bc = bn; bn = t_; } while (0)
    SLOAD(0, 0); asm volatile("s_waitcnt vmcnt(0)" ::: "memory"); SWRITE(0, 0); __syncthreads();
    qkt(pA0, pA1, K_lds, qr, r32, hi); partialSM(pA0, pA1, m_reg, mnA, alA);
    SLOAD(1, KVBLK); if (2 < NT) SLOAD(0, 2 * KVBLK);
    SWAIT(); SWRITE(1, 1); __syncthreads();
    for (int j = 1; j + 1 < NT; j += 2) {
      SBAR(); qkt(pB0, pB1, K_lds + bc * SHM_K, qr, r32, hi);
      finishSM(pA0, pA1, alA, l_reg, pa0, pa1, pa2, pa3); SBAR();
      SLOAD(1, (j + 2) * KVBLK); SBAR();
      pv_sm(o, vb0 + bp * SHM_V, pa0, pa1, pa2, pa3, pB0, pB1, m_reg, mnB, alB);
      SWAIT(); SWRITE(bn, 0);
      RESC(alB); __syncthreads(); ROT3();
      SBAR(); qkt(pA0, pA1, K_lds + bc * SHM_K, qr, r32, hi);
      finishSM(pB0, pB1, alB, l_reg, pa0, pa1, pa2, pa3); SBAR();
      if (j + 3 < NT) SLOAD(0, (j + 3) * KVBLK); SBAR();
      pv_sm(o, vb0 + bp * SHM_V, pa0, pa1, pa2, pa3, pA0, pA1, m_reg, mnA, alA);
      SWAIT(); SWRITE(bn, 1);
      RESC(alA); __syncthreads(); ROT3();
    }
    SBAR(); qkt(pB0, pB1, K_lds + bc * SHM_K, qr, r32, hi);
    finishSM(pA0, pA1, alA, l_reg, pa0, pa1, pa2, pa3); SBAR();
    pv_sm(o, vb0 + bp * SHM_V, pa0, pa1, pa2, pa3, pB0, pB1, m_reg, mnB, alB);
    RESC(alB);
    finishSM(pB0, pB1, alB, l_reg, pa0, pa1, pa2, pa3); SBAR();
    pv_d0(o, vb0 + bc * SHM_V, pa0, pa1, pa2, pa3);
#undef ROT3
    if (hi == 0) li_l[r32] = l_reg; asm volatile("s_waitcnt lgkmcnt(0)" ::: "memory");
#pragma unroll
    for (int r = 0; r < 16; ++r) { const float rl = __builtin_amdgcn_rcpf(li_l[crow(r, hi)]);
#pragma unroll
      for (int d0 = 0; d0 < 4; ++d0) o[d0][r] *= rl; }
    if (comp == 0) {
#pragma unroll
      for (int d0 = 0; d0 < 4; ++d0)
#pragma unroll
        for (int hf = 0; hf < 2; ++hf) { u32x4 t; t.x = cvtpk(o[d0][8 * hf], o[d0][8 * hf + 1]); t.y = cvtpk(o[d0][8 * hf + 2], o[d0][8 * hf + 3]); t.z = cvtpk(o[d0][8 * hf + 4], o[d0][8 * hf + 5]); t.w = cvtpk(o[d0][8 * hf + 6], o[d0][8 * hf + 7]); sl[(d0 * 2 + hf) * 512] = t; } }
    __syncthreads();
#undef SLOAD
#undef SWRITE
#undef SWAIT
#undef RESC
  }
  {
    bf16_t* stg = (bf16_t*)(lds + wid * 8704);
    float sg[4];
#pragma unroll
    for (int d0 = 0; d0 < 4; ++d0) sg[d0] = subln[d0 * 32 + r32] * 0.8f;
#pragma unroll
    for (int hf = 0; hf < 2; ++hf) {
      u32x4 t0[4];
#pragma unroll
      for (int d0 = 0; d0 < 4; ++d0) t0[d0] = sl[(d0 * 2 + hf) * 512];
#pragma unroll
      for (int k = 0; k < 8; ++k) { const int r = 8 * hf + k; float v[4]; float q = 0.f;
#pragma unroll
        for (int d0 = 0; d0 < 4; ++d0) { const unsigned w0 = t0[d0][k >> 1];
          const float a = __uint_as_float((k & 1) ? (w0 & 0xffff0000u) : (w0 << 16));
          v[d0] = a - lam * o[d0][r]; q += v[d0] * v[d0]; }
        q = xl::sum32(q);
        const float rs = __builtin_amdgcn_rsqf(q * (1.0f / 128.0f) + 1e-6f); const int orow = crow(r, hi);
#pragma unroll
        for (int d0 = 0; d0 < 4; ++d0) { const float w = v[d0] * rs * sg[d0]; stg[orow * 136 + d0 * 32 + r32] = (bf16_t)(cvtpk(w, w) & 0xffffu); } }
      asm volatile("" ::: "memory");
    }
    asm volatile("s_waitcnt lgkmcnt(0)" ::: "memory");
    bf16_t* Og = Ob + (long)(wid * QBLK) * LD;
#pragma unroll
    for (int i = 0; i < 8; ++i) { const int row = i * 4 + (lane >> 4), ch = lane & 15; const u32x4 t = *(const u32x4*)((const char*)stg + row * 272 + ch * 16); *(u32x4*)(Og + (long)row * LD + ch * 8) = t; }
  }
  __syncthreads();
}
#undef SBAR
#undef KSWZ
}

namespace ct {
using att::bf16x8; using att::f32x16; using att::bf16_t;
template <int MB> __device__ __forceinline__ void unit(const bf16_t* Amat, int K, const bf16_t* src, int P, long sA, long sB, bf16_t* dst, int Q, long sC, long sD, float scale, char* lds) {
  constexpr int NCH = 8 / MB;
  int tid_ = threadIdx.x; asm volatile("" : "+v"(tid_));
  const int tid = tid_, wid = tid >> 6, lane = tid & 63, r32 = lane & 31, hi = lane >> 5;
  const int rb = wid % MB, cc = wid / MB;
  const int sr = tid >> 4, sc = (tid & 15) * 8, vst0 = att::v_st(sr, sc), vst1 = att::v_st(32 + sr, sc);
  const int vb = (int)(uintptr_t)lds + cc * 16384 + att::v_rd_base(lane);
  const int NKT = K >> 6;
#pragma unroll 1
  for (int cs = 0; cs < 4 / NCH; ++cs) {
    f32x16 o[4] = {};
#pragma unroll 1
    for (int kt = 0; kt < NKT; ++kt) {
      const int k0 = kt * 64 + sr, k1 = k0 + 32;
      const bf16_t* r0 = src + (long)(k0 % P) * sA + (long)(k0 / P) * sB + cs * NCH * 128 + sc;
      const bf16_t* r1 = src + (long)(k1 % P) * sA + (long)(k1 / P) * sB + cs * NCH * 128 + sc;
      bf16x8 t0[NCH], t1[NCH];
#pragma unroll
      for (int ch = 0; ch < NCH; ++ch) { t0[ch] = *reinterpret_cast<const bf16x8*>(r0 + ch * 128); t1[ch] = *reinterpret_cast<const bf16x8*>(r1 + ch * 128); }
      const bf16_t* ap = Amat + (long)(rb * 32 + r32) * K + kt * 64 + hi * 8;
      const bf16x8 pa0 = *reinterpret_cast<const bf16x8*>(ap), pa1 = *reinterpret_cast<const bf16x8*>(ap + 16), pa2 = *reinterpret_cast<const bf16x8*>(ap + 32), pa3 = *reinterpret_cast<const bf16x8*>(ap + 48);
      __syncthreads();
#pragma unroll
      for (int ch = 0; ch < NCH; ++ch) { *(bf16x8*)(lds + ch * 16384 + vst0) = t0[ch]; *(bf16x8*)(lds + ch * 16384 + vst1) = t1[ch]; }
      __syncthreads();
      att::pv_d0(o, vb, pa0, pa1, pa2, pa3);
    }
    bf16_t* stg = (bf16_t*)(lds + 65536 + wid * 8704);
#pragma unroll
    for (int r = 0; r < 16; ++r) { const int orow = att::crow(r, hi);
#pragma unroll
      for (int d0 = 0; d0 < 4; ++d0) { const __bf16 hb = (__bf16)(o[d0][r] * scale); stg[orow * 136 + d0 * 32 + r32] = __builtin_bit_cast(bf16_t, hb); } }
    asm volatile("s_waitcnt lgkmcnt(0)" ::: "memory");
#pragma unroll
    for (int i = 0; i < 8; ++i) { const int row = i * 4 + (lane >> 4), ch = lane & 15, m = rb * 32 + row;
      const att::u32x4 t = *(const att::u32x4*)((const char*)stg + row * 272 + ch * 16);
      *(att::u32x4*)(dst + (long)(m % Q) * sC + (long)(m / Q) * sD + (cs * NCH + cc) * 128 + ch * 8) = t; }
    asm volatile("s_waitcnt lgkmcnt(0)" ::: "memory");
  }
  __syncthreads();
}
}
#define LAS __attribute__((address_space(3)))
typedef unsigned short bf16;
typedef unsigned v4u __attribute__((ext_vector_type(4)));
typedef float f32x4 __attribute__((ext_vector_type(4)));
constexpr int NWAVES = 8;
constexpr int T = 81920, TP = 65536, D = 1024, FF = 4096, PLE = 256, INW = 5632;
constexpr float EPS = 1e-6f;
constexpr size_t MiB = 1u << 20;
constexpr size_t WS_ROPE = 1 * MiB;
constexpr size_t WS_WF2 = 2 * MiB, WS_WQKV = 4 * MiB, WS_WG = 10 * MiB, WS_WF = 14 * MiB, WS_WA = 15 * MiB, WS_WO = 17 * MiB, WS_WUP = 19 * MiB, WS_WDN = 27 * MiB, WS_WPLE = 35 * MiB, WS_WGATE = 36 * MiB;
constexpr size_t WS_A1S = 42 * MiB, WS_A1P = 46 * MiB, WS_A2S = 47 * MiB, WS_A2P = 47 * MiB + 512 * 1024;
constexpr size_t WS_UC = 544 * MiB;
constexpr size_t WS_SS = 58 * MiB;
constexpr size_t WS_XH = 64 * MiB;
constexpr size_t WS_GT = 224 * MiB;
constexpr size_t WS_Q = 384 * MiB, WS_K = 544 * MiB, WS_V = 704 * MiB;
constexpr size_t WS_F = 864 * MiB;
constexpr size_t WS_STASH = 944 * MiB;
constexpr size_t WS_U = 384 * MiB;
constexpr size_t WS_PB = 384 * MiB;
constexpr size_t WS_EP = 424 * MiB, WS_E = 584 * MiB;
constexpr int LDS_BYTES = 147456;

#define XB_TMO      128
#define XB_XCNT(j)  (256  + 64 * (j))
#define XB_XSUB(j)  (1280 + 64 * (j))
#define XB_XGEN(j)  (2304 + 64 * (j))
#define XB_TOP      3328
#define XB_TOPGEN   3392
#define XCD_BAR_WORDS 3456
#define XB_SPIN_CAP (1u << 18)

__device__ __forceinline__ unsigned xb_ld(unsigned* p)              { return __hip_atomic_load(p, __ATOMIC_RELAXED, __HIP_MEMORY_SCOPE_AGENT); }
__device__ __forceinline__ unsigned xb_add(unsigned* p, unsigned v) { return __hip_atomic_fetch_add(p, v, __ATOMIC_RELAXED, __HIP_MEMORY_SCOPE_AGENT); }
__device__ __forceinline__ unsigned xb_xcc_id() { return (unsigned)__builtin_amdgcn_s_getreg((3 << 11) | 20) & 0xFu; }
#define XB_SPIN(cond, bar) do { unsigned _sp = 0; while (cond) { __builtin_amdgcn_s_sleep(1); \
    if ((++_sp & 255u) == 0u) { if (xb_ld(&(bar)[XB_TMO])) break; if (_sp > XB_SPIN_CAP) { atomicAdd(&(bar)[XB_TMO], 1u); break; } } } } while (0)

struct XcdBarrier {
    unsigned* bar; unsigned x;
    volatile LAS unsigned* st;
};

__device__ __forceinline__ XcdBarrier xcd_barrier_post(unsigned* bar, volatile LAS unsigned* st) {
    XcdBarrier b; b.bar = bar; b.x = xb_xcc_id(); b.st = st;
    if (threadIdx.x == 0) (void)xb_add(&bar[XB_XCNT(b.x)], 1u);
    return b;
}
__device__ __forceinline__ void xcd_barrier_complete(unsigned* bar, unsigned x, unsigned& nloc, unsigned& nx) {
    const unsigned G = gridDim.x * gridDim.y * gridDim.z;
    unsigned sum, cnt, mine, sp = 0u;
    for (;;) {
        sum = 0u; cnt = 0u; mine = 0u;
#pragma unroll
        for (unsigned j = 0; j < 16; ++j) { const unsigned c = xb_ld(&bar[XB_XCNT(j)]); sum += c; cnt += (c > 0u) ? 1u : 0u; mine = (j == x) ? c : mine; }
        if (sum == G) break;
        __builtin_amdgcn_s_sleep(1);
        if ((++sp & 255u) == 0u) { if (xb_ld(&bar[XB_TMO])) break; if (sp > XB_SPIN_CAP) { atomicAdd(&bar[XB_TMO], 1u); break; } }
    }
    nloc = mine > 0u ? mine : 1u; nx = cnt > 0u ? cnt : 1u;
}

__device__ __forceinline__ void xcd_barrier(const XcdBarrier& b) {
    asm volatile("s_waitcnt vmcnt(0)" ::: "memory");
    __syncthreads();
    if (threadIdx.x == 0) {
        unsigned* bar = b.bar;
        __builtin_amdgcn_s_waitcnt(0);
        unsigned nloc = b.st[0], nx = b.st[1];
        if (nloc == 0u) { xcd_barrier_complete(bar, b.x, nloc, nx); b.st[0] = nloc; b.st[1] = nx; }
        const unsigned old = xb_add(&bar[XB_XSUB(b.x)], 1u);
        const unsigned gen = old / nloc;
        if (old + 1u == (gen + 1u) * nloc) {
            __builtin_amdgcn_fence(__ATOMIC_RELEASE, "agent");
            asm volatile("s_waitcnt vmcnt(0)" ::: "memory");
            const unsigned og = xb_add(&bar[XB_TOP], 1u);
            const unsigned tg = og / nx;
            if (og + 1u == (tg + 1u) * nx) xb_add(&bar[XB_TOPGEN], 1u);
            else XB_SPIN(xb_ld(&bar[XB_TOPGEN]) == tg, bar);
            __builtin_amdgcn_fence(__ATOMIC_ACQUIRE, "agent");
            xb_add(&bar[XB_XGEN(b.x)], 1u);
            asm volatile("s_waitcnt vmcnt(0)" ::: "memory");
        } else {
            XB_SPIN(xb_ld(&bar[XB_XGEN(b.x)]) == gen, bar);
            __builtin_amdgcn_fence(__ATOMIC_ACQUIRE, "agent");
            asm volatile("s_waitcnt vmcnt(0)" ::: "memory");
        }
    }
    __syncthreads();
}

struct Args { const float* in[22]; float* out; unsigned char* ws; int ph_lo, ph_hi; };

__device__ __forceinline__ float wave_sum(float v) { return xl::sum64(v); }
__device__ __forceinline__ unsigned pk2(float lo, float hi) { return pg8::cvt_pk_bf16(lo, hi); }
__device__ __forceinline__ f32x4 unp4(unsigned long long q) { f32x4 r; r.x = __uint_as_float((unsigned)q << 16); r.y = __uint_as_float((unsigned)q & 0xffff0000u); r.z = __uint_as_float((unsigned)(q >> 32) << 16); r.w = __uint_as_float((unsigned)(q >> 32) & 0xffff0000u); return r; }
__device__ __forceinline__ unsigned long long pk4(f32x4 v) { return (unsigned long long)pk2(v.x, v.y) | ((unsigned long long)pk2(v.z, v.w) << 32); }
__device__ __forceinline__ void p0_transpose_item(const float* W, int ldw, int col0, int K, int N, const float* gain, bf16* WT, LAS float* scr, int item, int lane) {
    const int nblk = N / 32, kb = item / nblk, nb = item % nblk, k0 = 64 * kb, n0 = 32 * nb;
    float wv[32];
#pragma unroll
    for (int i = 0; i < 32; ++i) { const int kk = 2 * i + (lane >> 5); wv[i] = W[(size_t)(k0 + kk) * ldw + col0 + n0 + (lane & 31)]; }
#pragma unroll
    for (int i = 0; i < 32; ++i) { const int kk = 2 * i + (lane >> 5); const float g = gain ? gain[k0 + kk] : 1.f; scr[kk * 33 + (lane & 31)] = wv[i] * g; }
    asm volatile("s_waitcnt lgkmcnt(0)" ::: "memory");
    const int c = lane & 7;
#pragma unroll
    for (int j = 0; j < 4; ++j) { const int n = (lane >> 3) + 8 * j; const LAS float* s = scr + (8 * c) * 33 + n;
        v4u o; o.x = pk2(s[0 * 33], s[1 * 33]); o.y = pk2(s[2 * 33], s[3 * 33]); o.z = pk2(s[4 * 33], s[5 * 33]); o.w = pk2(s[6 * 33], s[7 * 33]);
        *(v4u*)(WT + (size_t)(n0 + n) * K + k0 + 8 * c) = o; }
    asm volatile("s_waitcnt lgkmcnt(0)" ::: "memory");
}
__device__ __forceinline__ const float* xrow(const Args& a, int m) { return m < TP ? a.in[0] + (size_t)m * D : a.in[1] + (size_t)(m - TP) * D; }

__global__ void __launch_bounds__(NWAVES * 64, 2) fwd_mega(Args args) {
    extern __shared__ __attribute__((aligned(16))) unsigned char lds[];
    cg::grid_group grid = cg::this_grid();
#define IN(k) (args.ph_lo <= (k) && (k) < args.ph_hi)
    volatile LAS unsigned* xst = (volatile LAS unsigned*)((LAS unsigned char*)lds + (LDS_BYTES - 16));
    if (threadIdx.x == 0) { xst[0] = 0u; xst[1] = 0u; }
    __syncthreads();
    const XcdBarrier xbar = xcd_barrier_post((unsigned*)args.ws, xst);
#define GSYNC() xcd_barrier(xbar)
    const int tid = threadIdx.x, lane = tid & 63, wave = __builtin_amdgcn_readfirstlane(tid >> 6);
    const int G = gridDim.x, bx = blockIdx.x; const int vcu = (G % 8 == 0) ? (bx % 8) * (G / 8) + bx / 8 : bx;
    unsigned char* ws = args.ws;
    LAS unsigned char* ldsl = (LAS unsigned char*)lds;
#define WF2 ((bf16*)(ws + WS_WF2))
#define WQKV ((bf16*)(ws + WS_WQKV))
#define WG ((bf16*)(ws + WS_WG))
#define WF ((bf16*)(ws + WS_WF))
#define WA ((bf16*)(ws + WS_WA))
#define WO ((bf16*)(ws + WS_WO))
#define WUP ((bf16*)(ws + WS_WUP))
#define WDN ((bf16*)(ws + WS_WDN))
#define WPLE ((bf16*)(ws + WS_WPLE))
#define WGATE ((bf16*)(ws + WS_WGATE))
#define ROPE ((float*)(ws + WS_ROPE))
#define UC ((bf16*)(ws + WS_UC))
#define SS ((float*)(ws + WS_SS))
#define XH ((bf16*)(ws + WS_XH))
#define GT ((bf16*)(ws + WS_GT))
#define QB ((bf16*)(ws + WS_Q))
#define KB ((bf16*)(ws + WS_V))
#define VB ((bf16*)(ws + WS_V) + (size_t)T * D)
#define FB ((bf16*)(ws + WS_F))
    const int gw = vcu * NWAVES + wave, NGW = G * NWAVES;
    const int gtid = bx * (NWAVES * 64) + tid, NGT = G * NWAVES * 64;

    using pg8::Gemm; using pg8::StaticOrder; using pg8::EpiGen; using pg8::ListOrder;
    LAS unsigned char* ring = ldsl;
    if (IN(0)) {
    {
        LAS float* scr = (LAS float*)(ldsl + wave * 16384);
        const float* w_in = args.in[5];
        constexpr int I_QKV = 16 * 96, I_G = 16 * 64, I_F = 8 * 32, I_A = 16 * 32, I_O = 16 * 32, I_UP = 16 * 128, I_DN = 64 * 32, I_PLE = 4 * 32, I_GATE = 16 * 32;
        constexpr int NITEMS = I_QKV + I_G + I_F + I_A + I_O + I_UP + I_DN + I_PLE + I_GATE;
        for (int it = gw; it < NITEMS; it += NGW) {
            int r = it;
            if (r < I_QKV) { p0_transpose_item(w_in, INW, 512, D, 3072, args.in[4], WQKV, scr, r, lane); continue; } r -= I_QKV;
            if (r < I_G) { p0_transpose_item(w_in, INW, 3584, D, 2048, args.in[4], WG, scr, r, lane); continue; } r -= I_G;
            if (r < I_F) { p0_transpose_item(args.in[6], D, 0, 512, D, nullptr, WF, scr, r, lane); continue; } r -= I_F;
            if (r < I_A) { p0_transpose_item(args.in[7], D, 0, D, D, nullptr, WA, scr, r, lane); continue; } r -= I_A;
            if (r < I_O) { p0_transpose_item(args.in[8], D, 0, D, D, nullptr, WO, scr, r, lane); continue; } r -= I_O;
            if (r < I_UP) { p0_transpose_item(args.in[16], FF, 0, D, FF, args.in[15], WUP, scr, r, lane); continue; } r -= I_UP;
            if (r < I_DN) { p0_transpose_item(args.in[17], D, 0, FF, D, nullptr, WDN, scr, r, lane); continue; } r -= I_DN;
            if (r < I_PLE) { p0_transpose_item(args.in[19], D, 0, PLE, D, nullptr, WPLE, scr, r, lane); continue; } r -= I_PLE;
            p0_transpose_item(args.in[20], D, 0, D, D, nullptr, WGATE, scr, r, lane);
        }
        __syncthreads();
        {
            LAS float* Wt = (LAS float*)ldsl;
            LAS float* ctab = (LAS float*)(ldsl + 8192);
            for (int item = bx; item < 256; item += G) {
                const int grp = item >> 6, k0 = (item & 63) * 16;
                for (int e = tid; e < 2048; e += NWAVES * 64) { const int kk = e >> 7, c = e & 127; Wt[c * 16 + kk] = w_in[(size_t)(k0 + kk) * INW + grp * 128 + c] * args.in[4][k0 + kk]; }
                if (tid < 128) ctab[tid] = __builtin_amdgcn_cosf((float)tid * (1.0f / 128.0f));
                __syncthreads();
                const int m = tid & 127, comp = (tid >> 7) & 1, kh = tid >> 8;
                float acc[8];
#pragma unroll
                for (int i = 0; i < 8; ++i) acc[i] = 0.f;
                for (int c = 0; c < 128; ++c) { const float t = ctab[(c * m + (comp ? 96 : 0)) & 127]; const LAS f32x4* wp = (const LAS f32x4*)(Wt + c * 16 + kh * 8); const f32x4 w0 = wp[0], w1 = wp[1];
#pragma unroll
                    for (int i = 0; i < 4; ++i) { acc[i] += w0[i] * t; acc[4 + i] += w1[i] * t; } }
                v4u o; o.x = pk2(acc[0], acc[1]); o.y = pk2(acc[2], acc[3]); o.z = pk2(acc[4], acc[5]); o.w = pk2(acc[6], acc[7]);
                *(v4u*)(WF2 + (size_t)(comp * 512 + grp * 128 + m) * D + k0 + kh * 8) = o;
                __syncthreads();
            }
        }
        { bf16* A1S = (bf16*)(ws + WS_A1S); bf16* A1P = (bf16*)(ws + WS_A1P); bf16* A2S = (bf16*)(ws + WS_A2S); bf16* A2P = (bf16*)(ws + WS_A2P);
          for (int it = gtid; it < 128 * 128 * 128; it += NGT) { const int k = it & 127, m = (it >> 7) & 127, s2 = it >> 14; const int ri = m >> 6, k1 = m & 63, comp = k >> 6, s1 = k & 63;
              const float fr = (float)((k1 * (128 * s1 + s2)) & 8191) * (1.0f / 8192.0f); const float c = __builtin_amdgcn_cosf(fr), s = __builtin_amdgcn_sinf(fr);
              const float v = ri == 0 ? (comp == 0 ? c : -s) : (comp == 0 ? -s : -c); A1S[it] = (bf16)(pk2(v, v) & 0xffffu); }
          for (int it = gtid; it < 64 * 64 * 64; it += NGT) { const int k = it & 63, m = (it >> 6) & 63, s2 = it >> 12; const int ri = m >> 5, k1 = m & 31, comp = k >> 5, s1 = k & 31;
              const float fr = (float)((k1 * (64 * s1 + s2)) & 2047) * (1.0f / 2048.0f); const float c = __builtin_amdgcn_cosf(fr), s = __builtin_amdgcn_sinf(fr);
              const float v = ri == 0 ? (comp == 0 ? c : -s) : (comp == 0 ? -s : -c); A1P[it] = (bf16)(pk2(v, v) & 0xffffu); }
          for (int it = gtid; it < 128 * 256; it += NGT) { const int k = it & 255, k2 = it >> 8; const int ri = k >> 7, s2 = k & 127;
              const float fr = (float)((k2 * s2) & 127) * (1.0f / 128.0f); const float v = ri == 0 ? __builtin_amdgcn_cosf(fr) : __builtin_amdgcn_sinf(fr); A2S[it] = (bf16)(pk2(v, v) & 0xffffu); }
          for (int it = gtid; it < 64 * 128; it += NGT) { const int k = it & 127, k2 = it >> 7; const int ri = k >> 6, s2 = k & 63;
              const float fr = (float)((k2 * s2) & 63) * (1.0f / 64.0f); const float v = ri == 0 ? __builtin_amdgcn_cosf(fr) : __builtin_amdgcn_sinf(fr); A2P[it] = (bf16)(pk2(v, v) & 0xffffu); }
        }
        if (gtid < 65536) { const int pos = gtid >> 3, i = gtid & 7;
            const double ifr[8] = {0.15915494309189535, 0.03086376340470123, 0.005985185712713705, 0.001160663641240061, 0.00022507907903927653, 4.364795279280289e-05, 8.464330808241401e-06, 1.6414262627950345e-06};
            double rev = (double)pos * (i == 0 ? ifr[0] : i == 1 ? ifr[1] : i == 2 ? ifr[2] : i == 3 ? ifr[3] : i == 4 ? ifr[4] : i == 5 ? ifr[5] : i == 6 ? ifr[6] : ifr[7]);
            rev -= (double)(long long)rev; const float fr = (float)rev;
            ROPE[pos * 16 + i] = __builtin_amdgcn_cosf(fr); ROPE[pos * 16 + 8 + i] = __builtin_amdgcn_sinf(fr); }
        for (int m0 = gw; m0 < T; m0 += 4 * NGW) { f32x4 v[4][4];
#pragma unroll
            for (int r = 0; r < 4; ++r) { const int m = m0 + r * NGW; if (m < T) { const f32x4* xr = (const f32x4*)xrow(args, m) + lane;
#pragma unroll
                for (int j = 0; j < 4; ++j) v[r][j] = xr[64 * j]; } }
#pragma unroll
            for (int r = 0; r < 4; ++r) { const int m = m0 + r * NGW; if (m < T) { float s = 0.f;
#pragma unroll
                for (int j = 0; j < 4; ++j) s += (v[r][j].x * v[r][j].x + v[r][j].y * v[r][j].y) + (v[r][j].z * v[r][j].z + v[r][j].w * v[r][j].w);
                const float ms = wave_sum(s) * (1.f / D) + EPS; const float rs = __builtin_amdgcn_rsqf(ms);
                if (lane == 0) ((float*)(ws + 63 * MiB))[m] = ms * rs;
                unsigned long long* o8 = (unsigned long long*)(XH + (size_t)m * D) + lane;
#pragma unroll
                for (int j = 0; j < 4; ++j) o8[64 * j] = pk4(v[r][j] * rs); } } }
    }
    if (IN(0) && IN(1)) { asm volatile("s_waitcnt vmcnt(0)" ::: "memory"); grid.sync(); }

    }

    if (IN(1)) {
    {
        Gemm g{XH, WF2, T, 4096, D}; StaticOrder S; S.init(T, 4096, G, bx); pg8::EpiQKV E{GT, QB, KB, (size_t)T * D, ROPE};
        pg8::gemm_phase<pg8::EpiQKV, StaticOrder, true, true>(ring, g, S, E);
    }
    if (IN(1) && IN(2)) GSYNC();

    }
#define GF GT
#define GA ((bf16*)(ws + WS_V))
#define Y1 ((bf16*)(ws + WS_UC))
#define MG GT
#define ATT QB
    if (IN(2)) {
    {
        float lam;
        { const float a = wave_sum(args.in[9][lane] * args.in[10][lane]), b = wave_sum(args.in[11][lane] * args.in[12][lane]); lam = __expf(a) - __expf(b) + 0.2f; }
        float* stash = (float*)(ws + WS_STASH) + (size_t)bx * 32768;
        const int NCU = G;
        const int ppc = (2048 + NCU - 1) / NCU, spc = (512 + NCU - 1) / NCU;
#ifdef DBG_ATT2
        for (int pass2 = 0; pass2 < 2; ++pass2)
#else
        const int pass2 = 1;
#endif
        for (int i = 0; i < ppc + spc; ++i) { const bool smp = i >= ppc; int bh, qb;
            if (NCU == 256) { if (smp) { bh = (vcu >> 5) + 8 * (i - ppc); qb = vcu & 31; } else { bh = (vcu >> 3) + 32 * i; qb = vcu & 7; } }
            else { const int ui = smp ? vcu * spc + (i - ppc) : vcu * ppc + i; if (ui >= (smp ? 512 : 2048)) continue; const int lq = smp ? 5 : 3; bh = ui >> lq; qb = ui & ((1 << lq) - 1); }
            const int b = bh >> 3, h = bh & 7; const int seq = smp ? 8192 : 2048;
            const size_t r0 = (smp ? (size_t)TP : 0) + (size_t)b * seq; const size_t qo = (r0 + qb * 256) * D + h * 128, ko = r0 * D + h * 128;
            att::attn_unit(QB + qo, KB + ko, VB + ko, (pass2 ? QB : UC) + qo, seq, (char*)lds, stash, lam, args.in[13]); }
        __syncthreads();
        { const bf16* A1S = (const bf16*)(ws + WS_A1S); const bf16* A1P = (const bf16*)(ws + WS_A1P); bf16* US = UC + (size_t)131072 * 512;
          for (int ui = vcu; ui < 256 + 2048; ui += NCU) {
            if (ui < 256) { const int b = ui >> 7, s2 = ui & 127;
                ct::unit<4>(A1S + (size_t)s2 * 128 * 128, 128, GT + ((size_t)TP + (size_t)b * 8192 + s2) * 1024, 64, 128L * 1024, 512L, US + ((size_t)b * 64 * 2 * 128 + s2) * 512, 64, 2L * 128 * 512, 128L * 512, 1.0f, (char*)lds); }
            else { const int up = ui - 256, b = up >> 6, s2 = up & 63;
                ct::unit<2>(A1P + (size_t)s2 * 64 * 64, 64, GT + ((size_t)b * 2048 + s2) * 1024, 32, 64L * 1024, 512L, UC + ((size_t)b * 32 * 2 * 64 + s2) * 512, 32, 2L * 64 * 512, 64L * 512, 1.0f, (char*)lds); }
          } }
    }
    if (IN(2) && IN(3)) GSYNC();

    }

    if (IN(3)) {
    {
        const bf16* A2S = (const bf16*)(ws + WS_A2S); const bf16* A2P = (const bf16*)(ws + WS_A2P); const bf16* US = UC + (size_t)131072 * 512;
        for (int ui = vcu; ui < 128 + 1024; ui += G) {
            if (ui < 128) { const int b = ui >> 6, k1 = ui & 63;
                ct::unit<4>(A2S, 256, US + ((size_t)(b * 64 + k1) * 2 * 128) * 512, 256, 512L, 0L, FB + ((size_t)TP + (size_t)b * 8192 + k1) * 512, 128, 64L * 512, 0L, 1.0f / 1024.0f, (char*)lds); }
            else { const int up = ui - 128, b = up >> 5, k1 = up & 31;
                ct::unit<2>(A2P, 128, UC + ((size_t)(b * 32 + k1) * 2 * 64) * 512, 128, 512L, 0L, FB + ((size_t)b * 2048 + k1) * 512, 64, 32L * 512, 0L, 1.0f / 512.0f, (char*)lds); }
        }
    }
    {
        Gemm g{XH, WG, T, 2048, D}; StaticOrder S; S.init(T, 2048, G, bx); EpiGen<1> E{GF, D, nullptr, nullptr, nullptr, 1.f, (size_t)(WS_V - WS_GT) / 2};
        pg8::gemm_phase<EpiGen<1>, StaticOrder, true, true>(ring, g, S, E);
    }
    if (IN(3) && IN(4)) GSYNC();

    }

    if (IN(4)) {
    {
        Gemm g{FB, WF, T, D, 512}; StaticOrder S; S.init(T, D, G, bx); EpiGen<2> E{Y1, D, GF, nullptr, nullptr, 1.f, 0};
        pg8::gemm_phase<EpiGen<2>, StaticOrder, true, true>(ring, g, S, E);
    }

    }

    if (IN(5)) {
    {
        Gemm g{ATT, WA, T, D, D}; StaticOrder S; S.init(T, D, G, bx); EpiGen<3> E{MG, D, Y1, GA, nullptr, 1.f, 0};
        pg8::gemm_phase<EpiGen<3>, StaticOrder, true, true>(ring, g, S, E);
    }
    if (IN(5) && IN(6)) GSYNC();

    }
#define Z XH
#define Z4 UC
    if (IN(6)) {
    {
        Gemm g{MG, WO, T, D, D}; StaticOrder S; S.init(T, D, G, bx); EpiGen<4> E{Z4, D, nullptr, nullptr, SS, 1.f, 0};
        pg8::gemm_phase<EpiGen<4>, StaticOrder, true, true>(ring, g, S, E);
    }
    if (IN(6) && IN(7)) GSYNC();

    }
#define H2 GT
    if (IN(7)) {
    { int ln_ = threadIdx.x; asm volatile("" : "+v"(ln_)); const int lane = ln_ & 63; constexpr int RB = 4;
    f32x4 gg[4];
#pragma unroll
    for (int j = 0; j < 4; ++j) gg[j] = ((const f32x4*)args.in[14] + lane)[64 * j];
    for (int m0 = gw; m0 < T; m0 += RB * NGW) {
        unsigned long long xq[RB][4], zq[RB][4]; float sv[RB], xsv[RB];
#pragma unroll
        for (int r = 0; r < RB; ++r) { const int m = m0 + r * NGW; if (m < T) {
            sv[r] = (lane < 16) ? SS[(size_t)m * 16 + lane] : 0.f; xsv[r] = ((const float*)(ws + 63 * MiB))[m];
            const unsigned long long* xr = (const unsigned long long*)(XH + (size_t)m * D) + lane; const unsigned long long* zr = (const unsigned long long*)(Z4 + (size_t)m * D) + lane;
#pragma unroll
            for (int j = 0; j < 4; ++j) { xq[r][j] = xr[64 * j]; zq[r][j] = zr[64 * j]; } } }
#pragma unroll
        for (int r = 0; r < RB; ++r) { const int m = m0 + r * NGW; if (m < T) {
            const float rs = __builtin_amdgcn_rsqf(wave_sum(sv[r]) * (1.f / D) + EPS); f32x4 v[4]; float s2 = 0.f;
#pragma unroll
            for (int j = 0; j < 4; ++j) { v[j] = unp4(xq[r][j]) * xsv[r] + unp4(zq[r][j]) * rs * gg[j]; s2 += (v[j].x * v[j].x + v[j].y * v[j].y) + (v[j].z * v[j].z + v[j].w * v[j].w); }
            const float rs2 = __builtin_amdgcn_rsqf(wave_sum(s2) * (1.f / D) + EPS);
            unsigned long long* x8 = (unsigned long long*)((bf16*)args.out + (size_t)m * D) + lane; unsigned long long* h8 = (unsigned long long*)(H2 + (size_t)m * D) + lane;
#pragma unroll
            for (int j = 0; j < 4; ++j) { x8[64 * j] = pk4(v[j]); h8[64 * j] = pk4(v[j] * rs2); } } }
    }
    }
    if (IN(7) && IN(8)) GSYNC();

    }
#define U ((bf16*)(ws + WS_U))
    if (IN(8)) {
    {
        Gemm g{H2, WUP, T, FF, D}; StaticOrder S; S.init(T, FF, G, bx); EpiGen<5> E{U, FF, nullptr, nullptr, nullptr, 1.f, 0};
        pg8::gemm_phase<EpiGen<5>, StaticOrder, true, true>(ring, g, S, E);
    }
    if (IN(8) && IN(9)) GSYNC();

    }

    if (IN(9)) {
    {
        Gemm g{U, WDN, T, D, FF}; StaticOrder S; S.init(T, D, G, bx); EpiGen<4> E{Z, D, nullptr, nullptr, SS, 1.f, 0};
        pg8::gemm_phase<EpiGen<4>, StaticOrder, true, true>(ring, g, S, E);
    }
    if (IN(9) && IN(10)) GSYNC();

    }
#define X2B GT
#define PB ((bf16*)(ws + WS_PB))
    if (IN(10)) {
    { int ln_ = threadIdx.x; asm volatile("" : "+v"(ln_)); const int lane = ln_ & 63; constexpr int RB = 4;
    f32x4 gg[4];
#pragma unroll
    for (int j = 0; j < 4; ++j) gg[j] = ((const f32x4*)args.in[18] + lane)[64 * j];
    for (int m0 = gw; m0 < T; m0 += RB * NGW) {
        unsigned long long xq[RB][4], zq[RB][4]; float sv[RB]; f32x4 pv[RB];
#pragma unroll
        for (int r = 0; r < RB; ++r) { const int m = m0 + r * NGW; if (m < T) {
            sv[r] = (lane < 16) ? SS[(size_t)m * 16 + lane] : 0.f;
            const unsigned long long* x8 = (const unsigned long long*)((const bf16*)args.out + (size_t)m * D) + lane; const unsigned long long* zr = (const unsigned long long*)(Z + (size_t)m * D) + lane;
#pragma unroll
            for (int j = 0; j < 4; ++j) { xq[r][j] = x8[64 * j]; zq[r][j] = zr[64 * j]; }
            const float* prow = m < TP ? args.in[2] + (size_t)m * PLE : args.in[3] + (size_t)(m - TP) * PLE; pv[r] = ((const f32x4*)prow)[lane]; } }
#pragma unroll
        for (int r = 0; r < RB; ++r) { const int m = m0 + r * NGW; if (m < T) {
            const float rs = __builtin_amdgcn_rsqf(wave_sum(sv[r]) * (1.f / D) + EPS);
            unsigned long long* h8 = (unsigned long long*)(X2B + (size_t)m * D) + lane;
#pragma unroll
            for (int j = 0; j < 4; ++j) h8[64 * j] = pk4(unp4(xq[r][j]) + unp4(zq[r][j]) * rs * gg[j]);
            ((unsigned long long*)(PB + (size_t)m * PLE))[lane] = pk4(pv[r]); } }
    }
    }
    if (IN(10) && IN(11)) GSYNC();

    }
#define EP ((bf16*)(ws + WS_EP))
#define EB ((bf16*)(ws + WS_E))
    if (IN(11)) {
    {
        Gemm g{PB, WPLE, T, D, PLE}; StaticOrder S; S.init(T, D, G, bx); EpiGen<0> E{EP, D, nullptr, nullptr, nullptr, 1.f, 0};
        pg8::gemm_phase<EpiGen<0>, StaticOrder, true, true>(ring, g, S, E);
    }

    }

    if (IN(12)) {
    {
        Gemm g{X2B, WGATE, T, D, D}; StaticOrder S; S.init(T, D, G, bx); EpiGen<6> E{EB, D, EP, nullptr, SS, 1.f, 0};
        pg8::gemm_phase<EpiGen<6>, StaticOrder, true, true>(ring, g, S, E);
    }
    if (IN(12) && IN(13)) GSYNC();

    }

    if (IN(13)) {
    { int ln_ = threadIdx.x; asm volatile("" : "+v"(ln_)); const int lane = ln_ & 63; constexpr int RB = 4;
    f32x4 gg[4];
#pragma unroll
    for (int j = 0; j < 4; ++j) gg[j] = ((const f32x4*)args.in[21] + lane)[64 * j];
    for (int m0 = gw; m0 < T; m0 += RB * NGW) {
        unsigned long long xq[RB][4], zq[RB][4]; float sv[RB];
#pragma unroll
        for (int r = 0; r < RB; ++r) { const int m = m0 + r * NGW; if (m < T) {
            sv[r] = (lane < 16) ? SS[(size_t)m * 16 + lane] : 0.f;
            const unsigned long long* x8 = (const unsigned long long*)(X2B + (size_t)m * D) + lane; const unsigned long long* zr = (const unsigned long long*)(EB + (size_t)m * D) + lane;
#pragma unroll
            for (int j = 0; j < 4; ++j) { xq[r][j] = x8[64 * j]; zq[r][j] = zr[64 * j]; } } }
#pragma unroll
        for (int r = 0; r < RB; ++r) { const int m = m0 + r * NGW; if (m < T) {
            const float rs = __builtin_amdgcn_rsqf(wave_sum(sv[r]) * (1.f / D) + EPS);
            f32x4* orow = (f32x4*)(args.out + (size_t)m * D) + lane;
#pragma unroll
            for (int j = 0; j < 4; ++j) orow[64 * j] = unp4(xq[r][j]) + unp4(zq[r][j]) * rs * gg[j]; } }
    }
    }
    }

}


__global__ void __launch_bounds__(256) ck_kernel(const unsigned* buf, size_t nwords, unsigned* cs, int rep, unsigned* flag) {
    const size_t per = (nwords + gridDim.x - 1) / gridDim.x; const size_t lo = (size_t)blockIdx.x * per; size_t hi = lo + per; if (hi > nwords) hi = nwords;
    unsigned s = 0;
    for (size_t i = lo + threadIdx.x; i < hi; i += 256) { const unsigned w = buf[i]; s += w * 2654435761u + (w >> 7); }
    __shared__ unsigned red[256]; red[threadIdx.x] = s; __syncthreads();
    for (int o = 128; o > 0; o >>= 1) { if ((int)threadIdx.x < o) red[threadIdx.x] += red[threadIdx.x + o]; __syncthreads(); }
    if (threadIdx.x == 0) { if (rep == 0) cs[blockIdx.x] = red[0]; else if (cs[blockIdx.x] != red[0]) atomicOr(flag, 1u); }
}
__global__ void nanflag_kernel(float* out, const unsigned* flag) { if (*flag) out[0] = __builtin_nanf(""); }
__global__ void clrflag_kernel(unsigned* flag) { *flag = 0u; }
extern "C" void kernel_launch(void* const* d_in, const int* in_sizes, int n_in, void* d_out, int out_size, void* d_ws, size_t ws_size, hipStream_t stream) {
    static int grid = 0;
    if (grid == 0) {
        int dev = 0, cus = 0, per_cu = 0;
        hipGetDevice(&dev); hipDeviceGetAttribute(&cus, hipDeviceAttributeMultiprocessorCount, dev);
        hipFuncSetAttribute((const void*)fwd_mega, hipFuncAttributeMaxDynamicSharedMemorySize, LDS_BYTES);
        hipOccupancyMaxActiveBlocksPerMultiprocessor(&per_cu, (const void*)fwd_mega, NWAVES * 64, LDS_BYTES);
        if (per_cu < 1) per_cu = 1;
        grid = cus * per_cu;
        if (n_in != 22 || ws_size < (size_t)1008 * MiB) { fprintf(stderr, "kernel_launch: unexpected n_in %d / ws %zu\n", n_in, ws_size); }
    }
    hipMemsetAsync(d_ws, 0, 16384, stream);
    Args a{};
    for (int i = 0; i < 22; ++i) a.in[i] = (const float*)d_in[i];
    a.out = (float*)d_out; a.ws = (unsigned char*)d_ws;
#ifndef DBG_DOUBLE
#define DBG_DOUBLE 0
#endif
#ifndef N_LAUNCH_SPLIT
#define N_LAUNCH_SPLIT 0
#endif
    if (N_LAUNCH_SPLIT) {
#ifdef DBG_K
        unsigned char* w8 = (unsigned char*)d_ws; unsigned* flag = (unsigned*)(w8 + 512 * 1024); unsigned* cs = (unsigned*)(w8 + 600 * 1024);
        hipLaunchKernelGGL(clrflag_kernel, dim3(1), dim3(1), 0, stream, flag);
        for (int rep = 0; rep < 2; ++rep) {
            for (int p = (rep ? DBG_REP1_FROM : 0); p <= DBG_K; ++p) { a.ph_lo = p; a.ph_hi = p + 1; hipLaunchKernelGGL(fwd_mega, dim3(grid), dim3(NWAVES * 64), LDS_BYTES, stream, a); }
            const size_t offs[] = DBG_OFFS; const size_t lens[] = DBG_LENS; const int isout[] = DBG_ISOUT;
            for (int r = 0; r < (int)(sizeof(offs) / sizeof(offs[0])); ++r) {
                const unsigned char* base = isout[r] ? (const unsigned char*)d_out : w8;
                hipLaunchKernelGGL(ck_kernel, dim3(1024), dim3(256), 0, stream, (const unsigned*)(base + offs[r] * MiB), lens[r] * MiB / 4, cs + r * 1024, rep, flag); }
        }
        for (int p = DBG_K + 1; p < 14; ++p) { a.ph_lo = p; a.ph_hi = p + 1; hipLaunchKernelGGL(fwd_mega, dim3(grid), dim3(NWAVES * 64), LDS_BYTES, stream, a); }
        hipLaunchKernelGGL(nanflag_kernel, dim3(1), dim3(1), 0, stream, (float*)d_out, flag);
#else
        for (int p = 0; p < 14; ++p) { a.ph_lo = p; a.ph_hi = p + 1; const int reps = ((DBG_DOUBLE >> p) & 1) ? 2 : 1;
            for (int r = 0; r < reps; ++r) hipLaunchKernelGGL(fwd_mega, dim3(grid), dim3(NWAVES * 64), LDS_BYTES, stream, a); }
#endif
    } else {
        a.ph_lo = 0; a.ph_hi = 14;
        void* kargs[] = {&a};
        hipError_t e = hipLaunchCooperativeKernel((const void*)fwd_mega, dim3(grid), dim3(NWAVES * 64), kargs, LDS_BYTES, stream);
        if (e != hipSuccess) fprintf(stderr, "cooperative launch failed: %s (grid %d)\n", hipGetErrorString(e), grid);
    }
}
```

```cpp
#include <hip/hip_runtime.h>
#include <hip/hip_cooperative_groups.h>
#include <hip/hip_bf16.h>
#include <cstdio>
#include <cstdint>
namespace cg = cooperative_groups;

namespace xl {
__device__ __forceinline__ float dpp_f(float v, const int ctrl_sel) {
    int x = __builtin_bit_cast(int, v), r;
    if (ctrl_sel == 0) r = __builtin_amdgcn_mov_dpp(x, 0xB1, 0xF, 0xF, true);
    else if (ctrl_sel == 1) r = __builtin_amdgcn_mov_dpp(x, 0x4E, 0xF, 0xF, true);
    else if (ctrl_sel == 2) r = __builtin_amdgcn_mov_dpp(x, 0x141, 0xF, 0xF, true);
    else r = __builtin_amdgcn_mov_dpp(x, 0x140, 0xF, 0xF, true);
    return __builtin_bit_cast(float, r);
}
__device__ __forceinline__ float sum16(float v) { v += dpp_f(v, 0); v += dpp_f(v, 1); v += dpp_f(v, 2); v += dpp_f(v, 3); return v; }
__device__ __forceinline__ float add_x16(float v) { auto r = __builtin_amdgcn_permlane16_swap(__float_as_uint(v), __float_as_uint(v), false, false); return __uint_as_float(r[0]) + __uint_as_float(r[1]); }
__device__ __forceinline__ float add_x32(float v) { auto r = __builtin_amdgcn_permlane32_swap(__float_as_uint(v), __float_as_uint(v), false, false); return __uint_as_float(r[0]) + __uint_as_float(r[1]); }
__device__ __forceinline__ float get_x16(float v, bool odd_row) { auto r = __builtin_amdgcn_permlane16_swap(__float_as_uint(v), __float_as_uint(v), false, false); return __uint_as_float(odd_row ? r[0] : r[1]); }
__device__ __forceinline__ float sum32(float v) { return add_x16(sum16(v)); }
__device__ __forceinline__ float sum64(float v) { return add_x32(add_x16(sum16(v))); }
}
namespace pg8 {
#define PG8_LAS __attribute__((address_space(3)))
typedef unsigned short bf16_t;
typedef short bf16x8 __attribute__((ext_vector_type(8)));
typedef float f32x4 __attribute__((ext_vector_type(4)));
typedef unsigned u32x4 __attribute__((ext_vector_type(4)));
constexpr int BM = 256, BK = 64, HALF = 128, HTB = HALF * BK * 2  , STAGE_BYTES = 8 * HTB, NXCD = 8, WGM = 8;

__host__ __device__ __forceinline__ int lds_byte(int r, int c) { const int st = (r >> 4) * 2 + (c >> 5), rr = r & 15, cc = c & 31, ob = rr * 64 + cc * 2; return st * 1024 + (ob ^ (((ob >> 9) & 1) << 5)); }
__host__ __device__ __forceinline__ void stage_rc(int b, int& R, int& C) { const int st = b / 1024, sb = b % 1024, swz = sb ^ (((sb >> 9) & 1) << 5); R = (st >> 1) * 16 + swz / 64; C = (st & 1) * 32 + (swz % 64) / 2; }
__host__ __device__ __forceinline__ int perm32(int rho) { const int n = rho >> 4, i = rho & 15; return 8 * (i >> 2) + 4 * n + (i & 3); }

struct Unit { int pm, pn; };
struct Gemm { const bf16_t* A; const bf16_t* Bt; int M, N, K; };

struct StaticOrder {
    int nM, nN, nwg, G, c;
    __host__ __device__ void init(int M, int N, int G_, int c_) { nM = M / BM; nN = N / BM; nwg = nM * nN; G = G_; c = c_; }
    __host__ __device__ bool next(int i, Unit& u) const {
        const long L = (long)i * G + c; if (L >= nwg) return false;
        int wgid = (int)L; { const int q = nwg / NXCD, r = nwg % NXCD, xcd = wgid % NXCD, off = wgid / NXCD; wgid = (xcd < r ? xcd * (q + 1) : r * (q + 1) + (xcd - r) * q) + off; }
        const int nig = WGM * nN, gid = wgid / nig, fm = gid * WGM, gsz = (nM - fm) < WGM ? (nM - fm) : WGM;
        u.pm = fm + ((wgid % nig) % gsz); u.pn = (wgid % nig) / gsz; return true;
    }
    __device__ __forceinline__ void a_ready(const Unit&) const {}
    __device__ __forceinline__ void done(const Unit&) const {}
};

__device__ __forceinline__ unsigned cvt_pk_bf16(float lo, float hi) { unsigned r; asm volatile("s_nop 0\n\tv_cvt_pk_bf16_f32 %0, %1, %2" : "=v"(r) : "v"(lo), "v"(hi)); return r; }
__device__ __forceinline__ void unpack8(const u32x4 w, float (&f)[8]) {
#pragma unroll
    for (int i = 0; i < 4; ++i) { f[2 * i] = __uint_as_float(w[i] << 16); f[2 * i + 1] = __uint_as_float(w[i] & 0xffff0000u); }
}
__device__ __forceinline__ u32x4 pack8(const float (&f)[8]) { u32x4 w; w.x = cvt_pk_bf16(f[0], f[1]); w.y = cvt_pk_bf16(f[2], f[3]); w.z = cvt_pk_bf16(f[4], f[5]); w.w = cvt_pk_bf16(f[6], f[7]); return w; }
__device__ __forceinline__ float sigm(float x) { return __builtin_amdgcn_rcpf(1.0f + __builtin_amdgcn_exp2f(-1.4426950408889634f * x)); }
template <int MODE> struct EpiGen {
    static constexpr bool PERM = true, AFTER_DRAIN = false;
    bf16_t* O; int ldc; const bf16_t* X1; const bf16_t* X2; float* ss; float scale; size_t split_stride;
    __device__ __forceinline__ void operator()(const f32x4 (&acc)[2][2][4][2], const Unit& u, int wr_, int wc_, int fr_, int fq_) const {
        int t_ = threadIdx.x; asm volatile("" : "+v"(t_));
        const int wid_ = __builtin_amdgcn_readfirstlane(t_ >> 6), wr = wid_ >> 2, wc = wid_ & 3, fr = t_ & 15, fq = (t_ >> 4) & 3;
        const int row0 = u.pm * BM + wr * 64 + fr; int colt = u.pn * BM; bf16_t* base = O;
        if (MODE == 1) { const int t = colt >> 10; base += (size_t)t * split_stride; colt -= t << 10; }
        const int col0 = colt + wc * 32 + 8 * fq;
#pragma unroll
        for (int ai = 0; ai < 2; ++ai)
#pragma unroll
            for (int m = 0; m < 4; ++m) { const int row = row0 + ai * HALF + m * 16; const size_t ro = (size_t)row * ldc + col0; float sq = 0.f;
#pragma unroll
                for (int bj = 0; bj < 2; ++bj) { float v[8];
#pragma unroll
                    for (int i = 0; i < 4; ++i) { v[i] = acc[ai][bj][m][0][i]; v[4 + i] = acc[ai][bj][m][1][i]; }
                    const size_t off = ro + bj * HALF;
                    if (MODE == 1) {
#pragma unroll
                        for (int i = 0; i < 8; ++i) v[i] = sigm(v[i]); }
                    if (MODE == 2) { float a[8]; unpack8(*(const u32x4*)(X1 + off), a);
#pragma unroll
                        for (int i = 0; i < 8; ++i) v[i] *= a[i]; }
                    if (MODE == 3) { float a[8], b[8]; unpack8(*(const u32x4*)(X1 + off), a); unpack8(*(const u32x4*)(X2 + off), b);
#pragma unroll
                        for (int i = 0; i < 8; ++i) v[i] = a[i] + b[i] * v[i]; }
                    if (MODE == 5) {
#pragma unroll
                        for (int i = 0; i < 8; ++i) { const float r = fmaxf(v[i], 0.f); v[i] = r * r; } }
                    if (MODE == 6) { float a[8]; unpack8(*(const u32x4*)(X1 + off), a);
#pragma unroll
                        for (int i = 0; i < 8; ++i) v[i] = a[i] * sigm(v[i]); }
                    if (MODE == 4 || MODE == 6) {
#pragma unroll
                        for (int i = 0; i < 8; ++i) sq += v[i] * v[i]; }
                    *(u32x4*)(base + off) = pack8(v); }
                if (MODE == 4 || MODE == 6) { sq = xl::add_x32(xl::add_x16(sq)); if (fq == 0) ss[(size_t)row * 16 + u.pn * 4 + wc] = sq; }
            }
    }
};
struct EpiGT {
    static constexpr bool PERM = true, AFTER_DRAIN = false;
    bf16_t* GT;
    __device__ __forceinline__ void operator()(const f32x4 (&acc)[2][2][4][2], const Unit& u, int wr, int wc, int fr, int fq) const {
        const int n0 = u.pm * BM + wr * 64 + fr; const int t0 = u.pn * BM + wc * 32 + 8 * fq;
#pragma unroll
        for (int bj = 0; bj < 2; ++bj) { const int t = t0 + bj * HALF; size_t tb; int S, s, b;
            if (t < 65536) { b = t >> 11; s = t & 2047; S = 2048; tb = 0; } else { const int tt = t - 65536; b = tt >> 13; s = tt & 8191; S = 8192; tb = (size_t)65536 * 1024; }
#pragma unroll
            for (int ai = 0; ai < 2; ++ai)
#pragma unroll
                for (int m = 0; m < 4; ++m) { const int n = n0 + ai * HALF + m * 16, comp = n >> 9, c = n & 511; float v[8];
#pragma unroll
                    for (int i = 0; i < 4; ++i) { v[i] = acc[ai][bj][m][0][i]; v[4 + i] = acc[ai][bj][m][1][i]; }
                    *(u32x4*)(GT + tb + ((size_t)(b * 512 + c) * 2 + comp) * S + s) = pack8(v); } }
    }
};
struct EpiQKV {
    static constexpr bool PERM = true, AFTER_DRAIN = false;
    bf16_t* Gb; bf16_t* Q; bf16_t* K; size_t vstride; const float* rope;
    __device__ __forceinline__ void operator()(const f32x4 (&acc)[2][2][4][2], const Unit& u, int wr, int wc, int fr, int fq) const {
        const int row0 = u.pm * BM + wr * 64 + fr; int colt = u.pn * BM; const int t = colt >> 10; bf16_t* base = (t == 0) ? Gb : ((t == 1) ? Q : (K + (size_t)(t - 2) * vstride)); colt -= t << 10;
        const int col0 = colt + wc * 32 + 8 * fq; const bool rot = (t == 1 || t == 2) && ((wc & 1) == 0);
        if (rot) {
#pragma unroll
            for (int ai = 0; ai < 2; ++ai) {
                f32x4 rc[4][4];
#pragma unroll
                for (int m = 0; m < 4; ++m) { const int row = row0 + ai * HALF + m * 16; const int pos = row < 65536 ? (row & 2047) : (row & 8191); const f32x4* rp = (const f32x4*)(rope + (size_t)pos * 16);
#pragma unroll
                    for (int j = 0; j < 4; ++j) rc[m][j] = rp[j]; }
#pragma unroll
                for (int m = 0; m < 4; ++m) { const int row = row0 + ai * HALF + m * 16; const size_t ro = (size_t)row * 1024 + col0;
#pragma unroll
                    for (int bj = 0; bj < 2; ++bj) { float v[8];
#pragma unroll
                        for (int i = 0; i < 4; ++i) { v[i] = acc[ai][bj][m][0][i]; v[4 + i] = acc[ai][bj][m][1][i]; }
#pragma unroll
                        for (int i = 0; i < 8; ++i) { const float o = xl::get_x16(v[i], (fq & 1) != 0); const float c = rc[m][i >> 2][i & 3], s = rc[m][2 + (i >> 2)][i & 3];
                            const float r = (fq == 0) ? (v[i] * c - o * s) : (v[i] * c + o * s);
                            v[i] = (fq < 2) ? r : v[i]; }
                        *(u32x4*)(base + ro + bj * HALF) = pack8(v); } }
            }
        } else {
#pragma unroll
            for (int ai = 0; ai < 2; ++ai)
#pragma unroll
                for (int m = 0; m < 4; ++m) { const int row = row0 + ai * HALF + m * 16; const size_t ro = (size_t)row * 1024 + col0;
#pragma unroll
                    for (int bj = 0; bj < 2; ++bj) { float v[8];
#pragma unroll
                        for (int i = 0; i < 4; ++i) { v[i] = acc[ai][bj][m][0][i]; v[4 + i] = acc[ai][bj][m][1][i]; }
                        *(u32x4*)(base + ro + bj * HALF) = pack8(v); } }
        }
    }
};
struct EpiDFT {
    static constexpr bool PERM = true, AFTER_DRAIN = false;
    bf16_t* F; int S; float scale;
    __device__ __forceinline__ void operator()(const f32x4 (&acc)[2][2][4][2], const Unit& u, int wr, int wc, int fr, int fq) const {
        const int b = u.pn >> 1, ct = u.pn & 1; const int row0 = b * S + u.pm * BM + wr * 64 + fr; const int col0 = ct * BM + wc * 32 + 8 * fq;
#pragma unroll
        for (int ai = 0; ai < 2; ++ai)
#pragma unroll
            for (int m = 0; m < 4; ++m) { const size_t ro = (size_t)(row0 + ai * HALF + m * 16) * 512 + col0;
#pragma unroll
                for (int bj = 0; bj < 2; ++bj) { float v[8];
#pragma unroll
                    for (int i = 0; i < 4; ++i) { v[i] = acc[ai][bj][m][0][i] * scale; v[4 + i] = acc[ai][bj][m][1][i] * scale; }
                    *(u32x4*)(F + ro + bj * HALF) = pack8(v); } }
    }
};
struct ListOrder {
    int base, count, nfast; bool pnfast;
    __device__ bool next(int i, Unit& u) const { if (i >= count) return false; const int idx = base + i; if (pnfast) { u.pn = idx % nfast; u.pm = idx / nfast; } else { u.pm = idx % nfast; u.pn = idx / nfast; } return true; }
    __device__ __forceinline__ void a_ready(const Unit&) const {}
    __device__ __forceinline__ void done(const Unit&) const {}
};
template <class Epi, class Sched, bool ALIGN_EPI = false, bool SP2 = false>
__device__ __forceinline__ void gemm_phase(PG8_LAS unsigned char* lds, const Gemm g, const Sched& S, const Epi& E) {
    int tid_ = threadIdx.x; asm volatile("" : "+v"(tid_));
    const int tid = tid_, wid = __builtin_amdgcn_readfirstlane(tid >> 6), lane = tid & 63, wr = wid >> 2, wc = wid & 3, fr = lane & 15, fq = lane >> 4;
    const int K = g.K, nt = K / BK;
    unsigned voffA[2], voffB[2];
#pragma unroll
    for (int i = 0; i < 2; ++i) { int R, C; stage_rc(tid * 16 + i * 8192, R, C); const int Rb = Epi::PERM ? ((R & ~31) + perm32(R & 31)) : R;
        voffA[i] = (unsigned)(R * K + C) * 2u; voffB[i] = (unsigned)(Rb * K + C) * 2u; }
    const size_t kstep = (size_t)(BK * 2);
    const size_t hstep = (size_t)HALF * K * 2;
    const size_t tstep = 2 * hstep;
    const unsigned ldsw = (unsigned)wid * 1024u;
    const int aoff = lds_byte(wr * 64 + fr, fq * 8), boff = lds_byte(wc * 32 + fr, fq * 8);
#define PG8_SA(b, h) (((b) * 2 + (h)) * HTB)
#define PG8_SB(b, h) ((4 + (b) * 2 + (h)) * HTB)
#define PG8_STAGE(bufoff, gbase, voff) do { _Pragma("unroll") for (int _i = 0; _i < 2; ++_i) \
        __builtin_amdgcn_global_load_lds((const unsigned*)((const char*)(gbase) + (voff)[_i]), (PG8_LAS unsigned*)(lds + (bufoff) + ldsw + _i * 8192), 16, 0, 0); } while (0)
#define PG8_LDA(dst, b, h) do { _Pragma("unroll") for (int m = 0; m < 4; ++m) _Pragma("unroll") for (int k = 0; k < 2; ++k) dst[m][k] = *(const PG8_LAS bf16x8*)(lds + PG8_SA(b, h) + aoff + m * 2048 + k * 1024); } while (0)
#define PG8_LDB(dst, b, h) do { _Pragma("unroll") for (int n = 0; n < 2; ++n) _Pragma("unroll") for (int k = 0; k < 2; ++k) dst[n][k] = *(const PG8_LAS bf16x8*)(lds + PG8_SB(b, h) + boff + n * 2048 + k * 1024); } while (0)
#define PG8_MMA(ai, bj, At, Bt) do { __builtin_amdgcn_s_setprio(1); _Pragma("unroll") for (int m = 0; m < 4; ++m) _Pragma("unroll") for (int n = 0; n < 2; ++n) _Pragma("unroll") for (int k = 0; k < 2; ++k) \
        acc[ai][bj][m][n] = __builtin_amdgcn_mfma_f32_16x16x32_bf16(Bt[n][k], At[m][k], acc[ai][bj][m][n], 0, 0, 0); __builtin_amdgcn_s_setprio(0); } while (0)
#define PG8_WAIT_V(n) asm volatile("s_waitcnt vmcnt(" #n ")" ::: "memory")
#define PG8_WAIT_L(n) asm volatile("s_waitcnt lgkmcnt(" #n ")" ::: "memory")
#define PG8_BAR __builtin_amdgcn_s_barrier()
#define PG8_SCHED __builtin_amdgcn_sched_barrier(0)
    Unit cur, nxt; int ui = 0;
    if (!S.next(0, cur)) return;
    f32x4 acc[2][2][4][2];
#pragma unroll
    for (int a = 0; a < 2; ++a)
#pragma unroll
        for (int b = 0; b < 2; ++b)
#pragma unroll
            for (int m = 0; m < 4; ++m)
#pragma unroll
                for (int n = 0; n < 2; ++n) acc[a][b][m][n] = (f32x4){0.f, 0.f, 0.f, 0.f};
    bf16x8 At[4][2], B0[2][2], B1[2][2];
    const char* cA = (const char*)g.A + (size_t)cur.pm * tstep; const char* cB = (const char*)g.Bt + (size_t)cur.pn * tstep;
    S.a_ready(cur);
    if constexpr (SP2) {
        PG8_STAGE(PG8_SB(0, 0), cB, voffB); PG8_STAGE(PG8_SB(0, 1), cB + hstep, voffB); PG8_STAGE(PG8_SA(0, 0), cA, voffA); PG8_STAGE(PG8_SA(0, 1), cA + hstep, voffA);
        if (wr == 1) PG8_BAR;
        PG8_WAIT_V(2); PG8_BAR;
        PG8_STAGE(PG8_SB(1, 0), cB + kstep, voffB); PG8_STAGE(PG8_SA(1, 0), cA + kstep, voffA); PG8_STAGE(PG8_SB(1, 1), cB + hstep + kstep, voffB);
        PG8_WAIT_V(6); PG8_BAR;
    } else {
        PG8_STAGE(PG8_SB(0, 0), cB, voffB); PG8_STAGE(PG8_SA(0, 0), cA, voffA); PG8_STAGE(PG8_SB(0, 1), cB + hstep, voffB); PG8_STAGE(PG8_SA(0, 1), cA + hstep, voffA);
        if (wr == 1) PG8_BAR;
        PG8_WAIT_V(4); PG8_BAR;
        PG8_STAGE(PG8_SB(1, 0), cB + kstep, voffB); PG8_STAGE(PG8_SA(1, 0), cA + kstep, voffA); PG8_STAGE(PG8_SB(1, 1), cB + hstep + kstep, voffB);
        PG8_WAIT_V(6); PG8_BAR;
    }
    for (;;) {
        const bool has_next = S.next(ui + 1, nxt);
        const char* nA = has_next ? (const char*)g.A + (size_t)nxt.pm * tstep : cA; const char* nB = has_next ? (const char*)g.Bt + (size_t)nxt.pn * tstep : cB;
        for (int t = 0; t < nt; t += 2) {
            const bool last = (t == nt - 2);
            const char* a1 = cA + (size_t)(t + 1) * kstep;
            const char* a2 = last ? nA : cA + (size_t)(t + 2) * kstep; const char* b2 = last ? nB : cB + (size_t)(t + 2) * kstep;
            const char* a3 = a2 + kstep; const char* b3 = b2 + kstep;
            if (last && has_next) S.a_ready(nxt);
            if constexpr (SP2) {
            PG8_LDB(B0, 0, 0); PG8_LDB(B1, 0, 1); PG8_SCHED; PG8_LDA(At, 0, 0); PG8_STAGE(PG8_SA(1, 1), a1 + hstep, voffA);
            PG8_WAIT_V(8); PG8_WAIT_L(0); PG8_BAR; PG8_MMA(0, 0, At, B0); PG8_MMA(0, 1, At, B1); PG8_BAR; PG8_SCHED;
            PG8_LDA(At, 0, 1); PG8_STAGE(PG8_SB(0, 0), b2, voffB); PG8_STAGE(PG8_SB(0, 1), b2 + hstep, voffB); PG8_STAGE(PG8_SA(0, 0), a2, voffA);
            PG8_WAIT_V(8); PG8_WAIT_L(0); PG8_BAR; PG8_MMA(1, 0, At, B0); PG8_MMA(1, 1, At, B1); PG8_BAR; PG8_SCHED;
            PG8_LDB(B0, 1, 0); PG8_LDB(B1, 1, 1); PG8_SCHED; PG8_LDA(At, 1, 0); PG8_STAGE(PG8_SA(0, 1), a2 + hstep, voffA);
            PG8_WAIT_V(8); PG8_WAIT_L(0); PG8_BAR; PG8_MMA(0, 0, At, B0); PG8_MMA(0, 1, At, B1); PG8_BAR; PG8_SCHED;
            PG8_LDA(At, 1, 1); PG8_STAGE(PG8_SB(1, 0), b3, voffB); PG8_STAGE(PG8_SB(1, 1), b3 + hstep, voffB); PG8_STAGE(PG8_SA(1, 0), a3, voffA);
            PG8_WAIT_V(8); PG8_WAIT_L(0); PG8_BAR; PG8_MMA(1, 0, At, B0); PG8_MMA(1, 1, At, B1); PG8_BAR; PG8_SCHED;
            } else {
            PG8_LDB(B0, 0, 0); PG8_SCHED; PG8_LDA(At, 0, 0); PG8_STAGE(PG8_SA(1, 1), a1 + hstep, voffA);
            PG8_WAIT_L(8); PG8_BAR; PG8_WAIT_L(0); PG8_MMA(0, 0, At, B0); PG8_BAR; PG8_SCHED;
            PG8_LDB(B1, 0, 1); PG8_STAGE(PG8_SB(0, 0), b2, voffB);
            PG8_BAR; PG8_WAIT_L(0); PG8_MMA(0, 1, At, B1); PG8_BAR;
            PG8_LDA(At, 0, 1); PG8_STAGE(PG8_SA(0, 0), a2, voffA);
            PG8_BAR; PG8_WAIT_L(0); PG8_MMA(1, 0, At, B0); PG8_BAR; PG8_SCHED;
            PG8_STAGE(PG8_SB(0, 1), b2 + hstep, voffB);
            PG8_WAIT_V(6); PG8_BAR; PG8_MMA(1, 1, At, B1); PG8_BAR;
            PG8_LDB(B0, 1, 0); PG8_SCHED; PG8_LDA(At, 1, 0); PG8_STAGE(PG8_SA(0, 1), a2 + hstep, voffA);
            PG8_WAIT_L(8); PG8_BAR; PG8_WAIT_L(0); PG8_MMA(0, 0, At, B0); PG8_BAR; PG8_SCHED;
            PG8_LDB(B1, 1, 1); PG8_STAGE(PG8_SB(1, 0), b3, voffB);
            PG8_BAR; PG8_WAIT_L(0); PG8_MMA(0, 1, At, B1); PG8_BAR;
            PG8_LDA(At, 1, 1); PG8_STAGE(PG8_SA(1, 0), a3, voffA);
            PG8_BAR; PG8_WAIT_L(0); PG8_MMA(1, 0, At, B0); PG8_BAR; PG8_SCHED;
            PG8_STAGE(PG8_SB(1, 1), b3 + hstep, voffB);
            PG8_WAIT_V(6); PG8_BAR; PG8_MMA(1, 1, At, B1); PG8_BAR;
            }
        }
        if constexpr (ALIGN_EPI) { if (wr == 0) PG8_BAR; }
        if constexpr (!Epi::AFTER_DRAIN) { E(acc, cur, wr, wc, fr, fq); S.done(cur); }
        if (!has_next) break;
#pragma unroll
        for (int a = 0; a < 2; ++a)
#pragma unroll
            for (int b = 0; b < 2; ++b)
#pragma unroll
                for (int m = 0; m < 4; ++m)
#pragma unroll
                    for (int n = 0; n < 2; ++n) acc[a][b][m][n] = (f32x4){0.f, 0.f, 0.f, 0.f};
        cur = nxt; cA = nA; cB = nB; ++ui;
        if constexpr (ALIGN_EPI) { if (wr == 1) PG8_BAR; }
    }
    PG8_WAIT_V(0);
    if constexpr (!ALIGN_EPI) { if (wr == 0) PG8_BAR; }
    PG8_BAR;
    if constexpr (Epi::AFTER_DRAIN) { E.fused(acc, cur, wr, wc, fr, fq, lds, wid, lane); S.done(cur); }
#undef PG8_SA
#undef PG8_SB
#undef PG8_STAGE
#undef PG8_LDA
#undef PG8_LDB
#undef PG8_MMA
#undef PG8_WAIT_V
#undef PG8_WAIT_L
#undef PG8_BAR
#undef PG8_SCHED
}
}
namespace att {
using bf16x8 = __attribute__((ext_vector_type(8))) short;
using s16x4  = __attribute__((ext_vector_type(4))) short;
using f32x16 = __attribute__((ext_vector_type(16))) float;
using u32x4  = __attribute__((ext_vector_type(4))) unsigned;
using f32x4v = __attribute__((ext_vector_type(4))) float;
typedef unsigned short bf16_t;
constexpr int NW = 8, QBLK = 32, KVBLK = 64, LD = 1024;
constexpr float SCALE = 0.125f, THR = 8.f;
constexpr int SHM_V = KVBLK * 128 * 2, SHM_K = KVBLK * 64 * 2, SHM_ATTN = 3 * SHM_V + 3 * SHM_K + NW * 64 * 4;
#define KSWZ(row, colB) ((row) * 128 + ((colB) ^ ((((row) >> 1) & 7) << 4)))
#define SBAR() __builtin_amdgcn_sched_barrier(0)
__device__ __forceinline__ int crow(int r, int hi) { return (r & 3) + 8 * (r >> 2) + 4 * hi; }
__device__ __forceinline__ unsigned cvtpk(float lo, float hi) { unsigned r; asm volatile("s_nop 0\n\tv_cvt_pk_bf16_f32 %0, %1, %2" : "=v"(r) : "v"(lo), "v"(hi)); return r; }
__device__ __forceinline__ void partialSM(f32x16& p0, f32x16& p1, float& m_reg, float& mn, float& alpha) {
  constexpr float C = SCALE * 1.4426950408889634f;
  float pmax = p0[0];
#pragma unroll
  for (int r = 1; r < 16; ++r) pmax = fmaxf(pmax, p0[r]);
#pragma unroll
  for (int r = 0; r < 16; ++r) pmax = fmaxf(pmax, p1[r]);
  { auto rr = __builtin_amdgcn_permlane32_swap(__float_as_uint(pmax), __float_as_uint(pmax), false, false);
    pmax = fmaxf(__uint_as_float(rr[0]), __uint_as_float(rr[1])); }
  if (__builtin_expect(__all(pmax - m_reg <= THR / SCALE), 1)) { mn = m_reg; alpha = 1.f; }
  else { mn = fmaxf(m_reg, pmax); alpha = __builtin_amdgcn_exp2f((m_reg - mn) * C); m_reg = mn; }
  float mnC = -mn * C;
#pragma unroll
  for (int r = 0; r < 16; ++r) p0[r] = fmaf(p0[r], C, mnC);
#pragma unroll
  for (int r = 0; r < 16; ++r) p1[r] = fmaf(p1[r], C, mnC);
#pragma unroll
  for (int r = 0; r < 16; ++r) p0[r] = __builtin_amdgcn_exp2f(p0[r]);
}
__device__ __forceinline__ void finishSM(f32x16& p0, f32x16& p1, float alpha, float& l_reg, bf16x8& pa0, bf16x8& pa1, bf16x8& pa2, bf16x8& pa3) {
#pragma unroll
  for (int r = 0; r < 16; ++r) p1[r] = __builtin_amdgcn_exp2f(p1[r]);
  float ps = 0;
#pragma unroll
  for (int r = 0; r < 16; ++r) ps += p0[r];
#pragma unroll
  for (int r = 0; r < 16; ++r) ps += p1[r];
  { auto rr = __builtin_amdgcn_permlane32_swap(__float_as_uint(ps), __float_as_uint(ps), false, false);
    ps = __uint_as_float(rr[0]) + __uint_as_float(rr[1]); }
  l_reg = l_reg * alpha + ps;
#define PK4(P, BASE, OUT) do { unsigned a0 = cvtpk(P[BASE + 0], P[BASE + 1]), a1 = cvtpk(P[BASE + 2], P[BASE + 3]);   \
    unsigned b0 = cvtpk(P[BASE + 4], P[BASE + 5]), b1 = cvtpk(P[BASE + 6], P[BASE + 7]);                              \
    auto r0 = __builtin_amdgcn_permlane32_swap(a0, b0, false, false); auto r1 = __builtin_amdgcn_permlane32_swap(a1, b1, false, false); \
    u32x4 w = {r0[0], r1[0], r0[1], r1[1]}; OUT = *reinterpret_cast<bf16x8*>(&w); } while (0)
  PK4(p0, 0, pa0); PK4(p0, 8, pa1); PK4(p1, 0, pa2); PK4(p1, 8, pa3);
#undef PK4
}
__device__ __forceinline__ void qkt(f32x16& p0, f32x16& p1, const char* Ks, const bf16x8* qr, int r32, int hi) {
  p0 = f32x16{}; p1 = f32x16{};
#pragma unroll
  for (int d0 = 0; d0 < 4; ++d0) { int cb = (d0 * 16 + hi * 8) * 2;
    bf16x8 b0 = *reinterpret_cast<const bf16x8*>(Ks + KSWZ(r32, cb));
    bf16x8 b1 = *reinterpret_cast<const bf16x8*>(Ks + KSWZ(32 + r32, cb));
    p0 = __builtin_amdgcn_mfma_f32_32x32x16_bf16(b0, qr[d0], p0, 0, 0, 0);
    p1 = __builtin_amdgcn_mfma_f32_32x32x16_bf16(b1, qr[d0], p1, 0, 0, 0); }
}
__device__ __forceinline__ int v_st(int k, int c) { const int kk = (k & ~0xC) | ((k & 4) << 1) | ((k & 8) >> 1); return ((kk >> 3) * 4 + (c >> 5)) * 512 + ((kk & 7) * 32 + (c & 31)) * 2; }
__device__ __forceinline__ int v_rd_base(int lane) { return ((lane & 3) << 3) | (((lane >> 2) & 3) << 6) | (((lane >> 4) & 1) << 5) | (((lane >> 5) & 1) << 8); }
constexpr int v_rd_off(int d0, int ks, int half) { return d0 * 512 + ks * 4096 + half * 2048; }
template <int OFF> __device__ __forceinline__ s16x4 tr_read(int vb) {
  s16x4 r; asm volatile("ds_read_b64_tr_b16 %0, %1 offset:%2" : "=&v"(r) : "v"(vb), "i"(OFF) : "memory"); return r;
}
template <int D0> __device__ __forceinline__ void pv_one(f32x16& od, int vb, bf16x8 pa0, bf16x8 pa1, bf16x8 pa2, bf16x8 pa3) {
  const s16x4 l0 = tr_read<v_rd_off(D0, 0, 0)>(vb), h0 = tr_read<v_rd_off(D0, 0, 1)>(vb), l1 = tr_read<v_rd_off(D0, 1, 0)>(vb), h1 = tr_read<v_rd_off(D0, 1, 1)>(vb);
  const s16x4 l2 = tr_read<v_rd_off(D0, 2, 0)>(vb), h2 = tr_read<v_rd_off(D0, 2, 1)>(vb), l3 = tr_read<v_rd_off(D0, 3, 0)>(vb), h3 = tr_read<v_rd_off(D0, 3, 1)>(vb);
  asm volatile("s_waitcnt lgkmcnt(0)" ::: "memory"); SBAR();
#define PK(L, H) (bf16x8){L[0], L[1], L[2], L[3], H[0], H[1], H[2], H[3]}
  od = __builtin_amdgcn_mfma_f32_32x32x16_bf16(pa0, PK(l0, h0), od, 0, 0, 0);
  od = __builtin_amdgcn_mfma_f32_32x32x16_bf16(pa1, PK(l1, h1), od, 0, 0, 0);
  od = __builtin_amdgcn_mfma_f32_32x32x16_bf16(pa2, PK(l2, h2), od, 0, 0, 0);
  od = __builtin_amdgcn_mfma_f32_32x32x16_bf16(pa3, PK(l3, h3), od, 0, 0, 0);
#undef PK
}
__device__ __forceinline__ void pv_d0(f32x16* o, int vb, bf16x8 pa0, bf16x8 pa1, bf16x8 pa2, bf16x8 pa3) {
  pv_one<0>(o[0], vb, pa0, pa1, pa2, pa3); pv_one<1>(o[1], vb, pa0, pa1, pa2, pa3); pv_one<2>(o[2], vb, pa0, pa1, pa2, pa3); pv_one<3>(o[3], vb, pa0, pa1, pa2, pa3);
}
__device__ __forceinline__ void pv_sm(f32x16* o, int vb, bf16x8 pa0, bf16x8 pa1, bf16x8 pa2, bf16x8 pa3, f32x16& p0, f32x16& p1, float& m_reg, float& mn, float& alpha) {
  constexpr float C = SCALE * 1.4426950408889634f;
  pv_one<0>(o[0], vb, pa0, pa1, pa2, pa3);
  float pmax = p0[0];
#pragma unroll
  for (int r = 1; r < 16; ++r) pmax = fmaxf(pmax, p0[r]);
#pragma unroll
  for (int r = 0; r < 16; ++r) pmax = fmaxf(pmax, p1[r]);
  { auto rr = __builtin_amdgcn_permlane32_swap(__float_as_uint(pmax), __float_as_uint(pmax), false, false);
    pmax = fmaxf(__uint_as_float(rr[0]), __uint_as_float(rr[1])); }
  pv_one<1>(o[1], vb, pa0, pa1, pa2, pa3);
  const bool keep = __all(pmax - m_reg <= THR / SCALE);
  mn = keep ? m_reg : fmaxf(m_reg, pmax); alpha = __builtin_amdgcn_exp2f((m_reg - mn) * C); m_reg = mn;
  const float mnC = -mn * C;
#pragma unroll
  for (int r = 0; r < 16; ++r) p0[r] = fmaf(p0[r], C, mnC);
  pv_one<2>(o[2], vb, pa0, pa1, pa2, pa3);
#pragma unroll
  for (int r = 0; r < 16; ++r) p1[r] = fmaf(p1[r], C, mnC);
#pragma unroll
  for (int r = 0; r < 8; ++r) p0[r] = __builtin_amdgcn_exp2f(p0[r]);
  pv_one<3>(o[3], vb, pa0, pa1, pa2, pa3);
#pragma unroll
  for (int r = 8; r < 16; ++r) p0[r] = __builtin_amdgcn_exp2f(p0[r]);
}
__device__ __forceinline__ void attn_unit(const bf16_t* Qb, const bf16_t* Kb, const bf16_t* Vh, bf16_t* Ob, int seq, char* lds, float* stash, float lam, const float* subln) {
  int tid_ = threadIdx.x; asm volatile("" : "+v"(tid_));
  const int tid = tid_, wid = tid >> 6, lane = tid & 63, r32 = lane & 31, hi = lane >> 5;
  char* V_lds = lds; char* K_lds = lds + 3 * SHM_V;
  float* ws = (float*)(lds + 3 * SHM_V + 3 * SHM_K) + wid * 64; float* li_l = ws; float* al_l = ws + 32;
  const int sr = tid >> 4, sc = (tid & 15) * 8, vst0 = v_st(sr, sc), vst1 = v_st(32 + sr, sc);
  const int kr = tid >> 3, kc = (tid & 7) * 8, kst = KSWZ(kr, kc * 2);
  const int vb0 = (int)(uintptr_t)V_lds + v_rd_base(lane);
  const int NT = seq / KVBLK;
  f32x16 o[4];
  u32x4* const sl = (u32x4*)(lds + 3 * SHM_V + 3 * SHM_K + NW * 64 * 4) + tid;
  for (int comp = 0; comp < 2; ++comp) {
    const bf16_t* Kh = Kb + comp * 64;
    float m_reg = -1e30f, l_reg = 0; bf16x8 qr[4];
#pragma unroll
    for (int d = 0; d < 4; ++d) o[d] = f32x16{};
    const bf16_t* Qw = Qb + comp * 64 + (long)(wid * QBLK + r32) * LD + hi * 8;
#pragma unroll
    for (int d0 = 0; d0 < 4; ++d0) qr[d0] = *reinterpret_cast<const bf16x8*>(Qw + d0 * 16);
    struct { bf16x8 vs0, vs1, ks0; } sr_[2];
#define SLOAD(i, k0) do { sr_[i].vs0 = *reinterpret_cast<const bf16x8*>(&Vh[(long)((k0) + sr) * LD + sc]); sr_[i].vs1 = *reinterpret_cast<const bf16x8*>(&Vh[(long)((k0) + 32 + sr) * LD + sc]); \
    sr_[i].ks0 = *reinterpret_cast<const bf16x8*>(&Kh[(long)((k0) + kr) * LD + kc]); } while (0)
#define SWRITE(b, i) do { *(bf16x8*)(V_lds + (b) * SHM_V + vst0) = sr_[i].vs0; *(bf16x8*)(V_lds + (b) * SHM_V + vst1) = sr_[i].vs1; \
    *(bf16x8*)(K_lds + (b) * SHM_K + kst) = sr_[i].ks0; } while (0)
#define SWAIT() asm volatile("s_waitcnt vmcnt(3)" ::: "memory")
#define RESC(a) do { if (__any((a) < 1.f)) { if (hi == 0) al_l[r32] = (a); asm volatile("s_waitcnt lgkmcnt(0)" ::: "memory"); \
    _Pragma("unroll") for (int d = 0; d < 4; ++d) _Pragma("unroll") for (int r = 0; r < 16; ++r) o[d][r] *= al_l[crow(r, hi)]; } } while (0)
    f32x16 pA0, pA1, pB0, pB1; float mnA, mnB, alA, alB; bf16x8 pa0, pa1, pa2, pa3;
    int bp = 0, bc = 1, bn = 2;
#define ROT3() do { const int t_ = bp; bp = bc; bc = bn; bn = t_; } while (0)
    SLOAD(0, 0); asm volatile("s_waitcnt vmcnt(0)" ::: "memory"); SWRITE(0, 0); __syncthreads();
    qkt(pA0, pA1, K_lds, qr, r32, hi); partialSM(pA0, pA1, m_reg, mnA, alA);
    SLOAD(1, KVBLK); if (2 < NT) SLOAD(0, 2 * KVBLK);
    SWAIT(); SWRITE(1, 1); __syncthreads();
    for (int j = 1; j + 1 < NT; j += 2) {
      SBAR(); qkt(pB0, pB1, K_lds + bc * SHM_K, qr, r32, hi);
      finishSM(pA0, pA1, alA, l_reg, pa0, pa1, pa2, pa3); SBAR();
      SLOAD(1, (j + 2) * KVBLK); SBAR();
      pv_sm(o, vb0 + bp * SHM_V, pa0, pa1, pa2, pa3, pB0, pB1, m_reg, mnB, alB);
      SWAIT(); SWRITE(bn, 0);
      RESC(alB); __syncthreads(); ROT3();
      SBAR(); qkt(pA0, pA1, K_lds + bc * SHM_K, qr, r32, hi);
      finishSM(pB0, pB1, alB, l_reg, pa0, pa1, pa2, pa3); SBAR();
      if (j + 3 < NT) SLOAD(0, (j + 3) * KVBLK); SBAR();
      pv_sm(o, vb0 + bp * SHM_V, pa0, pa1, pa2, pa3, pA0, pA1, m_reg, mnA, alA);
      SWAIT(); SWRITE(bn, 1);
      RESC(alA); __syncthreads(); ROT3();
    }
    SBAR(); qkt(pB0, pB1, K_lds + bc * SHM_K, qr, r32, hi);
    finishSM(pA0, pA1, alA, l_reg, pa0, pa1, pa2, pa3); SBAR();
    pv_sm(o, vb0 + bp * SHM_V, pa0, pa1, pa2, pa3, pB0, pB1, m_reg, mnB, alB);
    RESC(alB);
    finishSM(pB0, pB1, alB, l_reg, pa0, pa1, pa2, pa3); SBAR();
    pv_d0(o, vb0 + bc * SHM_V, pa0, pa1, pa2, pa3);
#undef ROT3
    if (hi == 0) li_l[r32] = l_reg; asm volatile("s_waitcnt lgkmcnt(0)" ::: "memory");
#pragma unroll
    for (int r = 0; r < 16; ++r) { const float rl = __builtin_amdgcn_rcpf(li_l[crow(r, hi)]);
#pragma unroll
      for (int d0 = 0; d0 < 4; ++d0) o[d0][r] *= rl; }
    if (comp == 0) {
#pragma unroll
      for (int d0 = 0; d0 < 4; ++d0)
#pragma unroll
        for (int hf = 0; hf < 2; ++hf) { u32x4 t; t.x = cvtpk(o[d0][8 * hf], o[d0][8 * hf + 1]); t.y = cvtpk(o[d0][8 * hf + 2], o[d0][8 * hf + 3]); t.z = cvtpk(o[d0][8 * hf + 4], o[d0][8 * hf + 5]); t.w = cvtpk(o[d0][8 * hf + 6], o[d0][8 * hf + 7]); sl[(d0 * 2 + hf) * 512] = t; } }
    __syncthreads();
#undef SLOAD
#undef SWRITE
#undef SWAIT
#undef RESC
  }
  {
    bf16_t* stg = (bf16_t*)(lds + wid * 8704);
    float sg[4];
#pragma unroll
    for (int d0 = 0; d0 < 4; ++d0) sg[d0] = subln[d0 * 32 + r32] * 0.8f;
#pragma unroll
    for (int hf = 0; hf < 2; ++hf) {
      u32x4 t0[4];
#pragma unroll
      for (int d0 = 0; d0 < 4; ++d0) t0[d0] = sl[(d0 * 2 + hf) * 512];
#pragma unroll
      for (int k = 0; k < 8; ++k) { const int r = 8 * hf + k; float v[4]; float q = 0.f;
#pragma unroll
        for (int d0 = 0; d0 < 4; ++d0) { const unsigned w0 = t0[d0][k >> 1];
          const float a = __uint_as_float((k & 1) ? (w0 & 0xffff0000u) : (w0 << 16));
          v[d0] = a - lam * o[d0][r]; q += v[d0] * v[d0]; }
        q = xl::sum32(q);
        const float rs = __builtin_amdgcn_rsqf(q * (1.0f / 128.0f) + 1e-6f); const int orow = crow(r, hi);
#pragma unroll
        for (int d0 = 0; d0 < 4; ++d0) { const float w = v[d0] * rs * sg[d0]; stg[orow * 136 + d0 * 32 + r32] = (bf16_t)(cvtpk(w, w) & 0xffffu); } }
      asm volatile("" ::: "memory");
    }
    asm volatile("s_waitcnt lgkmcnt(0)" ::: "memory");
    bf16_t* Og = Ob + (long)(wid * QBLK) * LD;
#pragma unroll
    for (int i = 0; i < 8; ++i) { const int row = i * 4 + (lane >> 4), ch = lane & 15; const u32x4 t = *(const u32x4*)((const char*)stg + row * 272 + ch * 16); *(u32x4*)(Og + (long)row * LD + ch * 8) = t; }
  }
  __syncthreads();
}
#undef SBAR
#undef KSWZ
}

namespace ct {
using att::bf16x8; using att::f32x16; using att::bf16_t;
template <int MB> __device__ __forceinline__ void unit(const bf16_t* Amat, int K, const bf16_t* src, int P, long sA, long sB, bf16_t* dst, int Q, long sC, long sD, float scale, char* lds) {
  constexpr int NCH = 8 / MB;
  int tid_ = threadIdx.x; asm volatile("" : "+v"(tid_));
  const int tid = tid_, wid = tid >> 6, lane = tid & 63, r32 = lane & 31, hi = lane >> 5;
  const int rb = wid % MB, cc = wid / MB;
  const int sr = tid >> 4, sc = (tid & 15) * 8, vst0 = att::v_st(sr, sc), vst1 = att::v_st(32 + sr, sc);
  const int vb = (int)(uintptr_t)lds + cc * 16384 + att::v_rd_base(lane);
  const int NKT = K >> 6;
#pragma unroll 1
  for (int cs = 0; cs < 4 / NCH; ++cs) {
    f32x16 o[4] = {};
#pragma unroll 1
    for (int kt = 0; kt < NKT; ++kt) {
      const int k0 = kt * 64 + sr, k1 = k0 + 32;
      const bf16_t* r0 = src + (long)(k0 % P) * sA + (long)(k0 / P) * sB + cs * NCH * 128 + sc;
      const bf16_t* r1 = src + (long)(k1 % P) * sA + (long)(k1 / P) * sB + cs * NCH * 128 + sc;
      bf16x8 t0[NCH], t1[NCH];
#pragma unroll
      for (int ch = 0; ch < NCH; ++ch) { t0[ch] = *reinterpret_cast<const bf16x8*>(r0 + ch * 128); t1[ch] = *reinterpret_cast<const bf16x8*>(r1 + ch * 128); }
      const bf16_t* ap = Amat + (long)(rb * 32 + r32) * K + kt * 64 + hi * 8;
      const bf16x8 pa0 = *reinterpret_cast<const bf16x8*>(ap), pa1 = *reinterpret_cast<const bf16x8*>(ap + 16), pa2 = *reinterpret_cast<const bf16x8*>(ap + 32), pa3 = *reinterpret_cast<const bf16x8*>(ap + 48);
      __syncthreads();
#pragma unroll
      for (int ch = 0; ch < NCH; ++ch) { *(bf16x8*)(lds + ch * 16384 + vst0) = t0[ch]; *(bf16x8*)(lds + ch * 16384 + vst1) = t1[ch]; }
      __syncthreads();
      att::pv_d0(o, vb, pa0, pa1, pa2, pa3);
    }
    bf16_t* stg = (bf16_t*)(lds + 65536 + wid * 8704);
#pragma unroll
    for (int r = 0; r < 16; ++r) { const int orow = att::crow(r, hi);
#pragma unroll
      for (int d0 = 0; d0 < 4; ++d0) { const __bf16 hb = (__bf16)(o[d0][r] * scale); stg[orow * 136 + d0 * 32 + r32] = __builtin_bit_cast(bf16_t, hb); } }
    asm volatile("s_waitcnt lgkmcnt(0)" ::: "memory");
#pragma unroll
    for (int i = 0; i < 8; ++i) { const int row = i * 4 + (lane >> 4), ch = lane & 15, m = rb * 32 + row;
      const att::u32x4 t = *(const att::u32x4*)((const char*)stg + row * 272 + ch * 16);
      *(att::u32x4*)(dst + (long)(m % Q) * sC + (long)(m / Q) * sD + (cs * NCH + cc) * 128 + ch * 8) = t; }
    asm volatile("s_waitcnt lgkmcnt(0)" ::: "memory");
  }
  __syncthreads();
}
}
#define LAS __attribute__((address_space(3)))
typedef unsigned short bf16;
typedef unsigned v4u __attribute__((ext_vector_type(4)));
typedef float f32x4 __attribute__((ext_vector_type(4)));
constexpr int NWAVES = 8;
constexpr int T = 81920, TP = 65536, D = 1024, FF = 4096, PLE = 256, INW = 5632;
constexpr float EPS = 1e-6f;
constexpr size_t MiB = 1u << 20;
constexpr size_t WS_ROPE = 1 * MiB;
constexpr size_t WS_WF2 = 2 * MiB, WS_WQKV = 4 * MiB, WS_WG = 10 * MiB, WS_WF = 14 * MiB, WS_WA = 15 * MiB, WS_WO = 17 * MiB, WS_WUP = 19 * MiB, WS_WDN = 27 * MiB, WS_WPLE = 35 * MiB, WS_WGATE = 36 * MiB;
constexpr size_t WS_A1S = 42 * MiB, WS_A1P = 46 * MiB, WS_A2S = 47 * MiB, WS_A2P = 47 * MiB + 512 * 1024;
constexpr size_t WS_UC = 544 * MiB;
constexpr size_t WS_SS = 58 * MiB;
constexpr size_t WS_XH = 64 * MiB;
constexpr size_t WS_GT = 224 * MiB;
constexpr size_t WS_Q = 384 * MiB, WS_K = 544 * MiB, WS_V = 704 * MiB;
constexpr size_t WS_F = 864 * MiB;
constexpr size_t WS_STASH = 944 * MiB;
constexpr size_t WS_U = 384 * MiB;
constexpr size_t WS_PB = 384 * MiB;
constexpr size_t WS_EP = 424 * MiB, WS_E = 584 * MiB;
constexpr int LDS_BYTES = 147456;

#define XB_TMO      128
#define XB_XCNT(j)  (256  + 64 * (j))
#define XB_XSUB(j)  (1280 + 64 * (j))
#define XB_XGEN(j)  (2304 + 64 * (j))
#define XB_TOP      3328
#define XB_TOPGEN   3392
#define XCD_BAR_WORDS 3456
#define XB_SPIN_CAP (1u << 18)

__device__ __forceinline__ unsigned xb_ld(unsigned* p)              { return __hip_atomic_load(p, __ATOMIC_RELAXED, __HIP_MEMORY_SCOPE_AGENT); }
__device__ __forceinline__ unsigned xb_add(unsigned* p, unsigned v) { return __hip_atomic_fetch_add(p, v, __ATOMIC_RELAXED, __HIP_MEMORY_SCOPE_AGENT); }
__device__ __forceinline__ unsigned xb_xcc_id() { return (unsigned)__builtin_amdgcn_s_getreg((3 << 11) | 20) & 0xFu; }
#define XB_SPIN(cond, bar) do { unsigned _sp = 0; while (cond) { __builtin_amdgcn_s_sleep(1); \
    if ((++_sp & 255u) == 0u) { if (xb_ld(&(bar)[XB_TMO])) break; if (_sp > XB_SPIN_CAP) { atomicAdd(&(bar)[XB_TMO], 1u); break; } } } } while (0)

struct XcdBarrier {
    unsigned* bar; unsigned x;
    volatile LAS unsigned* st;
};

__device__ __forceinline__ XcdBarrier xcd_barrier_post(unsigned* bar, volatile LAS unsigned* st) {
    XcdBarrier b; b.bar = bar; b.x = xb_xcc_id(); b.st = st;
    if (threadIdx.x == 0) (void)xb_add(&bar[XB_XCNT(b.x)], 1u);
    return b;
}
__device__ __forceinline__ void xcd_barrier_complete(unsigned* bar, unsigned x, unsigned& nloc, unsigned& nx) {
    const unsigned G = gridDim.x * gridDim.y * gridDim.z;
    unsigned sum, cnt, mine, sp = 0u;
    for (;;) {
        sum = 0u; cnt = 0u; mine = 0u;
#pragma unroll
        for (unsigned j = 0; j < 16; ++j) { const unsigned c = xb_ld(&bar[XB_XCNT(j)]); sum += c; cnt += (c > 0u) ? 1u : 0u; mine = (j == x) ? c : mine; }
        if (sum == G) break;
        __builtin_amdgcn_s_sleep(1);
        if ((++sp & 255u) == 0u) { if (xb_ld(&bar[XB_TMO])) break; if (sp > XB_SPIN_CAP) { atomicAdd(&bar[XB_TMO], 1u); break; } }
    }
    nloc = mine > 0u ? mine : 1u; nx = cnt > 0u ? cnt : 1u;
}

__device__ __forceinline__ void xcd_barrier(const XcdBarrier& b) {
    asm volatile("s_waitcnt vmcnt(0)" ::: "memory");
    __syncthreads();
    if (threadIdx.x == 0) {
        unsigned* bar = b.bar;
        __builtin_amdgcn_s_waitcnt(0);
        unsigned nloc = b.st[0], nx = b.st[1];
        if (nloc == 0u) { xcd_barrier_complete(bar, b.x, nloc, nx); b.st[0] = nloc; b.st[1] = nx; }
        const unsigned old = xb_add(&bar[XB_XSUB(b.x)], 1u);
        const unsigned gen = old / nloc;
        if (old + 1u == (gen + 1u) * nloc) {
            __builtin_amdgcn_fence(__ATOMIC_RELEASE, "agent");
            asm volatile("s_waitcnt vmcnt(0)" ::: "memory");
            const unsigned og = xb_add(&bar[XB_TOP], 1u);
            const unsigned tg = og / nx;
            if (og + 1u == (tg + 1u) * nx) xb_add(&bar[XB_TOPGEN], 1u);
            else XB_SPIN(xb_ld(&bar[XB_TOPGEN]) == tg, bar);
            __builtin_amdgcn_fence(__ATOMIC_ACQUIRE, "agent");
            xb_add(&bar[XB_XGEN(b.x)], 1u);
            asm volatile("s_waitcnt vmcnt(0)" ::: "memory");
        } else {
            XB_SPIN(xb_ld(&bar[XB_XGEN(b.x)]) == gen, bar);
            __builtin_amdgcn_fence(__ATOMIC_ACQUIRE, "agent");
            asm volatile("s_waitcnt vmcnt(0)" ::: "memory");
        }
    }
    __syncthreads();
}

struct Args { const float* in[22]; float* out; unsigned char* ws; int ph_lo, ph_hi; };

__device__ __forceinline__ float wave_sum(float v) { return xl::sum64(v); }
__device__ __forceinline__ unsigned pk2(float lo, float hi) { return pg8::cvt_pk_bf16(lo, hi); }
__device__ __forceinline__ f32x4 unp4(unsigned long long q) { f32x4 r; r.x = __uint_as_float((unsigned)q << 16); r.y = __uint_as_float((unsigned)q & 0xffff0000u); r.z = __uint_as_float((unsigned)(q >> 32) << 16); r.w = __uint_as_float((unsigned)(q >> 32) & 0xffff0000u); return r; }
__device__ __forceinline__ unsigned long long pk4(f32x4 v) { return (unsigned long long)pk2(v.x, v.y) | ((unsigned long long)pk2(v.z, v.w) << 32); }
__device__ __forceinline__ void p0_transpose_item(const float* W, int ldw, int col0, int K, int N, const float* gain, bf16* WT, LAS float* scr, int item, int lane) {
    const int nblk = N / 32, kb = item / nblk, nb = item % nblk, k0 = 64 * kb, n0 = 32 * nb;
    float wv[32];
#pragma unroll
    for (int i = 0; i < 32; ++i) { const int kk = 2 * i + (lane >> 5); wv[i] = W[(size_t)(k0 + kk) * ldw + col0 + n0 + (lane & 31)]; }
#pragma unroll
    for (int i = 0; i < 32; ++i) { const int kk = 2 * i + (lane >> 5); const float g = gain ? gain[k0 + kk] : 1.f; scr[kk * 33 + (lane & 31)] = wv[i] * g; }
    asm volatile("s_waitcnt lgkmcnt(0)" ::: "memory");
    const int c = lane & 7;
#pragma unroll
    for (int j = 0; j < 4; ++j) { const int n = (lane >> 3) + 8 * j; const LAS float* s = scr + (8 * c) * 33 + n;
        v4u o; o.x = pk2(s[0 * 33], s[1 * 33]); o.y = pk2(s[2 * 33], s[3 * 33]); o.z = pk2(s[4 * 33], s[5 * 33]); o.w = pk2(s[6 * 33], s[7 * 33]);
        *(v4u*)(WT + (size_t)(n0 + n) * K + k0 + 8 * c) = o; }
    asm volatile("s_waitcnt lgkmcnt(0)" ::: "memory");
}
__device__ __forceinline__ const float* xrow(const Args& a, int m) { return m < TP ? a.in[0] + (size_t)m * D : a.in[1] + (size_t)(m - TP) * D; }

__global__ void __launch_bounds__(NWAVES * 64, 2) fwd_mega(Args args) {
    extern __shared__ __attribute__((aligned(16))) unsigned char lds[];
    cg::grid_group grid = cg::this_grid();
#define IN(k) (args.ph_lo <= (k) && (k) < args.ph_hi)
    volatile LAS unsigned* xst = (volatile LAS unsigned*)((LAS unsigned char*)lds + (LDS_BYTES - 16));
    if (threadIdx.x == 0) { xst[0] = 0u; xst[1] = 0u; }
    __syncthreads();
    const XcdBarrier xbar = xcd_barrier_post((unsigned*)args.ws, xst);
#define GSYNC() xcd_barrier(xbar)
    const int tid = threadIdx.x, lane = tid & 63, wave = __builtin_amdgcn_readfirstlane(tid >> 6);
    const int G = gridDim.x, bx = blockIdx.x; const int vcu = (G % 8 == 0) ? (bx % 8) * (G / 8) + bx / 8 : bx;
    unsigned char* ws = args.ws;
    LAS unsigned char* ldsl = (LAS unsigned char*)lds;
#define WF2 ((bf16*)(ws + WS_WF2))
#define WQKV ((bf16*)(ws + WS_WQKV))
#define WG ((bf16*)(ws + WS_WG))
#define WF ((bf16*)(ws + WS_WF))
#define WA ((bf16*)(ws + WS_WA))
#define WO ((bf16*)(ws + WS_WO))
#define WUP ((bf16*)(ws + WS_WUP))
#define WDN ((bf16*)(ws + WS_WDN))
#define WPLE ((bf16*)(ws + WS_WPLE))
#define WGATE ((bf16*)(ws + WS_WGATE))
#define ROPE ((float*)(ws + WS_ROPE))
#define UC ((bf16*)(ws + WS_UC))
#define SS ((float*)(ws + WS_SS))
#define XH ((bf16*)(ws + WS_XH))
#define GT ((bf16*)(ws + WS_GT))
#define QB ((bf16*)(ws + WS_Q))
#define KB ((bf16*)(ws + WS_V))
#define VB ((bf16*)(ws + WS_V) + (size_t)T * D)
#define FB ((bf16*)(ws + WS_F))
    const int gw = vcu * NWAVES + wave, NGW = G * NWAVES;
    const int gtid = bx * (NWAVES * 64) + tid, NGT = G * NWAVES * 64;

    using pg8::Gemm; using pg8::StaticOrder; using pg8::EpiGen; using pg8::ListOrder;
    LAS unsigned char* ring = ldsl;
    if (IN(0)) {
    {
        LAS float* scr = (LAS float*)(ldsl + wave * 16384);
        const float* w_in = args.in[5];
        constexpr int I_QKV = 16 * 96, I_G = 16 * 64, I_F = 8 * 32, I_A = 16 * 32, I_O = 16 * 32, I_UP = 16 * 128, I_DN = 64 * 32, I_PLE = 4 * 32, I_GATE = 16 * 32;
        constexpr int NITEMS = I_QKV + I_G + I_F + I_A + I_O + I_UP + I_DN + I_PLE + I_GATE;
        for (int it = gw; it < NITEMS; it += NGW) {
            int r = it;
            if (r < I_QKV) { p0_transpose_item(w_in, INW, 512, D, 3072, args.in[4], WQKV, scr, r, lane); continue; } r -= I_QKV;
            if (r < I_G) { p0_transpose_item(w_in, INW, 3584, D, 2048, args.in[4], WG, scr, r, lane); continue; } r -= I_G;
            if (r < I_F) { p0_transpose_item(args.in[6], D, 0, 512, D, nullptr, WF, scr, r, lane); continue; } r -= I_F;
            if (r < I_A) { p0_transpose_item(args.in[7], D, 0, D, D, nullptr, WA, scr, r, lane); continue; } r -= I_A;
            if (r < I_O) { p0_transpose_item(args.in[8], D, 0, D, D, nullptr, WO, scr, r, lane); continue; } r -= I_O;
            if (r < I_UP) { p0_transpose_item(args.in[16], FF, 0, D, FF, args.in[15], WUP, scr, r, lane); continue; } r -= I_UP;
            if (r < I_DN) { p0_transpose_item(args.in[17], D, 0, FF, D, nullptr, WDN, scr, r, lane); continue; } r -= I_DN;
            if (r < I_PLE) { p0_transpose_item(args.in[19], D, 0, PLE, D, nullptr, WPLE, scr, r, lane); continue; } r -= I_PLE;
            p0_transpose_item(args.in[20], D, 0, D, D, nullptr, WGATE, scr, r, lane);
        }
        __syncthreads();
        {
            LAS float* Wt = (LAS float*)ldsl;
            LAS float* ctab = (LAS float*)(ldsl + 8192);
            for (int item = bx; item < 256; item += G) {
                const int grp = item >> 6, k0 = (item & 63) * 16;
                for (int e = tid; e < 2048; e += NWAVES * 64) { const int kk = e >> 7, c = e & 127; Wt[c * 16 + kk] = w_in[(size_t)(k0 + kk) * INW + grp * 128 + c] * args.in[4][k0 + kk]; }
                if (tid < 128) ctab[tid] = __builtin_amdgcn_cosf((float)tid * (1.0f / 128.0f));
                __syncthreads();
                const int m = tid & 127, comp = (tid >> 7) & 1, kh = tid >> 8;
                float acc[8];
#pragma unroll
                for (int i = 0; i < 8; ++i) acc[i] = 0.f;
                for (int c = 0; c < 128; ++c) { const float t = ctab[(c * m + (comp ? 96 : 0)) & 127]; const LAS f32x4* wp = (const LAS f32x4*)(Wt + c * 16 + kh * 8); const f32x4 w0 = wp[0], w1 = wp[1];
#pragma unroll
                    for (int i = 0; i < 4; ++i) { acc[i] += w0[i] * t; acc[4 + i] += w1[i] * t; } }
                v4u o; o.x = pk2(acc[0], acc[1]); o.y = pk2(acc[2], acc[3]); o.z = pk2(acc[4], acc[5]); o.w = pk2(acc[6], acc[7]);
                *(v4u*)(WF2 + (size_t)(comp * 512 + grp * 128 + m) * D + k0 + kh * 8) = o;
                __syncthreads();
            }
        }
        { bf16* A1S = (bf16*)(ws + WS_A1S); bf16* A1P = (bf16*)(ws + WS_A1P); bf16* A2S = (bf16*)(ws + WS_A2S); bf16* A2P = (bf16*)(ws + WS_A2P);
          for (int it = gtid; it < 128 * 128 * 128; it += NGT) { const int k = it & 127, m = (it >> 7) & 127, s2 = it >> 14; const int ri = m >> 6, k1 = m & 63, comp = k >> 6, s1 = k & 63;
              const float fr = (float)((k1 * (128 * s1 + s2)) & 8191) * (1.0f / 8192.0f); const float c = __builtin_amdgcn_cosf(fr), s = __builtin_amdgcn_sinf(fr);
              const float v = ri == 0 ? (comp == 0 ? c : -s) : (comp == 0 ? -s : -c); A1S[it] = (bf16)(pk2(v, v) & 0xffffu); }
          for (int it = gtid; it < 64 * 64 * 64; it += NGT) { const int k = it & 63, m = (it >> 6) & 63, s2 = it >> 12; const int ri = m >> 5, k1 = m & 31, comp = k >> 5, s1 = k & 31;
              const float fr = (float)((k1 * (64 * s1 + s2)) & 2047) * (1.0f / 2048.0f); const float c = __builtin_amdgcn_cosf(fr), s = __builtin_amdgcn_sinf(fr);
              const float v = ri == 0 ? (comp == 0 ? c : -s) : (comp == 0 ? -s : -c); A1P[it] = (bf16)(pk2(v, v) & 0xffffu); }
          for (int it = gtid; it < 128 * 256; it += NGT) { const int k = it & 255, k2 = it >> 8; const int ri = k >> 7, s2 = k & 127;
              const float fr = (float)((k2 * s2) & 127) * (1.0f / 128.0f); const float v = ri == 0 ? __builtin_amdgcn_cosf(fr) : __builtin_amdgcn_sinf(fr); A2S[it] = (bf16)(pk2(v, v) & 0xffffu); }
          for (int it = gtid; it < 64 * 128; it += NGT) { const int k = it & 127, k2 = it >> 7; const int ri = k >> 6, s2 = k & 63;
              const float fr = (float)((k2 * s2) & 63) * (1.0f / 64.0f); const float v = ri == 0 ? __builtin_amdgcn_cosf(fr) : __builtin_amdgcn_sinf(fr); A2P[it] = (bf16)(pk2(v, v) & 0xffffu); }
        }
        if (gtid < 65536) { const int pos = gtid >> 3, i = gtid & 7;
            const double ifr[8] = {0.15915494309189535, 0.03086376340470123, 0.005985185712713705, 0.001160663641240061, 0.00022507907903927653, 4.364795279280289e-05, 8.464330808241401e-06, 1.6414262627950345e-06};
            double rev = (double)pos * (i == 0 ? ifr[0] : i == 1 ? ifr[1] : i == 2 ? ifr[2] : i == 3 ? ifr[3] : i == 4 ? ifr[4] : i == 5 ? ifr[5] : i == 6 ? ifr[6] : ifr[7]);
            rev -= (double)(long long)rev; const float fr = (float)rev;
            ROPE[pos * 16 + i] = __builtin_amdgcn_cosf(fr); ROPE[pos * 16 + 8 + i] = __builtin_amdgcn_sinf(fr); }
        for (int m0 = gw; m0 < T; m0 += 4 * NGW) { f32x4 v[4][4];
#pragma unroll
            for (int r = 0; r < 4; ++r) { const int m = m0 + r * NGW; if (m < T) { const f32x4* xr = (const f32x4*)xrow(args, m) + lane;
#pragma unroll
                for (int j = 0; j < 4; ++j) v[r][j] = xr[64 * j]; } }
#pragma unroll
            for (int r = 0; r < 4; ++r) { const int m = m0 + r * NGW; if (m < T) { float s = 0.f;
#pragma unroll
                for (int j = 0; j < 4; ++j) s += (v[r][j].x * v[r][j].x + v[r][j].y * v[r][j].y) + (v[r][j].z * v[r][j].z + v[r][j].w * v[r][j].w);
                const float ms = wave_sum(s) * (1.f / D) + EPS; const float rs = __builtin_amdgcn_rsqf(ms);
                if (lane == 0) ((float*)(ws + 63 * MiB))[m] = ms * rs;
                unsigned long long* o8 = (unsigned long long*)(XH + (size_t)m * D) + lane;
#pragma unroll
                for (int j = 0; j < 4; ++j) o8[64 * j] = pk4(v[r][j] * rs); } } }
    }
    if (IN(0) && IN(1)) GSYNC();
    if (args.ph_lo < 0) grid.sync();

    }

    if (IN(1)) {
    {
        Gemm g{XH, WF2, T, 4096, D}; StaticOrder S; S.init(T, 4096, G, bx); pg8::EpiQKV E{GT, QB, KB, (size_t)T * D, ROPE};
        pg8::gemm_phase<pg8::EpiQKV, StaticOrder, true, true>(ring, g, S, E);
    }
    if (IN(1) && IN(2)) GSYNC();

    }
#define GF GT
#define GA ((bf16*)(ws + WS_V))
#define Y1 ((bf16*)(ws + WS_UC))
#define MG GT
#define ATT QB
    if (IN(2)) {
    {
        float lam;
        { const float a = wave_sum(args.in[9][lane] * args.in[10][lane]), b = wave_sum(args.in[11][lane] * args.in[12][lane]); lam = __expf(a) - __expf(b) + 0.2f; }
        float* stash = (float*)(ws + WS_STASH) + (size_t)bx * 32768;
        const int NCU = G;
        const int ppc = (2048 + NCU - 1) / NCU, spc = (512 + NCU - 1) / NCU;
#ifdef DBG_ATT2
        for (int pass2 = 0; pass2 < 2; ++pass2)
#else
        const int pass2 = 1;
#endif
        for (int i = 0; i < ppc + spc; ++i) { const bool smp = i >= ppc; int bh, qb;
            if (NCU == 256) { if (smp) { bh = (vcu >> 5) + 8 * (i - ppc); qb = vcu & 31; } else { bh = (vcu >> 3) + 32 * i; qb = vcu & 7; } }
            else { const int ui = smp ? vcu * spc + (i - ppc) : vcu * ppc + i; if (ui >= (smp ? 512 : 2048)) continue; const int lq = smp ? 5 : 3; bh = ui >> lq; qb = ui & ((1 << lq) - 1); }
            const int b = bh >> 3, h = bh & 7; const int seq = smp ? 8192 : 2048;
            const size_t r0 = (smp ? (size_t)TP : 0) + (size_t)b * seq; const size_t qo = (r0 + qb * 256) * D + h * 128, ko = r0 * D + h * 128;
            att::attn_unit(QB + qo, KB + ko, VB + ko, (pass2 ? QB : UC) + qo, seq, (char*)lds, stash, lam, args.in[13]); }
        __syncthreads();
        { const bf16* A1S = (const bf16*)(ws + WS_A1S); const bf16* A1P = (const bf16*)(ws + WS_A1P); bf16* US = UC + (size_t)131072 * 512;
          for (int ui = vcu; ui < 256 + 2048; ui += NCU) {
            if (ui < 256) { const int b = ui >> 7, s2 = ui & 127;
                ct::unit<4>(A1S + (size_t)s2 * 128 * 128, 128, GT + ((size_t)TP + (size_t)b * 8192 + s2) * 1024, 64, 128L * 1024, 512L, US + ((size_t)b * 64 * 2 * 128 + s2) * 512, 64, 2L * 128 * 512, 128L * 512, 1.0f, (char*)lds); }
            else { const int up = ui - 256, b = up >> 6, s2 = up & 63;
                ct::unit<2>(A1P + (size_t)s2 * 64 * 64, 64, GT + ((size_t)b * 2048 + s2) * 1024, 32, 64L * 1024, 512L, UC + ((size_t)b * 32 * 2 * 64 + s2) * 512, 32, 2L * 64 * 512, 64L * 512, 1.0f, (char*)lds); }
          } }
    }
    if (IN(2) && IN(3)) GSYNC();

    }

    if (IN(3)) {
    {
        const bf16* A2S = (const bf16*)(ws + WS_A2S); const bf16* A2P = (const bf16*)(ws + WS_A2P); const bf16* US = UC + (size_t)131072 * 512;
        for (int ui = vcu; ui < 128 + 1024; ui += G) {
            if (ui < 128) { const int b = ui >> 6, k1 = ui & 63;
                ct::unit<4>(A2S, 256, US + ((size_t)(b * 64 + k1) * 2 * 128) * 512, 256, 512L, 0L, FB + ((size_t)TP + (size_t)b * 8192 + k1) * 512, 128, 64L * 512, 0L, 1.0f / 1024.0f, (char*)lds); }
            else { const int up = ui - 128, b = up >> 5, k1 = up & 31;
                ct::unit<2>(A2P, 128, UC + ((size_t)(b * 32 + k1) * 2 * 64) * 512, 128, 512L, 0L, FB + ((size_t)b * 2048 + k1) * 512, 64, 32L * 512, 0L, 1.0f / 512.0f, (char*)lds); }
        }
    }
    {
        Gemm g{XH, WG, T, 2048, D}; StaticOrder S; S.init(T, 2048, G, bx); EpiGen<1> E{GF, D, nullptr, nullptr, nullptr, 1.f, (size_t)(WS_V - WS_GT) / 2};
        pg8::gemm_phase<EpiGen<1>, StaticOrder, true, true>(ring, g, S, E);
    }
    if (IN(3) && IN(4)) GSYNC();

    }

    if (IN(4)) {
    {
        Gemm g{FB, WF, T, D, 512}; StaticOrder S; S.init(T, D, G, bx); EpiGen<2> E{Y1, D, GF, nullptr, nullptr, 1.f, 0};
        pg8::gemm_phase<EpiGen<2>, StaticOrder, true, true>(ring, g, S, E);
    }

    }

    if (IN(5)) {
    {
        Gemm g{ATT, WA, T, D, D}; StaticOrder S; S.init(T, D, G, bx); EpiGen<3> E{MG, D, Y1, GA, nullptr, 1.f, 0};
        pg8::gemm_phase<EpiGen<3>, StaticOrder, true, true>(ring, g, S, E);
    }
    if (IN(5) && IN(6)) GSYNC();

    }
#define Z XH
#define Z4 UC
    if (IN(6)) {
    {
        Gemm g{MG, WO, T, D, D}; StaticOrder S; S.init(T, D, G, bx); EpiGen<4> E{Z4, D, nullptr, nullptr, SS, 1.f, 0};
        pg8::gemm_phase<EpiGen<4>, StaticOrder, true, true>(ring, g, S, E);
    }
    if (IN(6) && IN(7)) GSYNC();

    }
#define H2 GT
    if (IN(7)) {
    { int ln_ = threadIdx.x; asm volatile("" : "+v"(ln_)); const int lane = ln_ & 63; constexpr int RB = 4;
    f32x4 gg[4];
#pragma unroll
    for (int j = 0; j < 4; ++j) gg[j] = ((const f32x4*)args.in[14] + lane)[64 * j];
    for (int m0 = gw; m0 < T; m0 += RB * NGW) {
        unsigned long long xq[RB][4], zq[RB][4]; float sv[RB], xsv[RB];
#pragma unroll
        for (int r = 0; r < RB; ++r) { const int m = m0 + r * NGW; if (m < T) {
            sv[r] = (lane < 16) ? SS[(size_t)m * 16 + lane] : 0.f; xsv[r] = ((const float*)(ws + 63 * MiB))[m];
            const unsigned long long* xr = (const unsigned long long*)(XH + (size_t)m * D) + lane; const unsigned long long* zr = (const unsigned long long*)(Z4 + (size_t)m * D) + lane;
#pragma unroll
            for (int j = 0; j < 4; ++j) { xq[r][j] = xr[64 * j]; zq[r][j] = zr[64 * j]; } } }
#pragma unroll
        for (int r = 0; r < RB; ++r) { const int m = m0 + r * NGW; if (m < T) {
            const float rs = __builtin_amdgcn_rsqf(wave_sum(sv[r]) * (1.f / D) + EPS); f32x4 v[4]; float s2 = 0.f;
#pragma unroll
            for (int j = 0; j < 4; ++j) { v[j] = unp4(xq[r][j]) * xsv[r] + unp4(zq[r][j]) * rs * gg[j]; s2 += (v[j].x * v[j].x + v[j].y * v[j].y) + (v[j].z * v[j].z + v[j].w * v[j].w); }
            const float rs2 = __builtin_amdgcn_rsqf(wave_sum(s2) * (1.f / D) + EPS);
            unsigned long long* x8 = (unsigned long long*)((bf16*)args.out + (size_t)m * D) + lane; unsigned long long* h8 = (unsigned long long*)(H2 + (size_t)m * D) + lane;
#pragma unroll
            for (int j = 0; j < 4; ++j) { x8[64 * j] = pk4(v[j]); h8[64 * j] = pk4(v[j] * rs2); } } }
    }
    }
    if (IN(7) && IN(8)) GSYNC();

    }
#define U ((bf16*)(ws + WS_U))
    if (IN(8)) {
    {
        Gemm g{H2, WUP, T, FF, D}; StaticOrder S; S.init(T, FF, G, bx); EpiGen<5> E{U, FF, nullptr, nullptr, nullptr, 1.f, 0};
        pg8::gemm_phase<EpiGen<5>, StaticOrder, true, true>(ring, g, S, E);
    }
    if (IN(8) && IN(9)) GSYNC();

    }

    if (IN(9)) {
    {
        Gemm g{U, WDN, T, D, FF}; StaticOrder S; S.init(T, D, G, bx); EpiGen<4> E{Z, D, nullptr, nullptr, SS, 1.f, 0};
        pg8::gemm_phase<EpiGen<4>, StaticOrder, true, true>(ring, g, S, E);
    }
    if (IN(9) && IN(10)) GSYNC();

    }
#define X2B GT
#define PB ((bf16*)(ws + WS_PB))
    if (IN(10)) {
    { int ln_ = threadIdx.x; asm volatile("" : "+v"(ln_)); const int lane = ln_ & 63; constexpr int RB = 4;
    f32x4 gg[4];
#pragma unroll
    for (int j = 0; j < 4; ++j) gg[j] = ((const f32x4*)args.in[18] + lane)[64 * j];
    for (int m0 = gw; m0 < T; m0 += RB * NGW) {
        unsigned long long xq[RB][4], zq[RB][4]; float sv[RB]; f32x4 pv[RB];
#pragma unroll
        for (int r = 0; r < RB; ++r) { const int m = m0 + r * NGW; if (m < T) {
            sv[r] = (lane < 16) ? SS[(size_t)m * 16 + lane] : 0.f;
            const unsigned long long* x8 = (const unsigned long long*)((const bf16*)args.out + (size_t)m * D) + lane; const unsigned long long* zr = (const unsigned long long*)(Z + (size_t)m * D) + lane;
#pragma unroll
            for (int j = 0; j < 4; ++j) { xq[r][j] = x8[64 * j]; zq[r][j] = zr[64 * j]; }
            const float* prow = m < TP ? args.in[2] + (size_t)m * PLE : args.in[3] + (size_t)(m - TP) * PLE; pv[r] = ((const f32x4*)prow)[lane]; } }
#pragma unroll
        for (int r = 0; r < RB; ++r) { const int m = m0 + r * NGW; if (m < T) {
            const float rs = __builtin_amdgcn_rsqf(wave_sum(sv[r]) * (1.f / D) + EPS);
            unsigned long long* h8 = (unsigned long long*)(X2B + (size_t)m * D) + lane;
#pragma unroll
            for (int j = 0; j < 4; ++j) h8[64 * j] = pk4(unp4(xq[r][j]) + unp4(zq[r][j]) * rs * gg[j]);
            ((unsigned long long*)(PB + (size_t)m * PLE))[lane] = pk4(pv[r]); } }
    }
    }
    if (IN(10) && IN(11)) GSYNC();

    }
#define EP ((bf16*)(ws + WS_EP))
#define EB ((bf16*)(ws + WS_E))
    if (IN(11)) {
    {
        Gemm g{PB, WPLE, T, D, PLE}; StaticOrder S; S.init(T, D, G, bx); EpiGen<0> E{EP, D, nullptr, nullptr, nullptr, 1.f, 0};
        pg8::gemm_phase<EpiGen<0>, StaticOrder, true, true>(ring, g, S, E);
    }

    }

    if (IN(12)) {
    {
        Gemm g{X2B, WGATE, T, D, D}; StaticOrder S; S.init(T, D, G, bx); EpiGen<6> E{EB, D, EP, nullptr, SS, 1.f, 0};
        pg8::gemm_phase<EpiGen<6>, StaticOrder, true, true>(ring, g, S, E);
    }
    if (IN(12) && IN(13)) GSYNC();

    }

    if (IN(13)) {
    { int ln_ = threadIdx.x; asm volatile("" : "+v"(ln_)); const int lane = ln_ & 63; constexpr int RB = 4;
    f32x4 gg[4];
#pragma unroll
    for (int j = 0; j < 4; ++j) gg[j] = ((const f32x4*)args.in[21] + lane)[64 * j];
    for (int m0 = gw; m0 < T; m0 += RB * NGW) {
        unsigned long long xq[RB][4], zq[RB][4]; float sv[RB];
#pragma unroll
        for (int r = 0; r < RB; ++r) { const int m = m0 + r * NGW; if (m < T) {
            sv[r] = (lane < 16) ? SS[(size_t)m * 16 + lane] : 0.f;
            const unsigned long long* x8 = (const unsigned long long*)(X2B + (size_t)m * D) + lane; const unsigned long long* zr = (const unsigned long long*)(EB + (size_t)m * D) + lane;
#pragma unroll
            for (int j = 0; j < 4; ++j) { xq[r][j] = x8[64 * j]; zq[r][j] = zr[64 * j]; } } }
#pragma unroll
        for (int r = 0; r < RB; ++r) { const int m = m0 + r * NGW; if (m < T) {
            const float rs = __builtin_amdgcn_rsqf(wave_sum(sv[r]) * (1.f / D) + EPS);
            f32x4* orow = (f32x4*)(args.out + (size_t)m * D) + lane;
#pragma unroll
            for (int j = 0; j < 4; ++j) orow[64 * j] = unp4(xq[r][j]) + unp4(zq[r][j]) * rs * gg[j]; } }
    }
    }
    }

}


__global__ void __launch_bounds__(256) ck_kernel(const unsigned* buf, size_t nwords, unsigned* cs, int rep, unsigned* flag) {
    const size_t per = (nwords + gridDim.x - 1) / gridDim.x; const size_t lo = (size_t)blockIdx.x * per; size_t hi = lo + per; if (hi > nwords) hi = nwords;
    unsigned s = 0;
    for (size_t i = lo + threadIdx.x; i < hi; i += 256) { const unsigned w = buf[i]; s += w * 2654435761u + (w >> 7); }
    __shared__ unsigned red[256]; red[threadIdx.x] = s; __syncthreads();
    for (int o = 128; o > 0; o >>= 1) { if ((int)threadIdx.x < o) red[threadIdx.x] += red[threadIdx.x + o]; __syncthreads(); }
    if (threadIdx.x == 0) { if (rep == 0) cs[blockIdx.x] = red[0]; else if (cs[blockIdx.x] != red[0]) atomicOr(flag, 1u); }
}
__global__ void nanflag_kernel(float* out, const unsigned* flag) { if (*flag) out[0] = __builtin_nanf(""); }
__global__ void clrflag_kernel(unsigned* flag) { *flag = 0u; }
extern "C" void kernel_launch(void* const* d_in, const int* in_sizes, int n_in, void* d_out, int out_size, void* d_ws, size_t ws_size, hipStream_t stream) {
    static int grid = 0;
    if (grid == 0) {
        int dev = 0, cus = 0, per_cu = 0;
        hipGetDevice(&dev); hipDeviceGetAttribute(&cus, hipDeviceAttributeMultiprocessorCount, dev);
        hipFuncSetAttribute((const void*)fwd_mega, hipFuncAttributeMaxDynamicSharedMemorySize, LDS_BYTES);
        hipOccupancyMaxActiveBlocksPerMultiprocessor(&per_cu, (const void*)fwd_mega, NWAVES * 64, LDS_BYTES);
        if (per_cu < 1) per_cu = 1;
        grid = cus * per_cu;
        if (n_in != 22 || ws_size < (size_t)1008 * MiB) { fprintf(stderr, "kernel_launch: unexpected n_in %d / ws %zu\n", n_in, ws_size); }
    }
    hipMemsetAsync(d_ws, 0, 16384, stream);
    Args a{};
    for (int i = 0; i < 22; ++i) a.in[i] = (const float*)d_in[i];
    a.out = (float*)d_out; a.ws = (unsigned char*)d_ws;
#ifndef DBG_DOUBLE
#define DBG_DOUBLE 0
#endif
#ifndef N_LAUNCH_SPLIT
#define N_LAUNCH_SPLIT 0
#endif
    if (N_LAUNCH_SPLIT) {
#ifdef DBG_K
        unsigned char* w8 = (unsigned char*)d_ws; unsigned* flag = (unsigned*)(w8 + 512 * 1024); unsigned* cs = (unsigned*)(w8 + 600 * 1024);
        hipLaunchKernelGGL(clrflag_kernel, dim3(1), dim3(1), 0, stream, flag);
        for (int rep = 0; rep < 2; ++rep) {
            for (int p = (rep ? DBG_REP1_FROM : 0); p <= DBG_K; ++p) { a.ph_lo = p; a.ph_hi = p + 1; hipLaunchKernelGGL(fwd_mega, dim3(grid), dim3(NWAVES * 64), LDS_BYTES, stream, a); }
            const size_t offs[] = DBG_OFFS; const size_t lens[] = DBG_LENS; const int isout[] = DBG_ISOUT;
            for (int r = 0; r < (int)(sizeof(offs) / sizeof(offs[0])); ++r) {
                const unsigned char* base = isout[r] ? (const unsigned char*)d_out : w8;
                hipLaunchKernelGGL(ck_kernel, dim3(1024), dim3(256), 0, stream, (const unsigned*)(base + offs[r] * MiB), lens[r] * MiB / 4, cs + r * 1024, rep, flag); }
        }
        for (int p = DBG_K + 1; p < 14; ++p) { a.ph_lo = p; a.ph_hi = p + 1; hipLaunchKernelGGL(fwd_mega, dim3(grid), dim3(NWAVES * 64), LDS_BYTES, stream, a); }
        hipLaunchKernelGGL(nanflag_kernel, dim3(1), dim3(1), 0, stream, (float*)d_out, flag);
#else
        for (int p = 0; p < 14; ++p) { a.ph_lo = p; a.ph_hi = p + 1; const int reps = ((DBG_DOUBLE >> p) & 1) ? 2 : 1;
            for (int r = 0; r < reps; ++r) hipLaunchKernelGGL(fwd_mega, dim3(grid), dim3(NWAVES * 64), LDS_BYTES, stream, a); }
#endif
    } else {
        a.ph_lo = 0; a.ph_hi = 14;
        void* kargs[] = {&a};
        hipError_t e = hipLaunchCooperativeKernel((const void*)fwd_mega, dim3(grid), dim3(NWAVES * 64), kargs, LDS_BYTES, stream);
        if (e != hipSuccess) fprintf(stderr, "cooperative launch failed: %s (grid %d)\n", hipGetErrorString(e), grid);
    }
}
```
